# Optimizing an MI355X kernel written in HIP

```python
import jax, jax.numpy as jnp
from jax import lax
import numpy as np

D_MODEL = 1024
BATCH = 8
SEQ = 4096
DEPTH = 1
DEC_BATCH = 128
DEC_SEQ = 8
PAST_LEN = 16384
PAGE_SIZE = 128

HEAD_DIM = 64
D_RWKV = D_MODEL // 2
D_ATTN = D_MODEL - D_RWKV
N_RWKV_HEADS = D_RWKV // HEAD_DIM
N_Q_HEADS = D_ATTN // HEAD_DIM
N_KV_HEADS = 2
Q_PER_KV = N_Q_HEADS // N_KV_HEADS
WINDOW = 128
D_DECAY_LORA = 64
D_AAA_LORA = 64
D_PLE = 256
D_SHIFT = 3 * D_RWKV + D_DECAY_LORA + D_AAA_LORA
D_KV = N_KV_HEADS * HEAD_DIM
D_IN = D_SHIFT + D_RWKV + D_ATTN + 2 * D_KV + D_ATTN
NORM_EPS = 1e-6
LNX_EPS = 64e-5
NEG_INF = -1e30

kernel_name = 'hymba_rwkv7_swa_sink_step'


def _f32(t):
    return t.astype(jnp.float32)


def _rms(x, g, eps=NORM_EPS):
    xf = _f32(x)
    y = xf * lax.rsqrt(jnp.mean(xf * xf, axis=-1, keepdims=True) + eps)
    return (y * _f32(g)).astype(x.dtype)


def _in_proj(x, g_norm, w_in):
    h = _rms(x, g_norm) @ w_in
    sizes = [D_SHIFT, D_RWKV, D_ATTN, D_KV, D_KV, D_ATTN]
    idx = np.cumsum(sizes)[:-1].tolist()
    return jnp.split(h, idx, axis=-1)


def _rwkv_branch(f, prev, s0, mu, w0, w_dec2, a0, w_a2, k_k, k_a, r_k, lnx_w, lnx_b):
    B, T, _ = f.shape
    f_prev = jnp.concatenate([prev.astype(f.dtype), f[:, :-1]], axis=1)
    fs = _f32(f + (f_prev - f) * mu)
    r, k, v, wl, al = jnp.split(fs, [D_RWKV, 2 * D_RWKV, 3 * D_RWKV, 3 * D_RWKV + D_DECAY_LORA], axis=-1)
    logw = -jax.nn.softplus(-(_f32(w0) + jnp.tanh(wl) @ _f32(w_dec2))) - 0.5
    decay = jnp.exp(-jnp.exp(logw))
    a = jax.nn.sigmoid(_f32(a0) + al @ _f32(w_a2))
    hs = lambda t: t.reshape(B, T, N_RWKV_HEADS, HEAD_DIM)
    kk = hs(k * _f32(k_k))
    kk = kk * lax.rsqrt(jnp.maximum(jnp.sum(kk * kk, axis=-1, keepdims=True), 1e-24))
    k = k * (1.0 + (a - 1.0) * _f32(k_a))
    r_h, k_h, v_h, w_h, a_h = hs(r), hs(k), hs(v), hs(decay), hs(a)
    aa = -kk
    bb = kk * a_h

    def step(S, xs):
        r_t, w_t, k_t, v_t, a_t, b_t = xs
        Sa = jnp.einsum('bhvk,bhk->bhv', S, a_t)
        S = S * w_t[:, :, None, :] + Sa[..., None] * b_t[:, :, None, :] + v_t[..., None] * k_t[:, :, None, :]
        return S, jnp.einsum('bhvk,bhk->bhv', S, r_t)

    tm = lambda t: jnp.swapaxes(t, 0, 1)
    S_T, y = lax.scan(step, _f32(s0), (tm(r_h), tm(w_h), tm(k_h), tm(v_h), tm(aa), tm(bb)))
    y = tm(y)
    mean = jnp.mean(y, axis=-1, keepdims=True)
    var = jnp.mean(jnp.square(y - mean), axis=-1, keepdims=True)
    y = ((y - mean) * lax.rsqrt(var + LNX_EPS)).reshape(B, T, D_RWKV) * _f32(lnx_w) + _f32(lnx_b)
    bonus = jnp.sum(r_h * k_h * _f32(r_k), axis=-1, keepdims=True) * v_h
    y = y + bonus.reshape(B, T, D_RWKV)
    return y, S_T, f[:, -1:]


def _qkv(q, k, v, q_norm_w, k_norm_w):
    B, T, _ = q.shape
    q = _rms(q.reshape(B, T, N_KV_HEADS, Q_PER_KV, HEAD_DIM), q_norm_w)
    k = _rms(k.reshape(B, T, N_KV_HEADS, HEAD_DIM), k_norm_w)
    v = v.reshape(B, T, N_KV_HEADS, HEAD_DIM)
    return q, k, v


def _sink_attention(q, k, v, valid, sinks):
    s = jnp.einsum('...qkgd,...jkd->...kgqj', _f32(q), _f32(k)) * (HEAD_DIM ** -0.5)
    s = jnp.where(valid, s, NEG_INF)
    sink = _f32(sinks).reshape(N_KV_HEADS, Q_PER_KV, 1, 1)
    m = jnp.maximum(jnp.max(s, axis=-1, keepdims=True), sink)
    p = jnp.exp(s - m)
    denom = jnp.sum(p, axis=-1, keepdims=True) + jnp.exp(sink - m)
    return jnp.einsum('...kgqj,...jkd->...qkgd', (p / denom).astype(v.dtype), v)


def _swa_prompt(q, k, v, sinks):
    B, S = q.shape[:2]
    nb = S // WINDOW
    qb = q.reshape(B, nb, WINDOW, N_KV_HEADS, Q_PER_KV, HEAD_DIM)
    kb = k.reshape(B, nb, WINDOW, N_KV_HEADS, HEAD_DIM)
    vb = v.reshape(B, nb, WINDOW, N_KV_HEADS, HEAD_DIM)
    pad = jnp.zeros_like(kb[:, :1])
    kband = jnp.concatenate([jnp.concatenate([pad, kb[:, :-1]], axis=1), kb], axis=2)
    vband = jnp.concatenate([jnp.concatenate([pad, vb[:, :-1]], axis=1), vb], axis=2)
    blk = jnp.arange(nb)[:, None] * WINDOW
    qpos = blk + jnp.arange(WINDOW)[None]
    kpos = blk + jnp.arange(2 * WINDOW)[None] - WINDOW
    dist = qpos[:, :, None] - kpos[:, None, :]
    valid = (dist >= 0) & (dist < WINDOW) & (kpos[:, None, :] >= 0)
    o = _sink_attention(qb, kband, vband, valid[:, None, None], sinks)
    return o.reshape(B, S, D_ATTN)


def _swa_sample(q, k, v, ck, cv, sinks):
    B, T = q.shape[:2]
    wb = ck.shape[1]
    keys = jnp.concatenate([ck.astype(k.dtype), k], axis=1)
    vals = jnp.concatenate([cv.astype(v.dtype), v], axis=1)
    qpos = PAST_LEN + jnp.arange(T)
    kpos = PAST_LEN - wb + jnp.arange(wb + T)
    dist = qpos[:, None] - kpos[None, :]
    valid = (dist >= 0) & (dist < WINDOW)
    o = _sink_attention(q, keys, vals, valid, sinks)
    return o.reshape(B, T, D_ATTN), keys[:, -wb:], vals[:, -wb:]


def _merge(x, o_r, z_r, o_a, z_a, w_out, pl, g_ple, w_ple_gate, w_ple_proj):
    o = jnp.concatenate([o_r.astype(x.dtype) * jax.nn.silu(z_r), o_a.astype(x.dtype) * jax.nn.silu(z_a)], axis=-1)
    h = x + o @ w_out
    gate = jax.nn.sigmoid(_rms(h, g_ple) @ w_ple_gate)
    return h + gate * (pl.astype(x.dtype) @ w_ple_proj)


def setup_inputs(seed: int = 0) -> dict:
    key = jax.random.key(seed)
    ks = iter(jax.random.split(key, 40))
    nrm = lambda shape, s: jax.random.normal(next(ks), shape, jnp.float32) * s
    uni = lambda shape, lo, hi: jax.random.uniform(next(ks), shape, jnp.float32, lo, hi)
    wb = min(WINDOW, PAST_LEN)
    return {
        'x_prompt': nrm((BATCH, SEQ, D_MODEL), 1.0),
        'x_sample': nrm((DEC_BATCH, DEC_SEQ, D_MODEL), 1.0),
        'state_rwkv': nrm((DEPTH, DEC_BATCH, N_RWKV_HEADS, HEAD_DIM, HEAD_DIM), 1.0),
        'state_shift': nrm((DEPTH, DEC_BATCH, 1, D_SHIFT), 1.0),
        'cache_k': nrm((DEPTH, DEC_BATCH, wb, N_KV_HEADS, HEAD_DIM), 1.0),
        'cache_v': nrm((DEPTH, DEC_BATCH, wb, N_KV_HEADS, HEAD_DIM), 1.0),
        'p_prompt': nrm((DEPTH, BATCH, SEQ, D_PLE), 1.0),
        'p_sample': nrm((DEPTH, DEC_BATCH, DEC_SEQ, D_PLE), 1.0),
        'g_norm': 1.0 + nrm((DEPTH, D_MODEL), 0.02),
        'w_in': nrm((DEPTH, D_MODEL, D_IN), D_MODEL ** -0.5),
        'mu_shift': uni((DEPTH, D_SHIFT), 0.0, 1.0),
        'w0': uni((DEPTH, D_RWKV), -6.0, -1.0),
        'w_dec2': nrm((DEPTH, D_DECAY_LORA, D_RWKV), 0.1),
        'a0': nrm((DEPTH, D_RWKV), 0.5),
        'w_a2': nrm((DEPTH, D_AAA_LORA, D_RWKV), 0.1),
        'k_k': 0.85 + nrm((DEPTH, D_RWKV), 0.05),
        'k_a': 1.0 + nrm((DEPTH, D_RWKV), 0.05),
        'r_k': nrm((DEPTH, N_RWKV_HEADS, HEAD_DIM), 0.1),
        'lnx_w': 1.0 + nrm((DEPTH, D_RWKV), 0.02),
        'lnx_b': nrm((DEPTH, D_RWKV), 0.02),
        'q_norm_w': 1.0 + nrm((DEPTH, HEAD_DIM), 0.02),
        'k_norm_w': 1.0 + nrm((DEPTH, HEAD_DIM), 0.02),
        'sinks': nrm((DEPTH, N_Q_HEADS), 0.5),
        'w_out': nrm((DEPTH, D_MODEL, D_MODEL), D_MODEL ** -0.5),
        'g_ple': 1.0 + nrm((DEPTH, D_MODEL), 0.02),
        'w_ple_gate': nrm((DEPTH, D_MODEL, D_MODEL), D_MODEL ** -0.5),
        'w_ple_proj': nrm((DEPTH, D_PLE, D_MODEL), D_PLE ** -0.5),
    }


def reference(x_prompt, x_sample, state_rwkv, state_shift, cache_k, cache_v, p_prompt, p_sample,
              g_norm, w_in, mu_shift, w0, w_dec2, a0, w_a2, k_k, k_a, r_k, lnx_w, lnx_b,
              q_norm_w, k_norm_w, sinks, w_out, g_ple, w_ple_gate, w_ple_proj):
    xp, xs = x_prompt, x_sample
    bp, bs = xp.shape[0], xs.shape[0]
    s_p_list, s_s_list, sh_p_list, sh_s_list = [], [], [], []
    kp_list, ks_list, vp_list, vs_list = [], [], [], []
    for i in range(DEPTH):
        rw = (mu_shift[i], w0[i], w_dec2[i], a0[i], w_a2[i], k_k[i], k_a[i], r_k[i], lnx_w[i], lnx_b[i])
        f, z_r, q, k, v, z_a = _in_proj(xp, g_norm[i], w_in[i])
        s0 = jnp.zeros((bp, N_RWKV_HEADS, HEAD_DIM, HEAD_DIM), jnp.float32)
        o_r, S_p, sh_p = _rwkv_branch(f, jnp.zeros_like(f[:, :1]), s0, *rw)
        qh, kh, vh = _qkv(q, k, v, q_norm_w[i], k_norm_w[i])
        o_a = _swa_prompt(qh, kh, vh, sinks[i])
        wbp = min(WINDOW, xp.shape[1])
        kp_list.append(kh[:, -wbp:].astype(cache_k.dtype))
        vp_list.append(vh[:, -wbp:].astype(cache_v.dtype))
        s_p_list.append(S_p.astype(state_rwkv.dtype))
        sh_p_list.append(sh_p.astype(state_shift.dtype))
        xp = _merge(xp, o_r, z_r, o_a, z_a, w_out[i], p_prompt[i], g_ple[i], w_ple_gate[i], w_ple_proj[i])
        f, z_r, q, k, v, z_a = _in_proj(xs, g_norm[i], w_in[i])
        o_r, S_s, sh_s = _rwkv_branch(f, state_shift[i], state_rwkv[i], *rw)
        qh, kh, vh = _qkv(q, k, v, q_norm_w[i], k_norm_w[i])
        o_a, k_buf, v_buf = _swa_sample(qh, kh, vh, cache_k[i], cache_v[i], sinks[i])
        ks_list.append(k_buf.astype(cache_k.dtype))
        vs_list.append(v_buf.astype(cache_v.dtype))
        s_s_list.append(S_s.astype(state_rwkv.dtype))
        sh_s_list.append(sh_s.astype(state_shift.dtype))
        xs = _merge(xs, o_r, z_r, o_a, z_a, w_out[i], p_sample[i], g_ple[i], w_ple_gate[i], w_ple_proj[i])
    return (xp, xs,
            jnp.stack(s_p_list), jnp.stack(s_s_list),
            jnp.stack(sh_p_list), jnp.stack(sh_s_list),
            jnp.stack(kp_list), jnp.stack(ks_list),
            jnp.stack(vp_list), jnp.stack(vs_list))
```

```cpp
#include <hip/hip_runtime.h>
#include <stdint.h>
#include <cstdio>

#define LAS __attribute__((address_space(3)))
typedef float f32x16 __attribute__((ext_vector_type(16)));

#define MP 32768
#define MS 1024
#define MT 33792
#define TP 4096
#define TS 8
#define DM 1024
#define DIN 3456
#define DINP 3584
#define DSH 1664
#define OFF_ZR 1664
#define OFF_Q 2176
#define OFF_K 2688
#define OFF_V 2816
#define OFF_ZA 2944
#define NTHR 512

__device__ __forceinline__ int lane_id_() { int l; asm volatile("v_mbcnt_lo_u32_b32 %0, -1, 0\n\tv_mbcnt_hi_u32_b32 %0, -1, %0" : "=v"(l)); return l; }
#define TIDX_(wid) ((wid) * 64 + lane_id_())
namespace pg8 {
#define PG8_LAS __attribute__((address_space(3)))
typedef unsigned short bf16_t;
typedef short bf16x8 __attribute__((ext_vector_type(8)));
typedef float f32x4 __attribute__((ext_vector_type(4)));
typedef unsigned u32x4 __attribute__((ext_vector_type(4)));
constexpr int BM = 256, BK = 64, HALF = 128, HTB = HALF * BK * 2  , STAGE_BYTES = 8 * HTB, NXCD = 8, WGM = 8;

__host__ __device__ __forceinline__ int lds_byte(int r, int c) { const int st = (r >> 4) * 2 + (c >> 5), rr = r & 15, cc = c & 31, ob = rr * 64 + cc * 2; return st * 1024 + (ob ^ (((ob >> 9) & 1) << 5)); }
__host__ __device__ __forceinline__ void stage_rc(int b, int& R, int& C) { const int st = b / 1024, sb = b % 1024, swz = sb ^ (((sb >> 9) & 1) << 5); R = (st >> 1) * 16 + swz / 64; C = (st & 1) * 32 + (swz % 64) / 2; }
__host__ __device__ __forceinline__ int perm32(int rho) { const int n = rho >> 4, i = rho & 15; return 8 * (i >> 2) + 4 * n + (i & 3); }

struct Unit { int pm, pn; };
struct Gemm { const bf16_t* A; const bf16_t* Bt; int M, N, K, lda, wid; };

struct StaticOrder {
    int nM, nN, nwg, G, c;
    __host__ __device__ void init(int M, int N, int G_, int c_) { nM = M / BM; nN = N / BM; nwg = nM * nN; G = G_; c = c_; }
    __host__ __device__ bool next(int i, Unit& u) const {
        const long L = (long)i * G + c; if (L >= nwg) return false;
        int wgid = (int)L; { const int q = nwg / NXCD, r = nwg % NXCD, xcd = wgid % NXCD, off = wgid / NXCD; wgid = (xcd < r ? xcd * (q + 1) : r * (q + 1) + (xcd - r) * q) + off; }
        const int nig = WGM * nN, gid = wgid / nig, fm = gid * WGM, gsz = (nM - fm) < WGM ? (nM - fm) : WGM;
        u.pm = fm + ((wgid % nig) % gsz); u.pn = (wgid % nig) / gsz; return true;
    }
    __device__ __forceinline__ void a_ready(const Unit&) const {}
    __device__ __forceinline__ void done(const Unit&) const {}
};

typedef float f32x2_t __attribute__((ext_vector_type(2)));
typedef __bf16 bf16x2_t __attribute__((ext_vector_type(2)));
__device__ __forceinline__ unsigned pack2(float lo, float hi) { f32x2_t v = {lo, hi}; bf16x2_t b = __builtin_convertvector(v, bf16x2_t); return __builtin_bit_cast(unsigned, b); }
__device__ __forceinline__ bf16_t f2bf(float f) { return (bf16_t)(pack2(f, 0.f) & 0xffffu); }
__device__ __forceinline__ float bf2f(bf16_t h) { return __uint_as_float(((unsigned)h) << 16); }
__device__ __forceinline__ float bflo(unsigned u) { return __uint_as_float(u << 16); }
__device__ __forceinline__ float bfhi(unsigned u) { return __uint_as_float(u & 0xffff0000u); }
__device__ __forceinline__ float fexp2_(float x) { return __builtin_amdgcn_exp2f(x); }
__device__ __forceinline__ float frcp_(float x) { return __builtin_amdgcn_rcpf(x); }
__device__ __forceinline__ float sigmoidf_(float x) { return frcp_(1.0f + fexp2_(-1.44269504f * x)); }
__device__ __forceinline__ float wave_sum(float x) {
#pragma unroll
    for (int o = 32; o >= 1; o >>= 1) x += __shfl_xor(x, o);
    return x;
}
template <int CTRL> __device__ __forceinline__ float dpp_f(float x) {
    return __builtin_bit_cast(float, __builtin_amdgcn_update_dpp(0, __builtin_bit_cast(int, x), CTRL, 0xF, 0xF, false));
}
__device__ __forceinline__ float row16_allsum(float x) {
    x += dpp_f<0x128>(x); x += dpp_f<0x124>(x); x += dpp_f<0x122>(x); x += dpp_f<0x121>(x);
    return x;
}

struct EpiInProj {
    static constexpr bool PERM = true, AFTER_DRAIN = false;
    bf16_t* H;
    __device__ __forceinline__ void operator()(const f32x4 (&acc)[2][2][4][2], const Unit& u, int wr, int wc, int fr, int fq) const {
        const int row0 = u.pm * 256 + wr * 64 + fr, col0 = u.pn * 256 + wc * 32 + 8 * fq;
#pragma unroll
        for (int ai = 0; ai < 2; ++ai)
#pragma unroll
            for (int m = 0; m < 4; ++m) {
                const int row = row0 + ai * 128 + m * 16;
#pragma unroll
                for (int bj = 0; bj < 2; ++bj) {
                    const int col = col0 + bj * 128;
                    if (col < DIN) {
                        const f32x4 v0 = acc[ai][bj][m][0], v1 = acc[ai][bj][m][1];
                        u32x4 w; w.x = pack2(v0[0], v0[1]); w.y = pack2(v0[2], v0[3]); w.z = pack2(v1[0], v1[1]); w.w = pack2(v1[2], v1[3]);
                        *(u32x4*)(H + (size_t)row * DIN + col) = w;
                    }
                }
            }
    }
};
__device__ __forceinline__ unsigned char* ple_slot(float* y, int row, int pn, int wc, int fq) { return (unsigned char*)(y + (size_t)row * DM) + pn * 1024 + 512 + wc * 128 + fq * 32; }
struct EpiPle {
    static constexpr bool PERM = true, AFTER_DRAIN = false;
    float* y; bf16_t* pls;
    __device__ __forceinline__ void operator()(const f32x4 (&acc)[2][2][4][2], const Unit& u, int wr, int wc, int fr, int fq) const {
        const int row0 = u.pm * 256 + wr * 64 + fr;
#pragma unroll
        for (int ai = 0; ai < 2; ++ai)
#pragma unroll
            for (int m = 0; m < 4; ++m) {
                unsigned char* sl = ple_slot(y, row0 + ai * 128 + m * 16, u.pn, wc, fq);
#pragma unroll
                for (int bj = 0; bj < 2; ++bj) {
                    const f32x4 v0 = acc[ai][bj][m][0], v1 = acc[ai][bj][m][1];
                    u32x4 w; w.x = pack2(v0[0], v0[1]); w.y = pack2(v0[2], v0[3]); w.z = pack2(v1[0], v1[1]); w.w = pack2(v1[2], v1[3]);
                    *(u32x4*)(sl + bj * 16) = w;
                    if (u.pm >= MP / 256) *(u32x4*)(pls + (size_t)(row0 + ai * 128 + m * 16 - MP) * DM + u.pn * 256 + bj * 128 + wc * 32 + 8 * fq) = w;
                }
            }
    }
};
struct TailOrder {
    int n, G, c0, c;
    __device__ __forceinline__ bool next(int i, Unit& u) const { if (c < c0) return false; const int L = i * (G - c0) + (c - c0); if (L >= n) return false; u.pm = L >> 2; u.pn = L & 3; return true; }
    __device__ __forceinline__ void a_ready(const Unit&) const {}
    __device__ __forceinline__ void done(const Unit&) const {}
};
struct EpiOut {
    static constexpr bool PERM = true, AFTER_DRAIN = false;
    bf16_t* hb; float* part; const float* xs;
    __device__ __forceinline__ void operator()(const f32x4 (&acc)[2][2][4][2], const Unit& u, int wr, int wc, int fr, int fq) const {
        const int row0 = u.pm * 256 + wr * 64 + fr, col0 = u.pn * 256 + wc * 32 + 8 * fq;
        u32x4 xa[2], xb[2]; float sxa, sxb;
#define EO_LOAD(X, it) { const int row_ = row0 + ((it) >> 2) * 128 + ((it) & 3) * 16; const bf16_t* xr_ = hb + (size_t)row_ * DM + col0; X[0] = *(const u32x4*)xr_; X[1] = *(const u32x4*)(xr_ + 128); s##X = xs[row_]; }
#define EO_STEP(X, it) { const int ai_ = (it) >> 2, m_ = (it) & 3, row_ = row0 + ai_ * 128 + m_ * 16; float ss = 0.f; \
            _Pragma("unroll") for (int bj = 0; bj < 2; ++bj) { const u32x4 xv = X[bj]; \
                const f32x4 h0 = (f32x4){bflo(xv.x), bfhi(xv.x), bflo(xv.y), bfhi(xv.y)} * s##X + acc[ai_][bj][m_][0], h1 = (f32x4){bflo(xv.z), bfhi(xv.z), bflo(xv.w), bfhi(xv.w)} * s##X + acc[ai_][bj][m_][1]; \
                u32x4 w; w.x = pack2(h0[0], h0[1]); w.y = pack2(h0[2], h0[3]); w.z = pack2(h1[0], h1[1]); w.w = pack2(h1[2], h1[3]); \
                *(u32x4*)(hb + (size_t)row_ * DM + col0 + bj * 128) = w; \
                ss += (h0[0] * h0[0] + h0[1] * h0[1]) + (h0[2] * h0[2] + h0[3] * h0[3]) + (h1[0] * h1[0] + h1[1] * h1[1]) + (h1[2] * h1[2] + h1[3] * h1[3]); } \
            ss += __shfl_xor(ss, 16); ss += __shfl_xor(ss, 32); if (fq == 0) part[(size_t)row_ * 16 + u.pn * 4 + wc] = ss; }
        EO_LOAD(xa, 0)
        EO_LOAD(xb, 1) EO_STEP(xa, 0) EO_LOAD(xa, 2) EO_STEP(xb, 1) EO_LOAD(xb, 3) EO_STEP(xa, 2) EO_LOAD(xa, 4) EO_STEP(xb, 3)
        EO_LOAD(xb, 5) EO_STEP(xa, 4) EO_LOAD(xa, 6) EO_STEP(xb, 5) EO_LOAD(xb, 7) EO_STEP(xa, 6) EO_STEP(xb, 7)
#undef EO_LOAD
#undef EO_STEP
    }
};
struct EpiGate {
    static constexpr bool PERM = true, AFTER_DRAIN = false;
    float* y; const bf16_t* hb; const float* part;
    __device__ __forceinline__ void operator()(const f32x4 (&acc)[2][2][4][2], const Unit& u, int wr, int wc, int fr, int fq) const {
        const int row0 = u.pm * 256 + wr * 64 + fr, col0 = u.pn * 256 + wc * 32 + 8 * fq;
        u32x4 ha[2], hb2[2], pa[2], pb[2]; f32x4 qa[4], qb[4];
#define EG_LOAD(Hh, Pp, Qq, it) { const int row_ = row0 + ((it) >> 2) * 128 + ((it) & 3) * 16; \
            Hh[0] = *(const u32x4*)(hb + (size_t)row_ * DM + col0); Hh[1] = *(const u32x4*)(hb + (size_t)row_ * DM + col0 + 128); \
            { const unsigned char* sl_ = ple_slot(y, row_, u.pn, wc, fq); Pp[0] = *(const u32x4*)sl_; Pp[1] = *(const u32x4*)(sl_ + 16); } \
            _Pragma("unroll") for (int i = 0; i < 4; ++i) Qq[i] = *(const f32x4*)(part + (size_t)row_ * 16 + i * 4); }
#define EG_STEP(Hh, Pp, Qq, it) { const int ai_ = (it) >> 2, m_ = (it) & 3, row_ = row0 + ai_ * 128 + m_ * 16; \
            float ss = 0.f; _Pragma("unroll") for (int i = 0; i < 4; ++i) ss += (Qq[i][0] + Qq[i][1]) + (Qq[i][2] + Qq[i][3]); \
            const float rs = rsqrtf(ss * (1.0f / DM) + 1e-6f); \
            _Pragma("unroll") for (int bj = 0; bj < 2; ++bj) { const f32x4 a0 = acc[ai_][bj][m_][0], a1 = acc[ai_][bj][m_][1]; const u32x4 hh = Hh[bj], pl = Pp[bj]; f32x4 o0, o1; \
                o0[0] = bflo(hh.x) + sigmoidf_(a0[0] * rs) * bflo(pl.x); o0[1] = bfhi(hh.x) + sigmoidf_(a0[1] * rs) * bfhi(pl.x); \
                o0[2] = bflo(hh.y) + sigmoidf_(a0[2] * rs) * bflo(pl.y); o0[3] = bfhi(hh.y) + sigmoidf_(a0[3] * rs) * bfhi(pl.y); \
                o1[0] = bflo(hh.z) + sigmoidf_(a1[0] * rs) * bflo(pl.z); o1[1] = bfhi(hh.z) + sigmoidf_(a1[1] * rs) * bfhi(pl.z); \
                o1[2] = bflo(hh.w) + sigmoidf_(a1[2] * rs) * bflo(pl.w); o1[3] = bfhi(hh.w) + sigmoidf_(a1[3] * rs) * bfhi(pl.w); \
                float* yp = y + (size_t)row_ * DM + col0 + bj * 128; *(f32x4*)yp = o0; *(f32x4*)(yp + 4) = o1; } }
        EG_LOAD(ha, pa, qa, 0)
        EG_LOAD(hb2, pb, qb, 1) EG_STEP(ha, pa, qa, 0) EG_LOAD(ha, pa, qa, 2) EG_STEP(hb2, pb, qb, 1) EG_LOAD(hb2, pb, qb, 3) EG_STEP(ha, pa, qa, 2) EG_LOAD(ha, pa, qa, 4) EG_STEP(hb2, pb, qb, 3)
        EG_LOAD(hb2, pb, qb, 5) EG_STEP(ha, pa, qa, 4) EG_LOAD(ha, pa, qa, 6) EG_STEP(hb2, pb, qb, 5) EG_LOAD(hb2, pb, qb, 7) EG_STEP(ha, pa, qa, 6) EG_STEP(hb2, pb, qb, 7)
#undef EG_LOAD
#undef EG_STEP
    }
};

template <class Epi, class Sched, bool ALIGN_EPI = false, bool SP2 = false>
__device__ __forceinline__ void gemm_phase(PG8_LAS unsigned char* lds, const Gemm g, const Sched& S, const Epi& E) {
    int tid_o = TIDX_(g.wid); asm volatile("" : "+v"(tid_o));
    const int tid = tid_o, wid = __builtin_amdgcn_readfirstlane(tid >> 6), lane = tid & 63, wr = wid >> 2, wc = wid & 3, fr = lane & 15, fq = lane >> 4;
    const int K = g.K, nt = K / BK;
    unsigned voffA[2], voffB[2];
#pragma unroll
    for (int i = 0; i < 2; ++i) { int R, C; stage_rc(tid * 16 + i * 8192, R, C); const int Rb = Epi::PERM ? ((R & ~31) + perm32(R & 31)) : R;
        voffA[i] = (unsigned)(R * g.lda + C) * 2u; voffB[i] = (unsigned)(Rb * K + C) * 2u; }
    const size_t kstep = (size_t)(BK * 2);
    const size_t hstep = (size_t)HALF * K * 2;
    const size_t tstep = 2 * hstep;
    const size_t hstepA = (size_t)HALF * g.lda * 2, tstepA = 2 * hstepA;
    const unsigned ldsw = (unsigned)wid * 1024u;
    const int aoff = lds_byte(wr * 64 + fr, fq * 8), boff = lds_byte(wc * 32 + fr, fq * 8);
#define PG8_SA(b, h) (((b) * 2 + (h)) * HTB)
#define PG8_SB(b, h) ((4 + (b) * 2 + (h)) * HTB)
#define PG8_STAGE(bufoff, gbase, voff) do { _Pragma("unroll") for (int _i = 0; _i < 2; ++_i) \
        __builtin_amdgcn_global_load_lds((const unsigned*)((const char*)(gbase) + (voff)[_i]), (PG8_LAS unsigned*)(lds + (bufoff) + ldsw + _i * 8192), 16, 0, 0); } while (0)
#define PG8_LDA(dst, b, h) do { _Pragma("unroll") for (int m = 0; m < 4; ++m) _Pragma("unroll") for (int k = 0; k < 2; ++k) dst[m][k] = *(const PG8_LAS bf16x8*)(lds + PG8_SA(b, h) + aoff + m * 2048 + k * 1024); } while (0)
#define PG8_LDB(dst, b, h) do { _Pragma("unroll") for (int n = 0; n < 2; ++n) _Pragma("unroll") for (int k = 0; k < 2; ++k) dst[n][k] = *(const PG8_LAS bf16x8*)(lds + PG8_SB(b, h) + boff + n * 2048 + k * 1024); } while (0)
#define PG8_MMA(ai, bj, At, Bt) do { __builtin_amdgcn_s_setprio(1); _Pragma("unroll") for (int m = 0; m < 4; ++m) _Pragma("unroll") for (int n = 0; n < 2; ++n) _Pragma("unroll") for (int k = 0; k < 2; ++k) \
        acc[ai][bj][m][n] = __builtin_amdgcn_mfma_f32_16x16x32_bf16(Bt[n][k], At[m][k], acc[ai][bj][m][n], 0, 0, 0); __builtin_amdgcn_s_setprio(0); } while (0)
#define PG8_WAIT_V(n) asm volatile("s_waitcnt vmcnt(" #n ")" ::: "memory")
#define PG8_WAIT_L(n) asm volatile("s_waitcnt lgkmcnt(" #n ")" ::: "memory")
#define PG8_BAR __builtin_amdgcn_s_barrier()
#define PG8_SCHED __builtin_amdgcn_sched_barrier(0)
    Unit cur, nxt; int ui = 0;
    if (!S.next(0, cur)) return;
    f32x4 acc[2][2][4][2];
#pragma unroll
    for (int a = 0; a < 2; ++a)
#pragma unroll
        for (int b = 0; b < 2; ++b)
#pragma unroll
            for (int m = 0; m < 4; ++m)
#pragma unroll
                for (int n = 0; n < 2; ++n) acc[a][b][m][n] = (f32x4){0.f, 0.f, 0.f, 0.f};
    bf16x8 At[4][2], B0[2][2], B1[2][2];
    const char* cA = (const char*)g.A + (size_t)cur.pm * tstepA; const char* cB = (const char*)g.Bt + (size_t)cur.pn * tstep;
    S.a_ready(cur);
    if constexpr (SP2) {
        PG8_STAGE(PG8_SB(0, 0), cB, voffB); PG8_STAGE(PG8_SB(0, 1), cB + hstep, voffB); PG8_STAGE(PG8_SA(0, 0), cA, voffA); PG8_STAGE(PG8_SA(0, 1), cA + hstepA, voffA);
        if (wr == 1) PG8_BAR;
        PG8_WAIT_V(2); PG8_BAR;
        PG8_STAGE(PG8_SB(1, 0), cB + kstep, voffB); PG8_STAGE(PG8_SA(1, 0), cA + kstep, voffA); PG8_STAGE(PG8_SB(1, 1), cB + hstep + kstep, voffB);
        PG8_WAIT_V(6); PG8_BAR;
    } else {
        PG8_STAGE(PG8_SB(0, 0), cB, voffB); PG8_STAGE(PG8_SA(0, 0), cA, voffA); PG8_STAGE(PG8_SB(0, 1), cB + hstep, voffB); PG8_STAGE(PG8_SA(0, 1), cA + hstepA, voffA);
        if (wr == 1) PG8_BAR;
        PG8_WAIT_V(4); PG8_BAR;
        PG8_STAGE(PG8_SB(1, 0), cB + kstep, voffB); PG8_STAGE(PG8_SA(1, 0), cA + kstep, voffA); PG8_STAGE(PG8_SB(1, 1), cB + hstep + kstep, voffB);
        PG8_WAIT_V(6); PG8_BAR;
    }
    for (;;) {
        const bool has_next = S.next(ui + 1, nxt);
        const char* nA = has_next ? (const char*)g.A + (size_t)nxt.pm * tstepA : cA; const char* nB = has_next ? (const char*)g.Bt + (size_t)nxt.pn * tstep : cB;
#pragma unroll 1
        for (int t = 0; t < nt; t += 2) {
            const bool last = (t == nt - 2);
            const char* a1 = cA + (size_t)(t + 1) * kstep;
            const char* a2 = last ? nA : cA + (size_t)(t + 2) * kstep; const char* b2 = last ? nB : cB + (size_t)(t + 2) * kstep;
            const char* a3 = a2 + kstep; const char* b3 = b2 + kstep;
            if (last && has_next) S.a_ready(nxt);
            if constexpr (SP2) {
            PG8_LDB(B0, 0, 0); PG8_LDB(B1, 0, 1); PG8_SCHED; PG8_LDA(At, 0, 0); PG8_STAGE(PG8_SA(1, 1), a1 + hstepA, voffA);
            PG8_WAIT_V(8); PG8_WAIT_L(0); PG8_BAR; PG8_MMA(0, 0, At, B0); PG8_MMA(0, 1, At, B1); PG8_BAR; PG8_SCHED;
            PG8_LDA(At, 0, 1); PG8_STAGE(PG8_SB(0, 0), b2, voffB); PG8_STAGE(PG8_SB(0, 1), b2 + hstep, voffB); PG8_STAGE(PG8_SA(0, 0), a2, voffA);
            PG8_WAIT_V(8); PG8_WAIT_L(0); PG8_BAR; PG8_MMA(1, 0, At, B0); PG8_MMA(1, 1, At, B1); PG8_BAR; PG8_SCHED;
            PG8_LDB(B0, 1, 0); PG8_LDB(B1, 1, 1); PG8_SCHED; PG8_LDA(At, 1, 0); PG8_STAGE(PG8_SA(0, 1), a2 + hstepA, voffA);
            PG8_WAIT_V(8); PG8_WAIT_L(0); PG8_BAR; PG8_MMA(0, 0, At, B0); PG8_MMA(0, 1, At, B1); PG8_BAR; PG8_SCHED;
            PG8_LDA(At, 1, 1); PG8_STAGE(PG8_SB(1, 0), b3, voffB); PG8_STAGE(PG8_SB(1, 1), b3 + hstep, voffB); PG8_STAGE(PG8_SA(1, 0), a3, voffA);
            PG8_WAIT_V(8); PG8_WAIT_L(0); PG8_BAR; PG8_MMA(1, 0, At, B0); PG8_MMA(1, 1, At, B1); PG8_BAR; PG8_SCHED;
            } else {
            PG8_LDB(B0, 0, 0); PG8_SCHED; PG8_LDA(At, 0, 0); PG8_STAGE(PG8_SA(1, 1), a1 + hstepA, voffA);
            PG8_WAIT_L(8); PG8_BAR; PG8_WAIT_L(0); PG8_MMA(0, 0, At, B0); PG8_BAR; PG8_SCHED;
            PG8_LDB(B1, 0, 1); PG8_STAGE(PG8_SB(0, 0), b2, voffB);
            PG8_BAR; PG8_WAIT_L(0); PG8_MMA(0, 1, At, B1); PG8_BAR;
            PG8_LDA(At, 0, 1); PG8_STAGE(PG8_SA(0, 0), a2, voffA);
            PG8_BAR; PG8_WAIT_L(0); PG8_MMA(1, 0, At, B0); PG8_BAR; PG8_SCHED;
            PG8_STAGE(PG8_SB(0, 1), b2 + hstep, voffB);
            PG8_WAIT_V(6); PG8_BAR; PG8_MMA(1, 1, At, B1); PG8_BAR;
            PG8_LDB(B0, 1, 0); PG8_SCHED; PG8_LDA(At, 1, 0); PG8_STAGE(PG8_SA(0, 1), a2 + hstepA, voffA);
            PG8_WAIT_L(8); PG8_BAR; PG8_WAIT_L(0); PG8_MMA(0, 0, At, B0); PG8_BAR; PG8_SCHED;
            PG8_LDB(B1, 1, 1); PG8_STAGE(PG8_SB(1, 0), b3, voffB);
            PG8_BAR; PG8_WAIT_L(0); PG8_MMA(0, 1, At, B1); PG8_BAR;
            PG8_LDA(At, 1, 1); PG8_STAGE(PG8_SA(1, 0), a3, voffA);
            PG8_BAR; PG8_WAIT_L(0); PG8_MMA(1, 0, At, B0); PG8_BAR; PG8_SCHED;
            PG8_STAGE(PG8_SB(1, 1), b3 + hstep, voffB);
            PG8_WAIT_V(6); PG8_BAR; PG8_MMA(1, 1, At, B1); PG8_BAR;
            }
        }
        if constexpr (ALIGN_EPI) { if (wr == 0) PG8_BAR; }
        if constexpr (!Epi::AFTER_DRAIN) { E(acc, cur, wr, wc, fr, fq); S.done(cur); }
        if (!has_next) break;
#pragma unroll
        for (int a = 0; a < 2; ++a)
#pragma unroll
            for (int b = 0; b < 2; ++b)
#pragma unroll
                for (int m = 0; m < 4; ++m)
#pragma unroll
                    for (int n = 0; n < 2; ++n) acc[a][b][m][n] = (f32x4){0.f, 0.f, 0.f, 0.f};
        cur = nxt; cA = nA; cB = nB; ++ui;
        if constexpr (ALIGN_EPI) { if (wr == 1) PG8_BAR; }
    }
    PG8_WAIT_V(0);
    if constexpr (!ALIGN_EPI) { if (wr == 0) PG8_BAR; }
    PG8_BAR;
    if constexpr (Epi::AFTER_DRAIN) { E.fused(acc, cur, wr, wc, fr, fq, lds, wid, lane); S.done(cur); }
#undef PG8_SA
#undef PG8_SB
#undef PG8_STAGE
#undef PG8_LDA
#undef PG8_LDB
#undef PG8_MMA
#undef PG8_WAIT_V
#undef PG8_WAIT_L
#undef PG8_BAR
#undef PG8_SCHED
}
}
#define XB_TMO      128
#define XB_XCNT(j)  (256  + 64 * (j))
#define XB_XSUB(j)  (1280 + 64 * (j))
#define XB_XGEN(j)  (2304 + 64 * (j))
#define XB_TOP      3328
#define XB_TOPGEN   3392
#define XCD_BAR_WORDS 3456
#define XB_SPIN_CAP (1u << 18)
#define LAS __attribute__((address_space(3)))

__device__ __forceinline__ unsigned xb_ld(unsigned* p)              { return __hip_atomic_load(p, __ATOMIC_RELAXED, __HIP_MEMORY_SCOPE_AGENT); }
__device__ __forceinline__ unsigned xb_add(unsigned* p, unsigned v) { return __hip_atomic_fetch_add(p, v, __ATOMIC_RELAXED, __HIP_MEMORY_SCOPE_AGENT); }
__device__ __forceinline__ unsigned xb_xcc_id() { return (unsigned)__builtin_amdgcn_s_getreg((3 << 11) | 20) & 0xFu; }
#define XB_SPIN(cond, bar) do { unsigned _sp = 0; while (cond) { __builtin_amdgcn_s_sleep(1); \
    if ((++_sp & 255u) == 0u) { if (xb_ld(&(bar)[XB_TMO])) break; if (_sp > XB_SPIN_CAP) { atomicAdd(&(bar)[XB_TMO], 1u); break; } } } } while (0)

struct XcdBarrier {
    int wid; unsigned* bar; unsigned x;
    volatile LAS unsigned* st;
};

__device__ __forceinline__ XcdBarrier xcd_barrier_post(unsigned* bar, volatile LAS unsigned* st, int wid) {
    XcdBarrier b; b.wid = wid; b.bar = bar; b.x = xb_xcc_id(); b.st = st;
    if (TIDX_(wid) == 0) (void)xb_add(&bar[XB_XCNT(b.x)], 1u);
    return b;
}
__device__ __forceinline__ void xcd_barrier_complete(unsigned* bar, unsigned x, unsigned& nloc, unsigned& nx) {
    const unsigned G = gridDim.x * gridDim.y * gridDim.z;
    unsigned sum, cnt, mine, sp = 0u;
    for (;;) {
        sum = 0u; cnt = 0u; mine = 0u;
#pragma unroll
        for (unsigned j = 0; j < 16; ++j) { const unsigned c = xb_ld(&bar[XB_XCNT(j)]); sum += c; cnt += (c > 0u) ? 1u : 0u; mine = (j == x) ? c : mine; }
        if (sum == G) break;
        __builtin_amdgcn_s_sleep(1);
        if ((++sp & 255u) == 0u) { if (xb_ld(&bar[XB_TMO])) break; if (sp > XB_SPIN_CAP) { atomicAdd(&bar[XB_TMO], 1u); break; } }
    }
    nloc = mine > 0u ? mine : 1u; nx = cnt > 0u ? cnt : 1u;
}

__device__ __forceinline__ void xcd_barrier(const XcdBarrier& b) {
    asm volatile("s_waitcnt vmcnt(0)" ::: "memory");
    __syncthreads();
    if (TIDX_(b.wid) == 0) {
        unsigned* bar = b.bar;
        __builtin_amdgcn_s_waitcnt(0);
        unsigned nloc = b.st[0], nx = b.st[1];
        if (nloc == 0u) { xcd_barrier_complete(bar, b.x, nloc, nx); b.st[0] = nloc; b.st[1] = nx; }
        const unsigned old = xb_add(&bar[XB_XSUB(b.x)], 1u);
        const unsigned gen = old / nloc;
        if (old + 1u == (gen + 1u) * nloc) {
            __builtin_amdgcn_fence(__ATOMIC_RELEASE, "agent");
            asm volatile("s_waitcnt vmcnt(0)" ::: "memory");
            const unsigned og = xb_add(&bar[XB_TOP], 1u);
            const unsigned tg = og / nx;
            if (og + 1u == (tg + 1u) * nx) xb_add(&bar[XB_TOPGEN], 1u);
            else XB_SPIN(xb_ld(&bar[XB_TOPGEN]) == tg, bar);
            __builtin_amdgcn_fence(__ATOMIC_ACQUIRE, "agent");
            xb_add(&bar[XB_XGEN(b.x)], 1u);
            asm volatile("s_waitcnt vmcnt(0)" ::: "memory");
        } else {
            XB_SPIN(xb_ld(&bar[XB_XGEN(b.x)]) == gen, bar);
            __builtin_amdgcn_fence(__ATOMIC_ACQUIRE, "agent");
            asm volatile("s_waitcnt vmcnt(0)" ::: "memory");
        }
    }
    __syncthreads();
}

using namespace pg8;

struct Params {
    const float *x_prompt, *x_sample, *state_rwkv, *state_shift, *cache_k, *cache_v, *p_prompt, *p_sample, *g_norm, *w_in, *mu, *w0, *w_dec2, *a0, *w_a2,
        *k_k, *k_a, *r_k, *lnx_w, *lnx_b, *q_norm_w, *k_norm_w, *sinks, *w_out, *g_ple, *w_ple_gate, *w_ple_proj;
    float *y_all, *o_state_p, *o_state_s, *o_shift_p, *o_shift_s, *o_ck_p, *o_ck_s, *o_cv_p, *o_cv_s;
    unsigned* bar;
    bf16_t *Wt_in, *Wt_out, *Wt_gate, *Wt_ple, *H, *XB, *Rr, *Re, *Rk, *Rv, *Rkk, *Reta, *PB, *PLE, *HB, *SA_G1, *SA_PC, *SA_QT, *SA_YL, *YR, *WLd, *WLa, *PLS;
    float *rstd_x, *part, *rk, *SA_GC;
    int wid;
};

__device__ __forceinline__ void p0_prologue(const Params& P, unsigned char* lds) {
    int tid_o = TIDX_(P.wid); asm volatile("" : "+v"(tid_o)); const int tid = tid_o, lane = tid & 63, wave = tid >> 6;
    float* tile = (float*)lds;
#define P0_DECODE(it_) const float* src; const float* scale; bf16_t* dst; int K, N, kt, nt; { int r = (it_); \
        if (r < 864) { src = P.w_in; scale = P.g_norm; dst = P.Wt_in; K = DM; N = DIN; kt = r / 54; nt = r % 54; } \
        else if ((r -= 864) < 256) { src = P.w_out; scale = nullptr; dst = P.Wt_out; K = DM; N = DM; kt = r >> 4; nt = r & 15; } \
        else if ((r -= 256) < 256) { src = P.w_ple_gate; scale = P.g_ple; dst = P.Wt_gate; K = DM; N = DM; kt = r >> 4; nt = r & 15; } \
        else { r -= 256; src = P.w_ple_proj; scale = nullptr; dst = P.Wt_ple; K = 256; N = DM; kt = r >> 4; nt = r & 15; } } \
        const int k0 = kt * 64, n0 = nt * 64, tx = tid & 63, ty = tid >> 6;
    float pv[8];
    if ((int)blockIdx.x < 1440) { P0_DECODE(blockIdx.x)
#pragma unroll
        for (int i = 0; i < 8; ++i) { const int k = ty + 8 * i; float v = src[(size_t)(k0 + k) * N + n0 + tx]; if (scale) v *= scale[k0 + k]; pv[i] = v; } }
    for (int it = blockIdx.x; it < 1440; it += gridDim.x) {
        P0_DECODE(it)
        __syncthreads();
#pragma unroll
        for (int i = 0; i < 8; ++i) tile[(ty + 8 * i) * 65 + tx] = pv[i];
        if (it + (int)gridDim.x < 1440) { const int k0c = k0; (void)k0c;
            { P0_DECODE(it + gridDim.x)
#pragma unroll
              for (int i = 0; i < 8; ++i) { const int k = ty + 8 * i; float v = src[(size_t)(k0 + k) * N + n0 + tx]; if (scale) v *= scale[k0 + k]; pv[i] = v; } } }
        __syncthreads();
        const int n = tid >> 3, kq = tid & 7;
        u32x4 w;
        w.x = pack2(tile[(kq * 8 + 0) * 65 + n], tile[(kq * 8 + 1) * 65 + n]); w.y = pack2(tile[(kq * 8 + 2) * 65 + n], tile[(kq * 8 + 3) * 65 + n]);
        w.z = pack2(tile[(kq * 8 + 4) * 65 + n], tile[(kq * 8 + 5) * 65 + n]); w.w = pack2(tile[(kq * 8 + 6) * 65 + n], tile[(kq * 8 + 7) * 65 + n]);
        *(u32x4*)(dst + (size_t)(n0 + n) * K + k0 + kq * 8) = w;
    }
#undef P0_DECODE
    for (int i = blockIdx.x * NTHR + tid; i < 2 * 8 * 64 * 8; i += gridDim.x * NTHR) {
        const int which = i >> 12, r = i & 4095, hh = r >> 9, ch = (r >> 3) & 63, jc = r & 7;
        const float* src = (which ? P.w_a2 : P.w_dec2) + hh * 64 + ch;
        u32x4 wv; wv.x = pack2(src[(8 * jc + 0) * 512], src[(8 * jc + 1) * 512]); wv.y = pack2(src[(8 * jc + 2) * 512], src[(8 * jc + 3) * 512]);
        wv.z = pack2(src[(8 * jc + 4) * 512], src[(8 * jc + 5) * 512]); wv.w = pack2(src[(8 * jc + 6) * 512], src[(8 * jc + 7) * 512]);
        *(u32x4*)((which ? P.WLa : P.WLd) + (size_t)hh * 4096 + ch * 64 + jc * 8) = wv;
    }
    for (int i = blockIdx.x * NTHR + tid; i < (DINP - DIN) * DM / 8; i += gridDim.x * NTHR) *(u32x4*)(P.Wt_in + (size_t)DIN * DM + (size_t)i * 8) = (u32x4){0u, 0u, 0u, 0u};
    for (int row0 = blockIdx.x * 8 + wave; row0 < MT; row0 += gridDim.x * 8 * 4) {
        f32x4 v[4][4];
#pragma unroll
        for (int q = 0; q < 4; ++q) { const int row = row0 + q * gridDim.x * 8;
            if (row < MT) { const float* src = row < MP ? P.x_prompt + (size_t)row * DM : P.x_sample + (size_t)(row - MP) * DM;
#pragma unroll
                for (int i = 0; i < 4; ++i) v[q][i] = *(const f32x4*)(src + (lane + 64 * i) * 4); } }
#pragma unroll
        for (int q = 0; q < 4; ++q) { const int row = row0 + q * gridDim.x * 8;
            if (row < MT) { float ss = 0.f;
#pragma unroll
                for (int i = 0; i < 4; ++i) { const f32x4 x = v[q][i]; ss += (x[0] * x[0] + x[1] * x[1]) + (x[2] * x[2] + x[3] * x[3]); }
                ss = wave_sum(ss);
                const float ms = ss * (1.0f / DM) + 1e-6f, rs = rsqrtf(ms);
#pragma unroll
                for (int i = 0; i < 4; ++i) { const f32x4 x = v[q][i] * rs;
                    *(uint2*)(P.XB + (size_t)row * DM + (lane + 64 * i) * 4) = make_uint2(pack2(x[0], x[1]), pack2(x[2], x[3])); }
                if (lane == 0) P.rstd_x[row] = sqrtf(ms); } }
    }
    for (size_t i = (size_t)blockIdx.x * NTHR + tid; i < (size_t)MT * 64; i += (size_t)gridDim.x * NTHR * 4) {
        f32x4 v[4];
#pragma unroll
        for (int q = 0; q < 4; ++q) { const size_t e = (i + (size_t)q * gridDim.x * NTHR) * 4; if (e < (size_t)MT * 256) v[q] = *(const f32x4*)(e < (size_t)MP * 256 ? P.p_prompt + e : P.p_sample + (e - (size_t)MP * 256)); }
#pragma unroll
        for (int q = 0; q < 4; ++q) { const size_t e = (i + (size_t)q * gridDim.x * NTHR) * 4; if (e < (size_t)MT * 256) *(uint2*)(P.PB + e) = make_uint2(pack2(v[q][0], v[q][1]), pack2(v[q][2], v[q][3])); }
    }

}


#define PR_ROWB 3344
#define PR_FS 0
#define PR_AT (18 * PR_ROWB)
#define PR_CONST (PR_AT + 4096)
__device__ __forceinline__ void p2_rwkv_prep(const Params& P, unsigned char* lds) {
    int tid_o = TIDX_(P.wid); asm volatile("" : "+v"(tid_o)); const int tid = tid_o, lane = tid & 63, h = tid >> 6;
    const bf16_t* H = P.H;
    float* cst = (float*)(lds + PR_CONST);
    __syncthreads();
    { cst[tid] = P.w0[tid]; cst[512 + tid] = P.a0[tid]; cst[1024 + tid] = P.mu[tid]; cst[1536 + tid] = P.mu[512 + tid]; cst[2048 + tid] = P.mu[1024 + tid];
      cst[2560 + tid] = P.k_k[tid]; cst[3072 + tid] = P.k_a[tid]; cst[3584 + tid] = P.r_k[tid]; }
    bf16x8 wdf[4][2], waf[4][2];
#pragma unroll
    for (int n = 0; n < 4; ++n)
#pragma unroll
        for (int s = 0; s < 2; ++s) {
            const int ch = h * 64 + 16 * n + (lane & 15), j0 = 32 * s + 8 * (lane >> 4);
            u32x4 a, b;
#pragma unroll
            for (int q = 0; q < 4; ++q) {
                a[q] = pack2(P.w_dec2[(j0 + 2 * q) * 512 + ch], P.w_dec2[(j0 + 2 * q + 1) * 512 + ch]);
                b[q] = pack2(P.w_a2[(j0 + 2 * q) * 512 + ch], P.w_a2[(j0 + 2 * q + 1) * 512 + ch]);
            }
            wdf[n][s] = __builtin_bit_cast(bf16x8, a); waf[n][s] = __builtin_bit_cast(bf16x8, b);
        }
    const int atok = tid >> 5, aj = (tid & 31) * 4;
    float amu[4];
#pragma unroll
    for (int q = 0; q < 4; ++q) amu[q] = P.mu[1536 + aj + q];
#define PR_FILL(unit) { const int r0_ = (unit) * 16; const bool smp_ = r0_ >= MP; int tid_ = tid; asm volatile("" : "+v"(tid_)); \
        _Pragma("unroll") for (int hb = 0; hb < 2; ++hb) { u32x4 pre[4]; \
        _Pragma("unroll") for (int i = 0; i < 4; ++i) { const int id = tid_ + NTHR * (hb * 4 + i); const int row = id / 208, cc = id - row * 208; u32x4 v = (u32x4){0u, 0u, 0u, 0u}; \
            if (row >= 1 && row <= 16) v = *(const u32x4*)(H + (size_t)(r0_ + row - 1) * DIN + cc * 8); \
            else if (row == 0 && !smp_) { if ((r0_ & (TP - 1)) != 0) v = *(const u32x4*)(H + (size_t)(r0_ - 1) * DIN + cc * 8); } \
            else if (row < 18 && smp_) { const float* sp = P.state_shift + (size_t)(((r0_ - MP) >> 3) + (row == 17 ? 1 : 0)) * DSH + cc * 8; \
                const f32x4 s0 = *(const f32x4*)sp, s1 = *(const f32x4*)(sp + 4); v.x = pack2(s0[0], s0[1]); v.y = pack2(s0[2], s0[3]); v.z = pack2(s1[0], s1[1]); v.w = pack2(s1[2], s1[3]); } \
            pre[i] = v; } \
        _Pragma("unroll") for (int i = 0; i < 4; ++i) { const int id = tid_ + NTHR * (hb * 4 + i); const int row = id / 208, cc = id - row * 208; if (id < 18 * 208) *(u32x4*)(lds + PR_FS + row * PR_ROWB + cc * 16) = pre[i]; } \
        asm volatile("" ::: "memory"); } }
    int unit = MP / 16 + blockIdx.x;
    if (unit < MT / 16) { PR_FILL(unit); }
    __syncthreads();
    for (; unit < MT / 16; unit += gridDim.x) {
        const int r0 = unit * 16; const bool smp = r0 >= MP;
        const int nxt = unit + gridDim.x;
        {
            const int prow = (smp && atok == 8) ? 17 : atok;
            const uint2 fc = *(const uint2*)(lds + PR_FS + (atok + 1) * PR_ROWB + (1536 + aj) * 2), fp = *(const uint2*)(lds + PR_FS + prow * PR_ROWB + (1536 + aj) * 2);
            float x[4];
            x[0] = bflo(fc.x) + (bflo(fp.x) - bflo(fc.x)) * amu[0]; x[1] = bfhi(fc.x) + (bfhi(fp.x) - bfhi(fc.x)) * amu[1];
            x[2] = bflo(fc.y) + (bflo(fp.y) - bflo(fc.y)) * amu[2]; x[3] = bfhi(fc.y) + (bfhi(fp.y) - bfhi(fc.y)) * amu[3];
            if (aj < 64) {
#pragma unroll
                for (int q = 0; q < 4; ++q) x[q] = 1.0f - 2.0f * frcp_(1.0f + fexp2_(2.88539008f * x[q]));
            }
            *(uint2*)(lds + PR_AT + (aj < 64 ? 0 : 2048) + atok * 128 + (aj & 63) * 2) = make_uint2(pack2(x[0], x[1]), pack2(x[2], x[3]));
        }
        __syncthreads();
        f32x4 accw[4], acca[4];
        {
            bf16x8 tf[2], af[2];
#pragma unroll
            for (int s = 0; s < 2; ++s) {
                tf[s] = *(const bf16x8*)(lds + PR_AT + (lane & 15) * 128 + (32 * s + 8 * (lane >> 4)) * 2);
                af[s] = *(const bf16x8*)(lds + PR_AT + 2048 + (lane & 15) * 128 + (32 * s + 8 * (lane >> 4)) * 2);
            }
#pragma unroll
            for (int n = 0; n < 4; ++n) {
                f32x4 cw = (f32x4){0.f, 0.f, 0.f, 0.f}, ca = (f32x4){0.f, 0.f, 0.f, 0.f};
#pragma unroll
                for (int s = 0; s < 2; ++s) {
                    cw = __builtin_amdgcn_mfma_f32_16x16x32_bf16(wdf[n][s], tf[s], cw, 0, 0, 0);
                    ca = __builtin_amdgcn_mfma_f32_16x16x32_bf16(waf[n][s], af[s], ca, 0, 0, 0);
                }
                accw[n] = cw; acca[n] = ca;
            }
        }
        const int tok = lane & 15, row = r0 + tok;
        const int prow = (smp && tok == 8) ? 17 : tok;
        const unsigned char* fcur = lds + PR_FS + (tok + 1) * PR_ROWB;
        const unsigned char* fprv = lds + PR_FS + prow * PR_ROWB;
        float ss = 0.f, rks = 0.f;
#pragma unroll
        for (int n = 0; n < 4; ++n) {
            const int c0 = h * 64 + 16 * n + 4 * (lane >> 4);
            const f32x4 cmk = *(const f32x4*)(cst + 1536 + c0), ckk = *(const f32x4*)(cst + 2560 + c0);
            const uint2 kc = *(const uint2*)(fcur + (512 + c0) * 2), kp = *(const uint2*)(fprv + (512 + c0) * 2);
            const float fk[4] = {bflo(kc.x), bfhi(kc.x), bflo(kc.y), bfhi(kc.y)}, pk[4] = {bflo(kp.x), bfhi(kp.x), bflo(kp.y), bfhi(kp.y)};
#pragma unroll
            for (int q = 0; q < 4; ++q) { const float kk = (fk[q] + (pk[q] - fk[q]) * cmk[q]) * ckk[q]; ss += kk * kk; }
        }
        asm volatile("" ::: "memory"); __builtin_amdgcn_sched_barrier(0);
        ss += __shfl_xor(ss, 16); ss += __shfl_xor(ss, 32);
        const float kn = rsqrtf(fmaxf(ss, 1e-24f));
#pragma unroll
        for (int n = 0; n < 4; ++n) {
            const int c0 = h * 64 + 16 * n + 4 * (lane >> 4);
            const f32x4 cw0 = *(const f32x4*)(cst + c0), ca0 = *(const f32x4*)(cst + 512 + c0), cmr = *(const f32x4*)(cst + 1024 + c0), cmk = *(const f32x4*)(cst + 1536 + c0);
            const f32x4 cmv = *(const f32x4*)(cst + 2048 + c0), ckk = *(const f32x4*)(cst + 2560 + c0), cka = *(const f32x4*)(cst + 3072 + c0), crk = *(const f32x4*)(cst + 3584 + c0);
            const uint2 rc = *(const uint2*)(fcur + c0 * 2), rp = *(const uint2*)(fprv + c0 * 2);
            const uint2 kc = *(const uint2*)(fcur + (512 + c0) * 2), kp = *(const uint2*)(fprv + (512 + c0) * 2);
            const uint2 vc = *(const uint2*)(fcur + (1024 + c0) * 2), vp = *(const uint2*)(fprv + (1024 + c0) * 2);
            const float fr[4] = {bflo(rc.x), bfhi(rc.x), bflo(rc.y), bfhi(rc.y)}, pr[4] = {bflo(rp.x), bfhi(rp.x), bflo(rp.y), bfhi(rp.y)};
            const float fk[4] = {bflo(kc.x), bfhi(kc.x), bflo(kc.y), bfhi(kc.y)}, pk[4] = {bflo(kp.x), bfhi(kp.x), bflo(kp.y), bfhi(kp.y)};
            const float fv[4] = {bflo(vc.x), bfhi(vc.x), bflo(vc.y), bfhi(vc.y)}, pv[4] = {bflo(vp.x), bfhi(vp.x), bflo(vp.y), bfhi(vp.y)};
            float r[4], k2[4], v[4], e2[4], eta[4], kk[4];
#pragma unroll
            for (int q = 0; q < 4; ++q) {
                r[q] = fr[q] + (pr[q] - fr[q]) * cmr[q];
                const float k = fk[q] + (pk[q] - fk[q]) * cmk[q];
                v[q] = fv[q] + (pv[q] - fv[q]) * cmv[q];
                e2[q] = 0.87506123f * sigmoidf_(accw[n][q] + cw0[q]);
                eta[q] = sigmoidf_(acca[n][q] + ca0[q]);
                kk[q] = k * ckk[q] * kn;
                k2[q] = k * (1.0f + (eta[q] - 1.0f) * cka[q]);
                rks += r[q] * k2[q] * crk[q];
            }
            const size_t o = (size_t)row * 512 + c0;
            *(uint2*)(P.Rr + o) = make_uint2(pack2(r[0], r[1]), pack2(r[2], r[3])); *(uint2*)(P.Re + o) = make_uint2(pack2(e2[0], e2[1]), pack2(e2[2], e2[3]));
            *(uint2*)(P.Rk + o) = make_uint2(pack2(k2[0], k2[1]), pack2(k2[2], k2[3])); *(uint2*)(P.Rv + o) = make_uint2(pack2(v[0], v[1]), pack2(v[2], v[3]));
            *(uint2*)(P.Rkk + o) = make_uint2(pack2(kk[0], kk[1]), pack2(kk[2], kk[3])); *(uint2*)(P.Reta + o) = make_uint2(pack2(eta[0], eta[1]), pack2(eta[2], eta[3]));
            asm volatile("" ::: "memory"); __builtin_amdgcn_sched_barrier(0);
        }
        rks += __shfl_xor(rks, 16); rks += __shfl_xor(rks, 32);
        if ((lane >> 4) == 0) P.rk[(size_t)row * 8 + h] = rks;
        if (!smp) { if (((r0 + 15) & (TP - 1)) == TP - 1) { float* dst = P.o_shift_p + (size_t)(r0 >> 12) * DSH; for (int col = tid; col < DSH; col += NTHR) dst[col] = bf2f(*(const bf16_t*)(lds + PR_FS + 16 * PR_ROWB + col * 2)); } }
        else { const int b0 = (r0 - MP) >> 3;
            for (int col = tid; col < 2 * DSH; col += NTHR) { const int which = col >= DSH, cc = col - which * DSH; P.o_shift_s[(size_t)(b0 + which) * DSH + cc] = bf2f(*(const bf16_t*)(lds + PR_FS + (which ? 16 : 8) * PR_ROWB + cc * 2)); } }
        __syncthreads();
        if (nxt < MT / 16) { PR_FILL(nxt); }
        __syncthreads();
    }
#undef PR_FILL
    if (blockIdx.x < 8) { const bf16_t* hr = H + (size_t)(blockIdx.x * TP + TP - 1) * DIN; for (int col = tid; col < DSH; col += NTHR) P.o_shift_p[(size_t)blockIdx.x * DSH + col] = bf2f(hr[col]); }
}
template <int CTRL> __device__ __forceinline__ float dpp_qp(float x) {
    return __builtin_bit_cast(float, __builtin_amdgcn_update_dpp(0, __builtin_bit_cast(int, x), CTRL, 0xF, 0xF, false));
}
__device__ __forceinline__ float oct_allsum(float x) {
    x += dpp_qp<0xB1>(x);
    x += dpp_qp<0x4E>(x);
    x += dpp_qp<0x141>(x);
    return x;
}
__device__ __forceinline__ void p4_post(const Params& P) {
    int tid_o = TIDX_(P.wid); asm volatile("" : "+v"(tid_o)); const int tid = tid_o, lane = tid & 63, wave = tid >> 6;
    float lw[8], lb[8];
#pragma unroll
    for (int j = 0; j < 8; ++j) { lw[j] = P.lnx_w[lane * 8 + j]; lb[j] = P.lnx_b[lane * 8 + j]; }
    const int NW = gridDim.x * 8, gw = blockIdx.x * 8 + wave;
    for (int row0 = gw; row0 < MT; row0 += NW * 4) {
        u32x4 yv[4], vv[4], zv[4]; float rkv[4];
#pragma unroll
        for (int q = 0; q < 4; ++q) {
            const int row = row0 + q * NW;
            if (row < MT) {
                yv[q] = *(const u32x4*)(P.YR + (size_t)row * 512 + lane * 8);
                vv[q] = *(const u32x4*)(P.Rv + (size_t)row * 512 + lane * 8);
                zv[q] = *(const u32x4*)(P.H + (size_t)row * DIN + OFF_ZR + lane * 8);
                rkv[q] = P.rk[(size_t)row * 8 + (lane >> 3)];
            }
        }
#pragma unroll
        for (int q = 0; q < 4; ++q) {
            const int row = row0 + q * NW;
            if (row < MT) {
                float y[8], v[8], z[8];
#pragma unroll
                for (int j = 0; j < 4; ++j) { y[2 * j] = bflo(yv[q][j]); y[2 * j + 1] = bfhi(yv[q][j]); v[2 * j] = bflo(vv[q][j]); v[2 * j + 1] = bfhi(vv[q][j]); z[2 * j] = bflo(zv[q][j]); z[2 * j + 1] = bfhi(zv[q][j]); }
                float s = ((y[0] + y[1]) + (y[2] + y[3])) + ((y[4] + y[5]) + (y[6] + y[7]));
                const float mean = oct_allsum(s) * (1.0f / 64.0f);
                float d[8]; float s2 = 0.f;
#pragma unroll
                for (int j = 0; j < 8; ++j) { d[j] = y[j] - mean; s2 += d[j] * d[j]; }
                const float rstd = rsqrtf(oct_allsum(s2) * (1.0f / 64.0f) + 64e-5f);
                float o[8];
#pragma unroll
                for (int j = 0; j < 8; ++j) { float t = d[j] * rstd * lw[j] + lb[j] + rkv[q] * v[j]; o[j] = t * z[j] * sigmoidf_(z[j]); }
                u32x4 w; w.x = pack2(o[0], o[1]); w.y = pack2(o[2], o[3]); w.z = pack2(o[4], o[5]); w.w = pack2(o[6], o[7]);
                *(u32x4*)(P.H + (size_t)row * DIN + OFF_ZR + lane * 8) = w;
            }
        }
    }
}

__device__ __forceinline__ void p2_zcopy(const Params& P) {
    int tid_o = TIDX_(P.wid); asm volatile("" : "+v"(tid_o)); const int tid = tid_o;
    const int NT_ = gridDim.x * NTHR;
    for (int i = blockIdx.x * NTHR + tid; i < MT * 64; i += NT_ * 4) {
        u32x4 v[4];
#pragma unroll
        for (int q = 0; q < 4; ++q) { const int id = i + q * NT_; if (id < MT * 64) v[q] = *(const u32x4*)(P.H + (size_t)(id >> 6) * DIN + OFF_ZR + (id & 63) * 8); }
#pragma unroll
        for (int q = 0; q < 4; ++q) { const int id = i + q * NT_; if (id < MT * 64) *(u32x4*)(P.XB + (size_t)(id >> 6) * DM + (id & 63) * 8) = v[q]; }
    }
}
#define VT_LD 264
__device__ __forceinline__ void p3_attn_prompt(const Params& P, unsigned char* lds) {
    unsigned char* ldsK = lds;
    bf16_t* ldsVT = (bf16_t*)(lds + 32768);
    const bf16_t* H = P.H;
    int tid_o = TIDX_(P.wid); asm volatile("" : "+v"(tid_o));
    for (int unit = blockIdx.x; unit < 512; unit += gridDim.x) {
        int tid_l = tid_o; asm volatile("" : "+v"(tid_l)); const int tid = tid_l, lane = tid & 63, wid = tid >> 6;
        float kwr[8];
#pragma unroll
        for (int q = 0; q < 8; ++q) kwr[q] = P.k_norm_w[(tid & 7) * 8 + q];
        const int nu_ = (unit & 7) * 64 + (unit >> 3), qb = nu_ & 31, kvh = (nu_ >> 5) & 1, b = nu_ >> 6;
        const int seq_base = b * TP, blk = qb * 128;
        u32x4 qraw[2][4];
        {
            const int g_ = wid & 3, half_ = wid >> 2, head_ = kvh * 4 + g_, ql_ = lane & 31, hh_ = lane >> 5;
            {
                const bf16_t* hr = H + (size_t)(seq_base + blk + half_ * 64 + ql_) * DIN;
#pragma unroll
                for (int s = 0; s < 4; ++s) qraw[0][s] = *(const u32x4*)(hr + OFF_Q + head_ * 64 + s * 16 + hh_ * 8);
            }
        }
        __syncthreads();
#pragma unroll
        for (int i = 0; i < 4; ++i) {
            const int id = tid + NTHR * i, idx = id >> 3, c = id & 7;
            const int pos = blk - 128 + idx;
            u32x4 kv = (u32x4){0u, 0u, 0u, 0u};
            if (pos >= 0) kv = *(const u32x4*)(H + (size_t)(seq_base + pos) * DIN + OFF_K + kvh * 64 + c * 8);
            const int idx2 = (tid & 63) + 64 * i, c2 = tid >> 6, pos2 = blk - 128 + idx2;
            u32x4 vv = (u32x4){0u, 0u, 0u, 0u};
            if (pos2 >= 0) vv = *(const u32x4*)(H + (size_t)(seq_base + pos2) * DIN + OFF_V + kvh * 64 + c2 * 8);
            {
                float kf[8];
#pragma unroll
                for (int q = 0; q < 4; ++q) { kf[2 * q] = bflo(kv[q]); kf[2 * q + 1] = bfhi(kv[q]); }
                float ss = 0.f;
#pragma unroll
                for (int q = 0; q < 8; ++q) ss += kf[q] * kf[q];
                ss = oct_allsum(ss);
                const float rs = rsqrtf(ss * (1.0f / 64.0f) + 1e-6f);
#pragma unroll
                for (int q = 0; q < 8; ++q) kf[q] *= rs * kwr[q];
                kv.x = pack2(kf[0], kf[1]); kv.y = pack2(kf[2], kf[3]); kv.z = pack2(kf[4], kf[5]); kv.w = pack2(kf[6], kf[7]);
                if (qb == 31 && idx >= 128) {
                    const size_t o = ((size_t)(b * 128 + (idx - 128)) * 2 + kvh) * 64 + c * 8;
                    *(f32x4*)(P.o_ck_p + o) = (f32x4){kf[0], kf[1], kf[2], kf[3]}; *(f32x4*)(P.o_ck_p + o + 4) = (f32x4){kf[4], kf[5], kf[6], kf[7]};
                }
            }
            if (qb == 31 && idx2 >= 128) {
                const size_t o = ((size_t)(b * 128 + (idx2 - 128)) * 2 + kvh) * 64 + c2 * 8;
                *(f32x4*)(P.o_cv_p + o) = (f32x4){bflo(vv.x), bfhi(vv.x), bflo(vv.y), bfhi(vv.y)}; *(f32x4*)(P.o_cv_p + o + 4) = (f32x4){bflo(vv.z), bfhi(vv.z), bflo(vv.w), bfhi(vv.w)};
            }
            *(u32x4*)(ldsK + idx * 128 + ((c ^ (idx & 7)) << 4)) = kv;
#pragma unroll
            for (int q = 0; q < 4; ++q) {
                ldsVT[(c2 * 8 + q * 2) * VT_LD + idx2] = (bf16_t)(vv[q] & 0xffffu);
                ldsVT[(c2 * 8 + q * 2 + 1) * VT_LD + idx2] = (bf16_t)(vv[q] >> 16);
            }
        }
        __syncthreads();
        const int g = wid & 3, half = wid >> 2, head = kvh * 4 + g;
        {
            const bf16_t* hr = H + (size_t)(seq_base + blk + half * 64 + 32 + (lane & 31)) * DIN;
#pragma unroll
            for (int s = 0; s < 4; ++s) qraw[1][s] = *(const u32x4*)(hr + OFF_Q + head * 64 + s * 16 + (lane >> 5) * 8);
        }
        const float sink = P.sinks[head] * 1.44269504f;
        const int ql = lane & 31, hh = lane >> 5;
#pragma unroll
        for (int sb = 0; sb < 2; ++sb) {
            const int q0 = half * 64 + sb * 32;
            const int qrow = seq_base + blk + q0 + ql;
            uint2 zz[8];
            { const bf16_t* zr_ = H + (size_t)qrow * DIN + OFF_ZA + head * 64;
#pragma unroll
              for (int dt = 0; dt < 2; ++dt)
#pragma unroll
                for (int gq = 0; gq < 4; ++gq) zz[dt * 4 + gq] = *(const uint2*)(zr_ + dt * 32 + 8 * gq + 4 * hh); }
            bf16x8 qf[4];
            {
                float ss = 0.f;
#pragma unroll
                for (int s = 0; s < 4; ++s) {
#pragma unroll
                    for (int q = 0; q < 4; ++q) { const float x0 = bflo(qraw[sb][s][q]), x1 = bfhi(qraw[sb][s][q]); ss += x0 * x0 + x1 * x1; } }
                ss += __shfl_xor(ss, 32);
                const float rs = rsqrtf(ss * (1.0f / 64.0f) + 1e-6f) * (0.125f * 1.44269504f);
#pragma unroll
                for (int s = 0; s < 4; ++s) { u32x4 w;
#pragma unroll
                    for (int q = 0; q < 4; ++q) { const int d = s * 16 + hh * 8 + q * 2; w[q] = pack2(bflo(qraw[sb][s][q]) * rs * P.q_norm_w[d], bfhi(qraw[sb][s][q]) * rs * P.q_norm_w[d + 1]); }
                    qf[s] = __builtin_bit_cast(bf16x8, w); }
            }
            const int t0 = q0 >> 5;
            f32x16 sc[5];
#pragma unroll
            for (int kt = 0; kt < 5; ++kt) {
                f32x16 a;
#pragma unroll
                for (int r = 0; r < 16; ++r) a[r] = 0.f;
                const int krow = (t0 + kt) * 32 + ql;
#pragma unroll
                for (int s = 0; s < 4; ++s) {
                    const int c = s * 2 + hh;
                    const bf16x8 kf = *(const bf16x8*)(ldsK + krow * 128 + ((c ^ (krow & 7)) << 4));
                    a = __builtin_amdgcn_mfma_f32_32x32x16_bf16(kf, qf[s], a, 0, 0, 0);
                }
                sc[kt] = a;
            }
            const int kt_min = (qb == 0) ? 4 - t0 : 0;
            const int xq = ql - 4 * hh;
            float m = sink;
#pragma unroll
            for (int kt = 0; kt < 5; ++kt) {
                const bool dead = kt < kt_min;
#pragma unroll
                for (int r = 0; r < 16; ++r) {
                    const int cr = (r & 3) + 8 * (r >> 2);
                    const bool bad = dead || (kt == 0 && cr <= xq) || (kt == 4 && cr > xq);
                    const float s = bad ? -1e30f : sc[kt][r];
                    sc[kt][r] = s;
                    m = fmaxf(m, s);
                }
            }
            m = fmaxf(m, __shfl_xor(m, 32));
            float sum = 0.f;
#pragma unroll
            for (int kt = 0; kt < 5; ++kt)
#pragma unroll
                for (int r = 0; r < 16; ++r) { const float p = fexp2_(sc[kt][r] - m); sc[kt][r] = p; sum += p; }
            sum += __shfl_xor(sum, 32);
            const float inv = frcp_(sum + fexp2_(sink - m));
            f32x16 o[2];
#pragma unroll
            for (int dt = 0; dt < 2; ++dt)
#pragma unroll
                for (int r = 0; r < 16; ++r) o[dt][r] = 0.f;
#pragma unroll
            for (int kt = 0; kt < 5; ++kt)
#pragma unroll
                for (int s = 0; s < 2; ++s) {
                    u32x4 pw;
                    pw.x = pack2(sc[kt][8 * s + 0], sc[kt][8 * s + 1]); pw.y = pack2(sc[kt][8 * s + 2], sc[kt][8 * s + 3]);
                    pw.z = pack2(sc[kt][8 * s + 4], sc[kt][8 * s + 5]); pw.w = pack2(sc[kt][8 * s + 6], sc[kt][8 * s + 7]);
                    const bf16x8 pf = __builtin_bit_cast(bf16x8, pw);
                    const int key0 = (t0 + kt) * 32 + 16 * s + 4 * hh;
#pragma unroll
                    for (int dt = 0; dt < 2; ++dt) {
                        const bf16_t* vp = ldsVT + (dt * 32 + ql) * VT_LD + key0;
                        const uint2 v0 = *(const uint2*)vp, v1 = *(const uint2*)(vp + 8);
                        u32x4 vw; vw.x = v0.x; vw.y = v0.y; vw.z = v1.x; vw.w = v1.y;
                        const bf16x8 vf = __builtin_bit_cast(bf16x8, vw);
                        o[dt] = __builtin_amdgcn_mfma_f32_32x32x16_bf16(vf, pf, o[dt], 0, 0, 0);
                    }
                }
            const bf16_t* zr = H + (size_t)qrow * DIN + OFF_ZA + head * 64;
            int qrow_o = qrow; asm volatile("" : "+v"(qrow_o));
            bf16_t* orow = (bf16_t*)((unsigned char*)P.H + ((unsigned)qrow_o * (unsigned)(DIN * 2) + (unsigned)((OFF_Q + head * 64) * 2)));
#pragma unroll
            for (int dt = 0; dt < 2; ++dt)
#pragma unroll
                for (int gq = 0; gq < 4; ++gq) {
                    const int d = dt * 32 + 8 * gq + 4 * hh;
                    const uint2 z2 = zz[dt * 4 + gq];
                    const float z0 = bflo(z2.x), z1 = bfhi(z2.x), z2f = bflo(z2.y), z3 = bfhi(z2.y);
                    const float o0 = o[dt][gq * 4 + 0] * inv * z0 * sigmoidf_(z0);
                    const float o1 = o[dt][gq * 4 + 1] * inv * z1 * sigmoidf_(z1);
                    const float o2 = o[dt][gq * 4 + 2] * inv * z2f * sigmoidf_(z2f);
                    const float o3 = o[dt][gq * 4 + 3] * inv * z3 * sigmoidf_(z3);
                    *(uint2*)(orow + d) = make_uint2(pack2(o0, o1), pack2(o2, o3));
                }
            __builtin_amdgcn_sched_barrier(0);
        }
    }
}

#define VS_LD 168
__device__ __forceinline__ void p3_attn_sample(const Params& P, unsigned char* lds) {
    unsigned char* ldsK = lds;
    bf16_t* ldsVT = (bf16_t*)(lds + 20480);
    const bf16_t* H = P.H;
    int tid_o = TIDX_(P.wid); asm volatile("" : "+v"(tid_o)); const int tid = tid_o, lane = tid & 63, wid = tid >> 6;
    for (int unit = blockIdx.x; unit < 256; unit += gridDim.x) {
        const int b = unit >> 1, kvh = unit & 1;
        __syncthreads();
#pragma unroll
        for (int i = 0; i < 2; ++i) {
            const int id = tid + NTHR * i, j = id >> 3, c = id & 7;
            const float* kp = P.cache_k + ((size_t)(b * 128 + j) * 2 + kvh) * 64 + c * 8;
            const f32x4 k0 = *(const f32x4*)kp, k1 = *(const f32x4*)(kp + 4);
            *(u32x4*)(ldsK + j * 128 + ((c ^ (j & 7)) << 4)) = (u32x4){pack2(k0[0], k0[1]), pack2(k0[2], k0[3]), pack2(k1[0], k1[1]), pack2(k1[2], k1[3])};
            if (j >= 8) { float* op = P.o_ck_s + ((size_t)(b * 128 + j - 8) * 2 + kvh) * 64 + c * 8; *(f32x4*)op = k0; *(f32x4*)(op + 4) = k1; }
            const int j2 = (tid & 63) + 64 * i, c2 = tid >> 6;
            const float* vp = P.cache_v + ((size_t)(b * 128 + j2) * 2 + kvh) * 64 + c2 * 8;
            const f32x4 v0 = *(const f32x4*)vp, v1 = *(const f32x4*)(vp + 4);
#pragma unroll
            for (int q = 0; q < 4; ++q) { ldsVT[(c2 * 8 + q) * VS_LD + j2] = f2bf(v0[q]); ldsVT[(c2 * 8 + 4 + q) * VS_LD + j2] = f2bf(v1[q]); }
            if (j2 >= 8) { float* op = P.o_cv_s + ((size_t)(b * 128 + j2 - 8) * 2 + kvh) * 64 + c2 * 8; *(f32x4*)op = v0; *(f32x4*)(op + 4) = v1; }
        }
        if (tid < 64) {
            const int t = tid >> 3, c = tid & 7;
            const bf16_t* hr = H + (size_t)(MP + b * TS + t) * DIN;
            const u32x4 kv = *(const u32x4*)(hr + OFF_K + kvh * 64 + c * 8), vv = *(const u32x4*)(hr + OFF_V + kvh * 64 + c * 8);
            float kf[8], vf[8];
#pragma unroll
            for (int q = 0; q < 4; ++q) { kf[2 * q] = bflo(kv[q]); kf[2 * q + 1] = bfhi(kv[q]); vf[2 * q] = bflo(vv[q]); vf[2 * q + 1] = bfhi(vv[q]); }
            float ss = 0.f;
#pragma unroll
            for (int q = 0; q < 8; ++q) ss += kf[q] * kf[q];
            ss = oct_allsum(ss);
            const float rs = rsqrtf(ss * (1.0f / 64.0f) + 1e-6f);
#pragma unroll
            for (int q = 0; q < 8; ++q) kf[q] *= rs * P.k_norm_w[c * 8 + q];
            const int j = 128 + t;
            *(u32x4*)(ldsK + j * 128 + ((c ^ (j & 7)) << 4)) = (u32x4){pack2(kf[0], kf[1]), pack2(kf[2], kf[3]), pack2(kf[4], kf[5]), pack2(kf[6], kf[7])};
#pragma unroll
            for (int q = 0; q < 8; ++q) ldsVT[(c * 8 + q) * VS_LD + j] = f2bf(vf[q]);
            float* okp = P.o_ck_s + ((size_t)(b * 128 + 120 + t) * 2 + kvh) * 64 + c * 8; float* ovp = P.o_cv_s + ((size_t)(b * 128 + 120 + t) * 2 + kvh) * 64 + c * 8;
            *(f32x4*)okp = (f32x4){kf[0], kf[1], kf[2], kf[3]}; *(f32x4*)(okp + 4) = (f32x4){kf[4], kf[5], kf[6], kf[7]};
            *(f32x4*)ovp = (f32x4){vf[0], vf[1], vf[2], vf[3]}; *(f32x4*)(ovp + 4) = (f32x4){vf[4], vf[5], vf[6], vf[7]};
        } else if (tid < 64 + 192) {
            const int id = tid - 64, j = 136 + (id >> 3), c = id & 7;
            *(u32x4*)(ldsK + j * 128 + ((c ^ (j & 7)) << 4)) = (u32x4){0u, 0u, 0u, 0u};
#pragma unroll
            for (int q = 0; q < 8; ++q) ldsVT[(c * 8 + q) * VS_LD + j] = (bf16_t)0;
        }
        __syncthreads();
        if (wid == 0) {
            const int ql = lane & 31, hh = lane >> 5, t = ql >> 2, g = ql & 3, head = kvh * 4 + g;
            const int qrow = MP + b * TS + t;
            const float sink = P.sinks[head];
            uint2 zz[8];
            { const bf16_t* zr_ = H + (size_t)qrow * DIN + OFF_ZA + head * 64;
#pragma unroll
              for (int dt = 0; dt < 2; ++dt)
#pragma unroll
                for (int gq = 0; gq < 4; ++gq) zz[dt * 4 + gq] = *(const uint2*)(zr_ + dt * 32 + 8 * gq + 4 * hh); }
            bf16x8 qf[4];
            {
                u32x4 qraw[4]; float ss = 0.f;
#pragma unroll
                for (int s = 0; s < 4; ++s) { qraw[s] = *(const u32x4*)(H + (size_t)qrow * DIN + OFF_Q + head * 64 + s * 16 + hh * 8);
#pragma unroll
                    for (int q = 0; q < 4; ++q) { const float x0 = bflo(qraw[s][q]), x1 = bfhi(qraw[s][q]); ss += x0 * x0 + x1 * x1; } }
                ss += __shfl_xor(ss, 32);
                const float rs = rsqrtf(ss * (1.0f / 64.0f) + 1e-6f) * 0.125f;
#pragma unroll
                for (int s = 0; s < 4; ++s) { u32x4 w;
#pragma unroll
                    for (int q = 0; q < 4; ++q) { const int d = s * 16 + hh * 8 + q * 2; w[q] = pack2(bflo(qraw[s][q]) * rs * P.q_norm_w[d], bfhi(qraw[s][q]) * rs * P.q_norm_w[d + 1]); }
                    qf[s] = __builtin_bit_cast(bf16x8, w); }
            }
            f32x16 sc[5];
#pragma unroll
            for (int kt = 0; kt < 5; ++kt) {
                f32x16 a;
#pragma unroll
                for (int r = 0; r < 16; ++r) a[r] = 0.f;
                const int krow = kt * 32 + ql;
#pragma unroll
                for (int s = 0; s < 4; ++s) {
                    const int c = s * 2 + hh;
                    const bf16x8 kf = *(const bf16x8*)(ldsK + krow * 128 + ((c ^ (krow & 7)) << 4));
                    a = __builtin_amdgcn_mfma_f32_32x32x16_bf16(kf, qf[s], a, 0, 0, 0);
                }
                sc[kt] = a;
            }
            float m = sink;
#pragma unroll
            for (int kt = 0; kt < 5; ++kt)
#pragma unroll
                for (int r = 0; r < 16; ++r) {
                    const int kidx = kt * 32 + (r & 3) + 8 * (r >> 2) + 4 * hh;
                    const bool valid = (kidx > t) && (kidx <= t + 128);
                    const float s = valid ? sc[kt][r] : -1e30f;
                    sc[kt][r] = s;
                    m = fmaxf(m, s);
                }
            m = fmaxf(m, __shfl_xor(m, 32));
            float sum = 0.f;
#pragma unroll
            for (int kt = 0; kt < 5; ++kt)
#pragma unroll
                for (int r = 0; r < 16; ++r) { const float p = __expf(sc[kt][r] - m); sc[kt][r] = p; sum += p; }
            sum += __shfl_xor(sum, 32);
            const float inv = 1.0f / (sum + __expf(sink - m));
            f32x16 o[2];
#pragma unroll
            for (int dt = 0; dt < 2; ++dt)
#pragma unroll
                for (int r = 0; r < 16; ++r) o[dt][r] = 0.f;
#pragma unroll
            for (int kt = 0; kt < 5; ++kt)
#pragma unroll
                for (int s = 0; s < 2; ++s) {
                    u32x4 pw;
                    pw.x = pack2(sc[kt][8 * s + 0], sc[kt][8 * s + 1]); pw.y = pack2(sc[kt][8 * s + 2], sc[kt][8 * s + 3]);
                    pw.z = pack2(sc[kt][8 * s + 4], sc[kt][8 * s + 5]); pw.w = pack2(sc[kt][8 * s + 6], sc[kt][8 * s + 7]);
                    const bf16x8 pf = __builtin_bit_cast(bf16x8, pw);
                    const int key0 = kt * 32 + 16 * s + 4 * hh;
#pragma unroll
                    for (int dt = 0; dt < 2; ++dt) {
                        const bf16_t* vp = ldsVT + (dt * 32 + ql) * VS_LD + key0;
                        const uint2 v0 = *(const uint2*)vp, v1 = *(const uint2*)(vp + 8);
                        u32x4 vw; vw.x = v0.x; vw.y = v0.y; vw.z = v1.x; vw.w = v1.y;
                        const bf16x8 vf = __builtin_bit_cast(bf16x8, vw);
                        o[dt] = __builtin_amdgcn_mfma_f32_32x32x16_bf16(vf, pf, o[dt], 0, 0, 0);
                    }
                }
            bf16_t* orow = P.H + (size_t)qrow * DIN + OFF_Q + head * 64;
#pragma unroll
            for (int dt = 0; dt < 2; ++dt)
#pragma unroll
                for (int gq = 0; gq < 4; ++gq) {
                    const int d = dt * 32 + 8 * gq + 4 * hh;
                    const uint2 z2 = zz[dt * 4 + gq];
                    const float z0 = bflo(z2.x), z1 = bfhi(z2.x), z2f = bflo(z2.y), z3 = bfhi(z2.y);
                    const float o0 = o[dt][gq * 4 + 0] * inv * z0 * sigmoidf_(z0);
                    const float o1 = o[dt][gq * 4 + 1] * inv * z1 * sigmoidf_(z1);
                    const float o2 = o[dt][gq * 4 + 2] * inv * z2f * sigmoidf_(z2f);
                    const float o3 = o[dt][gq * 4 + 3] * inv * z3 * sigmoidf_(z3);
                    *(uint2*)(orow + d) = make_uint2(pack2(o0, o1), pack2(o2, o3));
                }
        }
    }
}
#define SS_BUF 2832
__device__ __forceinline__ void p3_scan(const Params& P, unsigned char* lds) {
    int tid_o = TIDX_(P.wid); asm volatile("" : "+v"(tid_o)); const int tid = tid_o, lane = tid & 63, wv = tid >> 6;
    const int grp = wv >> 2, tl = tid & 255;
    float* const B_ = (float*)lds + grp * SS_BUF;
    const int row_local = (wv & 3) * 4 + (lane >> 4), kq = lane & 15;
    const int stok = tl >> 3, scc = tl & 7; const bool stager = tl < 64;
    u32x4 gr = (u32x4){0u, 0u, 0u, 0u}, ge = gr, gk = gr, gv = gr, gkk = gr, get = gr;
    f32x4 Snext = (f32x4){0.f, 0.f, 0.f, 0.f};
#define SS_UNIT(p) (blockIdx.x + 256 * (2 * (p) + grp))
#define SS_PREFETCH(p) { const int un_ = SS_UNIT(p), b_ = un_ >> 5, h_ = (un_ >> 2) & 7, vq_ = un_ & 3; \
        Snext = *(const f32x4*)(P.state_rwkv + (size_t)(b_ * 8 + h_) * 4096 + (vq_ * 16 + row_local) * 64 + kq * 4); \
        if (stager) { const size_t o = (size_t)(MP + b_ * TS + stok) * 512 + h_ * 64 + scc * 8; \
            gr = *(const u32x4*)(P.Rr + o); ge = *(const u32x4*)(P.Re + o); gk = *(const u32x4*)(P.Rk + o); gv = *(const u32x4*)(P.Rv + o); gkk = *(const u32x4*)(P.Rkk + o); get = *(const u32x4*)(P.Reta + o); } }
    SS_PREFETCH(0)
    for (int p = 0; p < 8; ++p) {
        const int un = SS_UNIT(p), b = un >> 5, h = (un >> 2) & 7, vq = un & 3;
        __syncthreads();
        if (stager) {
            const int bo = stok * 64 + scc * 8; float fa[8], fwr[8], fw[8], fb[8], fk[8]; float br = 0.f, kr = 0.f;
#pragma unroll
            for (int q = 0; q < 4; ++q) {
                const float kk0 = bflo(gkk[q]), kk1 = bfhi(gkk[q]), r0 = bflo(gr[q]), r1 = bfhi(gr[q]);
                fa[2 * q] = -kk0; fa[2 * q + 1] = -kk1; fb[2 * q] = kk0 * bflo(get[q]); fb[2 * q + 1] = kk1 * bfhi(get[q]);
                fw[2 * q] = fexp2_(-bflo(ge[q])); fw[2 * q + 1] = fexp2_(-bfhi(ge[q])); fwr[2 * q] = fw[2 * q] * r0; fwr[2 * q + 1] = fw[2 * q + 1] * r1;
                fk[2 * q] = bflo(gk[q]); fk[2 * q + 1] = bfhi(gk[q]);
                br += fb[2 * q] * r0 + fb[2 * q + 1] * r1; kr += fk[2 * q] * r0 + fk[2 * q + 1] * r1; }
            *(f32x4*)(B_ + bo) = (f32x4){fa[0], fa[1], fa[2], fa[3]}; *(f32x4*)(B_ + bo + 4) = (f32x4){fa[4], fa[5], fa[6], fa[7]};
            *(f32x4*)(B_ + 512 + bo) = (f32x4){fwr[0], fwr[1], fwr[2], fwr[3]}; *(f32x4*)(B_ + 512 + bo + 4) = (f32x4){fwr[4], fwr[5], fwr[6], fwr[7]};
            *(f32x4*)(B_ + 1024 + bo) = (f32x4){fw[0], fw[1], fw[2], fw[3]}; *(f32x4*)(B_ + 1024 + bo + 4) = (f32x4){fw[4], fw[5], fw[6], fw[7]};
            *(f32x4*)(B_ + 1536 + bo) = (f32x4){fb[0], fb[1], fb[2], fb[3]}; *(f32x4*)(B_ + 1536 + bo + 4) = (f32x4){fb[4], fb[5], fb[6], fb[7]};
            *(f32x4*)(B_ + 2048 + bo) = (f32x4){fk[0], fk[1], fk[2], fk[3]}; *(f32x4*)(B_ + 2048 + bo + 4) = (f32x4){fk[4], fk[5], fk[6], fk[7]};
            if ((scc >> 1) == vq) { float* vp = B_ + 2560 + stok * 16 + (scc & 1) * 8;
                *(f32x4*)vp = (f32x4){bflo(gv[0]), bfhi(gv[0]), bflo(gv[1]), bfhi(gv[1])}; *(f32x4*)(vp + 4) = (f32x4){bflo(gv[2]), bfhi(gv[2]), bflo(gv[3]), bfhi(gv[3])}; }
            br = oct_allsum(br); kr = oct_allsum(kr);
            if (scc == 0) { B_[2688 + stok * 2] = br; B_[2688 + stok * 2 + 1] = kr; }
        }
        float S[4] = {Snext[0], Snext[1], Snext[2], Snext[3]};
        if (p + 1 < 8) SS_PREFETCH(p + 1)
        __syncthreads();
        {
            const float* pa = B_ + kq * 4; const float* pv = B_ + 2560 + row_local; const float* pbk = B_ + 2688; float* py = B_ + 2704 + row_local;
#define SS_LOAD(X, tt) const f32x4 a_##X = *(const f32x4*)(pa + (tt) * 64), wr_##X = *(const f32x4*)(pa + 512 + (tt) * 64), w_##X = *(const f32x4*)(pa + 1024 + (tt) * 64), \
                b_##X = *(const f32x4*)(pa + 1536 + (tt) * 64), k_##X = *(const f32x4*)(pa + 2048 + (tt) * 64); const float v_##X = pv[(tt) * 16]; const f32x2_t bk_##X = *(const f32x2_t*)(pbk + (tt) * 2);
#define SS_STEP(X, tt) { float u = (S[0] * a_##X[0] + S[1] * a_##X[1]) + (S[2] * a_##X[2] + S[3] * a_##X[3]); \
                float ya = (S[0] * wr_##X[0] + S[1] * wr_##X[1]) + (S[2] * wr_##X[2] + S[3] * wr_##X[3]); \
                u += dpp_f<0x128>(u); ya += dpp_f<0x128>(ya); u += dpp_f<0x124>(u); ya += dpp_f<0x124>(ya); \
                u += dpp_f<0x122>(u); ya += dpp_f<0x122>(ya); u += dpp_f<0x121>(u); ya += dpp_f<0x121>(ya); \
                S[0] = S[0] * w_##X[0] + (v_##X * k_##X[0] + u * b_##X[0]); S[1] = S[1] * w_##X[1] + (v_##X * k_##X[1] + u * b_##X[1]); \
                S[2] = S[2] * w_##X[2] + (v_##X * k_##X[2] + u * b_##X[2]); S[3] = S[3] * w_##X[3] + (v_##X * k_##X[3] + u * b_##X[3]); \
                const float y = ya + (u * bk_##X[0] + v_##X * bk_##X[1]); if (kq == 0) py[(tt) * 16] = y; }
            { SS_LOAD(A, 0) SS_LOAD(B, 1) SS_STEP(A, 0) SS_LOAD(C, 2) SS_STEP(B, 1) SS_LOAD(D, 3) SS_STEP(C, 2) SS_STEP(D, 3) }
            { SS_LOAD(A, 4) SS_LOAD(B, 5) SS_STEP(A, 4) SS_LOAD(C, 6) SS_STEP(B, 5) SS_LOAD(D, 7) SS_STEP(C, 6) SS_STEP(D, 7) }
#undef SS_LOAD
#undef SS_STEP
            f32x4 s4; s4[0] = S[0]; s4[1] = S[1]; s4[2] = S[2]; s4[3] = S[3];
            *(f32x4*)(P.o_state_s + (size_t)(b * 8 + h) * 4096 + (vq * 16 + row_local) * 64 + kq * 4) = s4;
        }
        __syncthreads();
        if (tl < 16) { const int tok = tl >> 1, hf = tl & 1; const float* yp = B_ + 2704 + tok * 16 + hf * 8;
            u32x4 o4; o4.x = pack2(yp[0], yp[1]); o4.y = pack2(yp[2], yp[3]); o4.z = pack2(yp[4], yp[5]); o4.w = pack2(yp[6], yp[7]);
            *(u32x4*)(P.YR + (size_t)(MP + b * TS + tok) * 512 + h * 64 + vq * 16 + hf * 8) = o4; }
    }
#undef SS_UNIT
#undef SS_PREFETCH
}
#define CH_EF 0
#define CH_ZF 17408
#define CH_A 21760
#define CH_R 29952
#define CH_B 38144
#define CH_K 46336
#define CH_AT 54528
#define CH_BH 62720
#define CH_KH 70912
#define CH_VT 79104
#define CH_T 87296
#define CH_AK 95488
#define CH_RB 103680
#define CH_G2 111872
#define CH_QV 120064
__device__ __forceinline__ int sw_ch(int row, int ch) { return (ch ^ row ^ (int)(0x63417250u >> ((row >> 1) & 0x1c))) & 7; }
__device__ __forceinline__ int sw_off(int row, int col) { return row * 128 + ((sw_ch(row, col >> 3) << 4) | ((col & 7) << 1)); }
__device__ __forceinline__ void nt_prod(const unsigned char* Y, const unsigned char* X, f32x4 (&acc)[2], int w, int lane) {
#pragma unroll
    for (int s = 0; s < 2; ++s) {
        const int yr = 16 * (w & 3) + (lane & 15), ch = 4 * s + (lane >> 4);
        const bf16x8 af = *(const bf16x8*)(Y + yr * 128 + (sw_ch(yr, ch) << 4));
#pragma unroll
        for (int n = 0; n < 2; ++n) {
            const int xr = 32 * (w >> 2) + 8 * ((lane & 15) >> 2) + 4 * n + (lane & 3);
            const bf16x8 bf = *(const bf16x8*)(X + xr * 128 + (sw_ch(xr, ch) << 4));
            acc[n] = __builtin_amdgcn_mfma_f32_16x16x32_bf16(bf, af, acc[n], 0, 0, 0);
        }
    }
}
template <int MODE> __device__ __forceinline__ void nt_mask(f32x4 (&acc)[2], int w, int lane) {
    if (MODE == 0) return;
    const int r = 16 * (w & 3) + (lane & 15);
#pragma unroll
    for (int n = 0; n < 2; ++n)
#pragma unroll
        for (int q = 0; q < 4; ++q) {
            const int c = 32 * (w >> 2) + 8 * (lane >> 4) + 4 * n + q;
            const bool keep = MODE == 1 ? (c < r) : MODE == 2 ? (c > r) : (c <= r);
            if (!keep) acc[n][q] = 0.f;
        }
}
__device__ __forceinline__ void nt_init_lds(const unsigned char* I, f32x4 (&acc)[2], int w, int lane) {
    const int r = 16 * (w & 3) + (lane & 15);
    const u32x4 v = *(const u32x4*)(I + sw_off(r, 32 * (w >> 2) + 8 * (lane >> 4)));
    acc[0] = (f32x4){bflo(v.x), bfhi(v.x), bflo(v.y), bfhi(v.y)}; acc[1] = (f32x4){bflo(v.z), bfhi(v.z), bflo(v.w), bfhi(v.w)};
}
__device__ __forceinline__ void nt_store_lds(unsigned char* O, const f32x4 (&acc)[2], int w, int lane) {
    const int r = 16 * (w & 3) + (lane & 15);
    *(u32x4*)(O + sw_off(r, 32 * (w >> 2) + 8 * (lane >> 4))) = (u32x4){pack2(acc[0][0], acc[0][1]), pack2(acc[0][2], acc[0][3]), pack2(acc[1][0], acc[1][1]), pack2(acc[1][2], acc[1][3])};
}
__device__ __forceinline__ void nt_store_f32(float* O, const f32x4 (&acc)[2], int w, int lane) {
    const int r = 16 * (w & 3) + (lane & 15);
#pragma unroll
    for (int n = 0; n < 2; ++n) { const int c = 32 * (w >> 2) + 8 * (lane >> 4) + 4 * n; *(f32x4*)(O + r * 68 + c) = acc[n]; }
}
__device__ __forceinline__ void nt_store_glb(bf16_t* O, const f32x4 (&acc)[2], int w, int lane) {
    const int r = 16 * (w & 3) + (lane & 15);
    *(u32x4*)(O + r * 64 + 32 * (w >> 2) + 8 * (lane >> 4)) = (u32x4){pack2(acc[0][0], acc[0][1]), pack2(acc[0][2], acc[0][3]), pack2(acc[1][0], acc[1][1]), pack2(acc[1][2], acc[1][3])};
}
#define ZACC(a) { a[0] = (f32x4){0.f, 0.f, 0.f, 0.f}; a[1] = (f32x4){0.f, 0.f, 0.f, 0.f}; }

#define CH_TH CH_A
#define CH_AL CH_R
#define CH_WD CH_B
#define CH_WA CH_K
#define CH_ZW CH_AT
#define CH_ZA 71936
#define CH_CST (131072 + 1024)
__device__ __forceinline__ void p3_chunk_a(const Params& P, unsigned char* lds) {
    int tid_o = TIDX_(P.wid); asm volatile("" : "+v"(tid_o)); const int tid = tid_o, lane = tid & 63, w = tid >> 6;
    float* EF = (float*)(lds + CH_EF); float* ZF = (float*)(lds + CH_ZF); float* cst = (float*)(lds + CH_CST);
    const bf16_t* H = P.H;
    const int tok = tid >> 3, cc = tid & 7;
    const int tok2 = (tid & 255) >> 2, cc2 = (tid >> 8) * 4 + (tid & 3);
    __syncthreads();
    { cst[tid] = P.w0[tid]; cst[512 + tid] = P.a0[tid]; cst[1024 + tid] = P.mu[tid]; cst[1536 + tid] = P.mu[512 + tid]; cst[2048 + tid] = P.mu[1024 + tid];
      cst[2560 + tid] = P.k_k[tid]; cst[3072 + tid] = P.k_a[tid]; cst[3584 + tid] = P.r_k[tid]; }
    if (tid < 128) cst[4096 + tid] = P.mu[1536 + tid];
    u32x4 nhr, nhk, nhv, npr, npk, npv, nl0, nl1, nq0, nq1, nwd, nwa;
#define CH_GLOAD(un) { const int bh_ = (un) >> 6, c_ = (un) & 63, h_ = bh_ & 7; const size_t R_ = (size_t)((bh_ >> 3) * TP + c_ * 64 + tok); const bf16_t* hc = H + R_ * DIN; \
        nhr = *(const u32x4*)(hc + h_ * 64 + cc * 8); nhk = *(const u32x4*)(hc + 512 + h_ * 64 + cc * 8); nhv = *(const u32x4*)(hc + 1024 + h_ * 64 + cc * 8); \
        const bf16_t* hl = H + (size_t)((bh_ >> 3) * TP + c_ * 64 + tok2) * DIN + 1536 + 16 * cc2; nl0 = *(const u32x4*)hl; nl1 = *(const u32x4*)(hl + 8); \
        if (c_ == 0 && tok == 0) { npr = (u32x4){0u, 0u, 0u, 0u}; npk = npr; npv = npr; } \
        else { const bf16_t* hp = hc - DIN; npr = *(const u32x4*)(hp + h_ * 64 + cc * 8); npk = *(const u32x4*)(hp + 512 + h_ * 64 + cc * 8); npv = *(const u32x4*)(hp + 1024 + h_ * 64 + cc * 8); } \
        if (c_ == 0 && tok2 == 0) { nq0 = (u32x4){0u, 0u, 0u, 0u}; nq1 = nq0; } else { nq0 = *(const u32x4*)(hl - DIN); nq1 = *(const u32x4*)(hl - DIN + 8); } \
        nwd = *(const u32x4*)(P.WLd + (size_t)h_ * 4096 + tid * 8); nwa = *(const u32x4*)(P.WLa + (size_t)h_ * 4096 + tid * 8); }
    if ((int)blockIdx.x < 4096) CH_GLOAD(blockIdx.x)
    __syncthreads();
    for (int unit = blockIdx.x; unit < 4096; unit += gridDim.x) {
        int tid_l = tid; asm volatile("" : "+v"(tid_l));
        const int tok = tid_l >> 3, cc = tid_l & 7, lane = tid_l & 63, w = tid_l >> 6, tok2 = (tid_l & 255) >> 2, cc2 = (tid_l >> 8) * 4 + (tid_l & 3);
        const int bh = unit >> 6, c = unit & 63, b = bh >> 3, h = bh & 7;
        const size_t R = (size_t)(b * TP + c * 64 + tok);
        float r[8], k2[8], v[8], e2[8], kk[8], eta[8];
        {
            const int c0 = h * 64 + cc * 8;
            const f32x4 mr0 = *(const f32x4*)(cst + 1024 + c0), mr1 = *(const f32x4*)(cst + 1024 + c0 + 4), mk0 = *(const f32x4*)(cst + 1536 + c0), mk1 = *(const f32x4*)(cst + 1536 + c0 + 4);
            const f32x4 mv0 = *(const f32x4*)(cst + 2048 + c0), mv1 = *(const f32x4*)(cst + 2048 + c0 + 4);
#pragma unroll
            for (int q = 0; q < 8; ++q) {
                const float fr = (q & 1) ? bfhi(nhr[q >> 1]) : bflo(nhr[q >> 1]), pr = (q & 1) ? bfhi(npr[q >> 1]) : bflo(npr[q >> 1]);
                const float fk = (q & 1) ? bfhi(nhk[q >> 1]) : bflo(nhk[q >> 1]), pk = (q & 1) ? bfhi(npk[q >> 1]) : bflo(npk[q >> 1]);
                const float fv = (q & 1) ? bfhi(nhv[q >> 1]) : bflo(nhv[q >> 1]), pv = (q & 1) ? bfhi(npv[q >> 1]) : bflo(npv[q >> 1]);
                r[q] = fr + (pr - fr) * (q < 4 ? mr0[q & 3] : mr1[q & 3]);
                k2[q] = fk + (pk - fk) * (q < 4 ? mk0[q & 3] : mk1[q & 3]);
                v[q] = fv + (pv - fv) * (q < 4 ? mv0[q & 3] : mv1[q & 3]);
            }
            float x[16];
#pragma unroll
            for (int j = 0; j < 16; ++j) { const unsigned wc_ = j < 8 ? nl0[(j & 7) >> 1] : nl1[(j & 7) >> 1], wp_ = j < 8 ? nq0[(j & 7) >> 1] : nq1[(j & 7) >> 1];
                const float f = (j & 1) ? bfhi(wc_) : bflo(wc_), fp = (j & 1) ? bfhi(wp_) : bflo(wp_);
                x[j] = f + (fp - f) * cst[4096 + 16 * cc2 + j]; }
            if (cc2 < 4) {
#pragma unroll
                for (int j = 0; j < 16; ++j) x[j] = 1.0f - 2.0f * frcp_(1.0f + fexp2_(2.88539008f * x[j]));
            }
            unsigned char* dst = lds + (cc2 < 4 ? CH_TH : CH_AL) + tok2 * 128; const int ch0 = 2 * (cc2 & 3);
            *(u32x4*)(dst + (sw_ch(tok2, ch0) << 4)) = (u32x4){pack2(x[0], x[1]), pack2(x[2], x[3]), pack2(x[4], x[5]), pack2(x[6], x[7])};
            *(u32x4*)(dst + (sw_ch(tok2, ch0 + 1) << 4)) = (u32x4){pack2(x[8], x[9]), pack2(x[10], x[11]), pack2(x[12], x[13]), pack2(x[14], x[15])};
            const int wrow = tid >> 3, wch = tid & 7;
            *(u32x4*)(lds + CH_WD + wrow * 128 + (sw_ch(wrow, wch) << 4)) = nwd; *(u32x4*)(lds + CH_WA + wrow * 128 + (sw_ch(wrow, wch) << 4)) = nwa;
        }
        __syncthreads();
        {
            f32x4 a0[2], a1[2]; ZACC(a0) ZACC(a1)
            nt_prod(lds + CH_TH, lds + CH_WD, a0, w, lane); nt_prod(lds + CH_AL, lds + CH_WA, a1, w, lane);
            nt_store_f32((float*)(lds + CH_ZW), a0, w, lane); nt_store_f32((float*)(lds + CH_ZA), a1, w, lane);
        }
        __syncthreads();
        {
            const int c0 = h * 64 + cc * 8;
            const float* zwp = (const float*)(lds + CH_ZW) + tok * 68 + cc * 8; const float* zap = (const float*)(lds + CH_ZA) + tok * 68 + cc * 8;
            const f32x4 zw0 = *(const f32x4*)zwp + *(const f32x4*)(cst + c0), zw1 = *(const f32x4*)(zwp + 4) + *(const f32x4*)(cst + c0 + 4);
            const f32x4 za0 = *(const f32x4*)zap + *(const f32x4*)(cst + 512 + c0), za1 = *(const f32x4*)(zap + 4) + *(const f32x4*)(cst + 512 + c0 + 4);
            const f32x4 kk0 = *(const f32x4*)(cst + 2560 + c0), kk1 = *(const f32x4*)(cst + 2560 + c0 + 4), ka0 = *(const f32x4*)(cst + 3072 + c0), ka1 = *(const f32x4*)(cst + 3072 + c0 + 4);
            const f32x4 rk0 = *(const f32x4*)(cst + 3584 + c0), rk1 = *(const f32x4*)(cst + 3584 + c0 + 4);
            float ss = 0.f, rks = 0.f;
#pragma unroll
            for (int q = 0; q < 8; ++q) {
                e2[q] = 0.87506123f * sigmoidf_(q < 4 ? zw0[q & 3] : zw1[q & 3]);
                eta[q] = sigmoidf_(q < 4 ? za0[q & 3] : za1[q & 3]);
                const float km = k2[q];
                kk[q] = km * (q < 4 ? kk0[q & 3] : kk1[q & 3]); ss += kk[q] * kk[q];
                k2[q] = km * (1.0f + (eta[q] - 1.0f) * (q < 4 ? ka0[q & 3] : ka1[q & 3]));
                rks += r[q] * k2[q] * (q < 4 ? rk0[q & 3] : rk1[q & 3]);
            }
            ss = oct_allsum(ss); rks = oct_allsum(rks);
            const float kn = rsqrtf(fmaxf(ss, 1e-24f));
#pragma unroll
            for (int q = 0; q < 8; ++q) kk[q] *= kn;
            *(u32x4*)(P.Rv + R * 512 + c0) = (u32x4){pack2(v[0], v[1]), pack2(v[2], v[3]), pack2(v[4], v[5]), pack2(v[6], v[7])};
            if (cc == 0) P.rk[R * 8 + h] = rks;
            *(f32x4*)(EF + tok * 68 + cc * 8) = (f32x4){e2[0], e2[1], e2[2], e2[3]}; *(f32x4*)(EF + tok * 68 + cc * 8 + 4) = (f32x4){e2[4], e2[5], e2[6], e2[7]};
        }
        __syncthreads();
        *(u32x4*)(lds + CH_T + tid * 16) = (u32x4){0u, 0u, 0u, 0u};
        {
            const int ch = tid & 63, seg = tid >> 6;
            float p[8]; float run = 0.f;
#pragma unroll
            for (int q = 0; q < 8; ++q) { run += EF[(8 * seg + q) * 68 + ch]; p[q] = run; }
            ZF[seg * 64 + ch] = run;
            __syncthreads();
            float offs = 0.f;
#pragma unroll
            for (int s2 = 0; s2 < 7; ++s2) if (s2 < seg) offs += ZF[s2 * 64 + ch];
#pragma unroll
            for (int q = 0; q < 8; ++q) EF[(8 * seg + q) * 68 + ch] = p[q] + offs;
        }
        __syncthreads();
        {
            const f32x4 E0 = *(const f32x4*)(EF + tok * 68 + cc * 8), E1 = *(const f32x4*)(EF + tok * 68 + cc * 8 + 4);
            const f32x4 C0 = *(const f32x4*)(EF + 63 * 68 + cc * 8), C1 = *(const f32x4*)(EF + 63 * 68 + cc * 8 + 4);
            float At[8], Rt[8], Bt[8], Kt[8], Bh[8], Kh[8];
#pragma unroll
            for (int q = 0; q < 8; ++q) {
                const float E = q < 4 ? E0[q & 3] : E1[q & 3], EC = q < 4 ? C0[q & 3] : C1[q & 3];
                const float g = __builtin_amdgcn_exp2f(-E), gi = __builtin_amdgcn_exp2f(E), gp = __builtin_amdgcn_exp2f(e2[q] - E), gc = __builtin_amdgcn_exp2f(E - EC);
                const float bb = kk[q] * eta[q];
                At[q] = -kk[q] * gp; Rt[q] = r[q] * g; Bt[q] = bb * gi; Kt[q] = k2[q] * gi; Bh[q] = bb * gc; Kh[q] = k2[q] * gc;
            }
            const int so = tok * 128 + (sw_ch(tok, cc) << 4);
            *(u32x4*)(lds + CH_A + so) = (u32x4){pack2(At[0], At[1]), pack2(At[2], At[3]), pack2(At[4], At[5]), pack2(At[6], At[7])};
            *(u32x4*)(lds + CH_R + so) = (u32x4){pack2(Rt[0], Rt[1]), pack2(Rt[2], Rt[3]), pack2(Rt[4], Rt[5]), pack2(Rt[6], Rt[7])};
            *(u32x4*)(lds + CH_B + so) = (u32x4){pack2(Bt[0], Bt[1]), pack2(Bt[2], Bt[3]), pack2(Bt[4], Bt[5]), pack2(Bt[6], Bt[7])};
            *(u32x4*)(lds + CH_K + so) = (u32x4){pack2(Kt[0], Kt[1]), pack2(Kt[2], Kt[3]), pack2(Kt[4], Kt[5]), pack2(Kt[6], Kt[7])};
#pragma unroll
            for (int q = 0; q < 8; ++q) {
                const int to = sw_off(cc * 8 + q, tok);
                *(bf16_t*)(lds + CH_AT + to) = f2bf(At[q]); *(bf16_t*)(lds + CH_BH + to) = f2bf(Bh[q]); *(bf16_t*)(lds + CH_KH + to) = f2bf(Kh[q]); *(bf16_t*)(lds + CH_VT + to) = f2bf(v[q]);
            }
            if (tok == 63) { float* gcp = P.SA_GC + (size_t)unit * 64 + cc * 8;
                *(f32x4*)gcp = (f32x4){fexp2_(-C0[0]), fexp2_(-C0[1]), fexp2_(-C0[2]), fexp2_(-C0[3])}; *(f32x4*)(gcp + 4) = (f32x4){fexp2_(-C1[0]), fexp2_(-C1[1]), fexp2_(-C1[2]), fexp2_(-C1[3])}; }
        }
        __syncthreads();
        if (unit + (int)gridDim.x < 4096) CH_GLOAD(unit + gridDim.x)
        {
            f32x4 a0[2], a1[2], a2[2]; ZACC(a0) ZACC(a1) ZACC(a2)
            nt_prod(lds + CH_A, lds + CH_B, a0, w, lane); nt_prod(lds + CH_K, lds + CH_A, a1, w, lane); nt_prod(lds + CH_R, lds + CH_B, a2, w, lane);
            nt_mask<1>(a0, w, lane); nt_mask<2>(a1, w, lane); nt_mask<3>(a2, w, lane);
            nt_store_f32(EF, a0, w, lane); nt_store_lds(lds + CH_G2, a0, w, lane); nt_store_lds(lds + CH_AK, a1, w, lane); nt_store_lds(lds + CH_RB, a2, w, lane);
            *(u32x4*)(lds + CH_QV + tid * 16) = (u32x4){0u, 0u, 0u, 0u};
            if (tid < 272) *(u32x4*)(lds + CH_ZF + tid * 16) = (u32x4){0u, 0u, 0u, 0u};
        }
        __syncthreads();
        if (tid < 64) {
            const int d = tid >> 4, j = tid & 15; const float* Ad = EF + (16 * d) * 68 + 16 * d;
            f32x4 ar[16][4]; float col[16];
#pragma unroll
            for (int t = 1; t < 10; ++t)
#pragma unroll
                for (int c4 = 0; c4 * 4 < t; ++c4) ar[t][c4] = *(const f32x4*)(Ad + t * 68 + 4 * c4);
#pragma unroll
            for (int t = 0; t < 10; ++t) { float v = (t == j) ? 1.f : 0.f;
#pragma unroll
                for (int i = 0; i < t; ++i) v += ar[t][i >> 2][i & 3] * col[i];
                col[t] = v; }
#pragma unroll
            for (int t = 10; t < 16; ++t)
#pragma unroll
                for (int c4 = 0; c4 * 4 < t; ++c4) ar[t][c4] = *(const f32x4*)(Ad + t * 68 + 4 * c4);
#pragma unroll
            for (int t = 10; t < 16; ++t) { float v = (t == j) ? 1.f : 0.f;
#pragma unroll
                for (int i = 0; i < t; ++i) v += ar[t][i >> 2][i & 3] * col[i];
                col[t] = v; }
#pragma unroll
            for (int t = 0; t < 16; ++t) { const bf16_t tv = f2bf(col[t]); *(bf16_t*)(lds + CH_T + sw_off(16 * d + t, 16 * d + j)) = tv; *(bf16_t*)(lds + CH_QV + sw_off(16 * d + j, 16 * d + t)) = tv; }
            const int l15 = lane & 15, g4 = lane >> 4;
#define CH_LVL(dd) { _Pragma("unroll") for (int jb = 0; jb < (dd); ++jb) { f32x4 z = (f32x4){0.f, 0.f, 0.f, 0.f}; \
                    _Pragma("unroll") for (int s = 0; s < ((dd) + 1) / 2; ++s) { const int yr = 16 * jb + l15, xr = 16 * (dd) + l15, ch = 4 * s + g4; \
                        const bf16x8 yf = *(const bf16x8*)(lds + CH_QV + yr * 128 + (sw_ch(yr, ch) << 4)), xf = *(const bf16x8*)(lds + CH_G2 + xr * 128 + (sw_ch(xr, ch) << 4)); \
                        z = __builtin_amdgcn_mfma_f32_16x16x32_bf16(xf, yf, z, 0, 0, 0); } \
                    *(uint2*)(lds + CH_ZF + (16 * jb + l15) * 64 + 32 + 8 * g4) = make_uint2(pack2(z[0], z[1]), pack2(z[2], z[3])); } \
                asm volatile("s_waitcnt lgkmcnt(0)" ::: "memory"); \
                _Pragma("unroll") for (int jb = 0; jb < (dd); ++jb) { const int yr = 16 * (dd) + l15, ch = 2 * (dd) - 2 + g4; \
                    const bf16x8 yf = *(const bf16x8*)(lds + CH_T + yr * 128 + (sw_ch(yr, ch) << 4)), xf = *(const bf16x8*)(lds + CH_ZF + (16 * jb + l15) * 64 + 16 * g4); \
                    f32x4 t = __builtin_amdgcn_mfma_f32_16x16x32_bf16(xf, yf, (f32x4){0.f, 0.f, 0.f, 0.f}, 0, 0, 0); \
                    tq[jb] = t; } \
                _Pragma("unroll") for (int jb = 0; jb < (dd); ++jb) { const f32x4 t = tq[jb]; const int rr = 16 * (dd) + l15, cc0 = 16 * jb + 4 * g4; \
                    *(uint2*)(lds + CH_T + sw_off(rr, cc0)) = make_uint2(pack2(t[0], t[1]), pack2(t[2], t[3])); \
                    _Pragma("unroll") for (int q = 0; q < 4; ++q) *(bf16_t*)(lds + CH_QV + sw_off(cc0 + q, rr)) = f2bf(t[q]); } \
                asm volatile("s_waitcnt lgkmcnt(0)" ::: "memory"); }
            asm volatile("s_waitcnt lgkmcnt(0)" ::: "memory");
            f32x4 tq[3];
            CH_LVL(1) CH_LVL(2) CH_LVL(3)
#undef CH_LVL
        }
        __syncthreads();
        {
            f32x4 a0[2], a1[2]; ZACC(a0) ZACC(a1)
            nt_prod(lds + CH_AT, lds + CH_T, a0, w, lane); nt_prod(lds + CH_AK, lds + CH_T, a1, w, lane);
            nt_store_lds(lds + CH_B, a0, w, lane); nt_store_lds(lds + CH_A, a1, w, lane);
        }
        __syncthreads();
        {
            f32x4 a0[2], a1[2], a2[2], a3[2];
            nt_init_lds(lds + CH_R, a0, w, lane); nt_prod(lds + CH_RB, lds + CH_B, a0, w, lane);
            ZACC(a1) nt_prod(lds + CH_R, lds + CH_K, a1, w, lane); nt_mask<3>(a1, w, lane); nt_prod(lds + CH_RB, lds + CH_A, a1, w, lane);
            ZACC(a2) nt_prod(lds + CH_BH, lds + CH_B, a2, w, lane);
            nt_init_lds(lds + CH_KH, a3, w, lane); nt_prod(lds + CH_BH, lds + CH_A, a3, w, lane);
            nt_store_glb(P.SA_G1 + (size_t)unit * 4096, a0, w, lane); nt_store_lds(lds + CH_G2, a1, w, lane);
            nt_store_glb(P.SA_PC + (size_t)unit * 4096, a2, w, lane); nt_store_lds(lds + CH_QV, a3, w, lane);
        }
        __syncthreads();
        {
            f32x4 a0[2], a1[2]; ZACC(a0) ZACC(a1)
            nt_prod(lds + CH_VT, lds + CH_G2, a0, w, lane); nt_prod(lds + CH_VT, lds + CH_QV, a1, w, lane);
            nt_store_glb(P.SA_YL + (size_t)unit * 4096, a0, w, lane); nt_store_glb(P.SA_QT + (size_t)unit * 4096, a1, w, lane);
        }
    }
}

#undef CH_GLOAD
#define CB_PC 0
#define CB_G1 8192
#define CB_QT 16384
#define CB_YL 18432
#define CB_GC 20480
#define CB_SLOT 20736
#define CB_SF (2 * CB_SLOT)
__device__ __forceinline__ void p4_chunk_b(const Params& P, unsigned char* lds) {
    int tid_o = TIDX_(P.wid); asm volatile("" : "+v"(tid_o)); const int tid = tid_o, lane = tid & 63, w = tid >> 6;
    for (int unit = blockIdx.x; unit < 256; unit += gridDim.x) {
        const int bh = (unit & 7) * 8 + (unit >> 5), vq = (unit >> 3) & 3, b = bh >> 3, h = bh & 7;
        const size_t u0 = (size_t)bh * 64;
        const int crow = tid >> 3, cch = tid & 7, cdst = crow * 128 + (sw_ch(crow, cch) << 4);
        const size_t x2off = tid < 128 ? (size_t)(16 * vq + (tid >> 3)) * 64 + (tid & 7) * 8 : tid < 256 ? (size_t)(16 * vq + ((tid - 128) >> 3)) * 64 + (tid & 7) * 8 : (size_t)((tid < 272 ? tid - 256 : 0) * 8);
        const int x2dst = tid < 128 ? CB_QT + cdst : tid < 256 ? CB_YL + (crow - 16) * 128 + (sw_ch(crow - 16, cch) << 4) : CB_GC + (tid < 272 ? tid - 256 : 0) * 16;
#define CB_LOAD(X, c) { const size_t uu = u0 + (c); X##0 = *(const u32x4*)(P.SA_PC + uu * 4096 + tid * 8); X##1 = *(const u32x4*)(P.SA_G1 + uu * 4096 + tid * 8); \
        const bf16_t* p2_ = tid < 128 ? P.SA_QT + uu * 4096 : tid < 256 ? P.SA_YL + uu * 4096 : (const bf16_t*)(P.SA_GC + uu * 64); X##2 = *(const u32x4*)(p2_ + x2off); }
#define CB_STORE(X, slot) { unsigned char* sl_ = lds + (slot) * CB_SLOT; *(u32x4*)(sl_ + CB_PC + cdst) = X##0; *(u32x4*)(sl_ + CB_G1 + cdst) = X##1; \
        if (tid < 272) *(u32x4*)(sl_ + x2dst) = X##2; }
        u32x4 A0, A1, A2 = (u32x4){0u, 0u, 0u, 0u}, B0, B1, B2 = A2, C0, C1, C2 = A2, D0, D1, D2 = A2, E0, E1, E2 = A2, F0, F1, F2 = A2;
        f32x4 Sn = (f32x4){0.f, 0.f, 0.f, 0.f};
        __syncthreads();
        if (tid < 128) *(u32x4*)(lds + CB_SF + tid * 16) = (u32x4){0u, 0u, 0u, 0u};
        CB_LOAD(A, 0) CB_STORE(A, 0)
        CB_LOAD(B, 1) CB_LOAD(C, 2) CB_LOAD(D, 3) CB_LOAD(E, 4) CB_LOAD(F, 5)
        asm volatile("s_waitcnt lgkmcnt(0)" ::: "memory"); __builtin_amdgcn_s_barrier(); asm volatile("" ::: "memory");
#define CB_STEP(c, CUR, NXT) { \
        { const unsigned char* sl_ = lds + ((c) & 1) * CB_SLOT; const int v_ = lane & 15, g_ = lane >> 4, n = w & 3, xr = 16 * n + v_; \
            bf16x8 sf[2]; sf[0] = *(const bf16x8*)(lds + CB_SF + ((c) & 1) * 2048 + lane * 16); sf[1] = *(const bf16x8*)(lds + CB_SF + ((c) & 1) * 2048 + 1024 + lane * 16); \
            if (w < 4) {     \
                const uint2 qt = *(const uint2*)(sl_ + CB_QT + sw_off(v_, 16 * n + 4 * g_)); const f32x4 gc = *(const f32x4*)(sl_ + CB_GC + (16 * n + 4 * g_) * 4); \
                f32x4 as = (f32x4){bflo(qt.x), bfhi(qt.x), bflo(qt.y), bfhi(qt.y)} + gc * Sn; \
                _Pragma("unroll") for (int s = 0; s < 2; ++s) { \
                    const uint2 p0 = *(const uint2*)(sl_ + CB_PC + sw_off(xr, 32 * s + 4 * g_)), p1 = *(const uint2*)(sl_ + CB_PC + sw_off(xr, 32 * s + 16 + 4 * g_)); \
                    u32x4 pf; pf.x = p0.x; pf.y = p0.y; pf.z = p1.x; pf.w = p1.y; \
                    as = __builtin_amdgcn_mfma_f32_16x16x32_bf16(__builtin_bit_cast(bf16x8, pf), sf[s], as, 0, 0, 0); } \
                Sn = as; \
                *(uint2*)(lds + CB_SF + (((c) + 1) & 1) * 2048 + (n >> 1) * 1024 + lane * 16 + (n & 1) * 8) = make_uint2(pack2(as[0], as[1]), pack2(as[2], as[3])); \
            } else {         \
                const uint2 yl = *(const uint2*)(sl_ + CB_YL + sw_off(v_, 16 * n + 4 * g_)); f32x4 ay = (f32x4){bflo(yl.x), bfhi(yl.x), bflo(yl.y), bfhi(yl.y)}; \
                _Pragma("unroll") for (int s = 0; s < 2; ++s) { \
                    const uint2 q0 = *(const uint2*)(sl_ + CB_G1 + sw_off(xr, 32 * s + 4 * g_)), q1 = *(const uint2*)(sl_ + CB_G1 + sw_off(xr, 32 * s + 16 + 4 * g_)); \
                    u32x4 gf; gf.x = q0.x; gf.y = q0.y; gf.z = q1.x; gf.w = q1.y; \
                    ay = __builtin_amdgcn_mfma_f32_16x16x32_bf16(__builtin_bit_cast(bf16x8, gf), sf[s], ay, 0, 0, 0); } \
                bf16_t* yo = P.YR + (size_t)(b * TP + (c) * 64) * 512 + h * 64 + 16 * vq + v_; \
                _Pragma("unroll") for (int q = 0; q < 4; ++q) yo[(size_t)(16 * n + 4 * g_ + q) * 512] = f2bf(ay[q]); } } \
        if ((c) + 1 < 64) CB_STORE(NXT, ((c) + 1) & 1) \
        if ((c) + 6 < 64) CB_LOAD(CUR, (c) + 6) \
        asm volatile("s_waitcnt lgkmcnt(0)" ::: "memory"); __builtin_amdgcn_s_barrier(); asm volatile("" ::: "memory"); }
        for (int c = 0; c < 60; c += 6) { CB_STEP(c, A, B) CB_STEP(c + 1, B, C) CB_STEP(c + 2, C, D) CB_STEP(c + 3, D, E) CB_STEP(c + 4, E, F) CB_STEP(c + 5, F, A) }
        CB_STEP(60, A, B) CB_STEP(61, B, C) CB_STEP(62, C, D) CB_STEP(63, D, E)
        if (w < 4) { float* so = P.o_state_p + (size_t)bh * 4096 + (size_t)(16 * vq + (lane & 15)) * 64 + 4 * (lane >> 4); *(f32x4*)(so + 16 * w) = Sn; }
#undef CB_LOAD
#undef CB_STORE
#undef CB_STEP
    }
}
template <int MODE>
__device__ __forceinline__ void g64_phase(const Params& P, unsigned char* lds, const bf16_t* A, const int lda, const bf16_t* Bt) {
    int tid_o = TIDX_(P.wid); asm volatile("" : "+v"(tid_o)); const int tid = tid_o, lane = tid & 63, w = tid >> 6;
    for (int tile = blockIdx.x; tile < 256; tile += gridDim.x) {
        const int row0 = MP + 64 * (tile >> 4), col0 = 64 * (tile & 15);
        u32x4 af[4][4], bf[4][4];
#pragma unroll
        for (int s = 0; s < 4; ++s)
#pragma unroll
            for (int m = 0; m < 4; ++m) {
                af[m][s] = *(const u32x4*)(A + (size_t)(row0 + 16 * m + (lane & 15)) * lda + 128 * w + 32 * s + 8 * (lane >> 4));
                bf[m][s] = *(const u32x4*)(Bt + (size_t)(col0 + 16 * m + (lane & 15)) * DM + 128 * w + 32 * s + 8 * (lane >> 4));
            }
        f32x4 acc[4][4];
#pragma unroll
        for (int m = 0; m < 4; ++m)
#pragma unroll
            for (int n = 0; n < 4; ++n) acc[m][n] = (f32x4){0.f, 0.f, 0.f, 0.f};
#pragma unroll
        for (int s = 0; s < 4; ++s)
#pragma unroll
            for (int m = 0; m < 4; ++m)
#pragma unroll
                for (int n = 0; n < 4; ++n) acc[m][n] = __builtin_amdgcn_mfma_f32_16x16x32_bf16(__builtin_bit_cast(bf16x8, bf[n][s]), __builtin_bit_cast(bf16x8, af[m][s]), acc[m][n], 0, 0, 0);
        __syncthreads();
        float* part_l = (float*)lds + w * 4096;
#pragma unroll
        for (int m = 0; m < 4; ++m)
#pragma unroll
            for (int n = 0; n < 4; ++n) { const int r = 16 * m + (lane & 15), ch = 4 * n + (lane >> 4); *(f32x4*)(part_l + r * 64 + ((ch ^ (r & 15)) << 2)) = acc[m][n]; }
        __syncthreads();
        const int r = tid >> 3, j = tid & 7, row = row0 + r, col = col0 + 8 * j;
        f32x4 s0 = (f32x4){0.f, 0.f, 0.f, 0.f}, s1 = s0;
#pragma unroll
        for (int ww = 0; ww < 8; ++ww) { const float* pl = (const float*)lds + ww * 4096 + r * 64; s0 += *(const f32x4*)(pl + (((2 * j) ^ (r & 15)) << 2)); s1 += *(const f32x4*)(pl + (((2 * j + 1) ^ (r & 15)) << 2)); }
        if (MODE == 0) {
            const float* xr = P.x_sample + (size_t)(row - MP) * DM + col;
            const f32x4 h0 = *(const f32x4*)xr + s0, h1 = *(const f32x4*)(xr + 4) + s1;
            u32x4 wv; wv.x = pack2(h0[0], h0[1]); wv.y = pack2(h0[2], h0[3]); wv.z = pack2(h1[0], h1[1]); wv.w = pack2(h1[2], h1[3]);
            *(u32x4*)(P.HB + (size_t)row * DM + col) = wv;
            float ss = (h0[0] * h0[0] + h0[1] * h0[1]) + (h0[2] * h0[2] + h0[3] * h0[3]) + (h1[0] * h1[0] + h1[1] * h1[1]) + (h1[2] * h1[2] + h1[3] * h1[3]);
            ss = oct_allsum(ss);
            if (j == 0) P.part[(size_t)row * 16 + (col0 >> 6)] = ss;
        } else {
            float ss = 0.f;
#pragma unroll
            for (int i = 0; i < 4; ++i) { const f32x4 p4 = *(const f32x4*)(P.part + (size_t)row * 16 + i * 4); ss += (p4[0] + p4[1]) + (p4[2] + p4[3]); }
            const float rs = rsqrtf(ss * (1.0f / DM) + 1e-6f);
            const u32x4 hh = *(const u32x4*)(P.HB + (size_t)row * DM + col), pl = *(const u32x4*)(P.PLS + (size_t)(row - MP) * DM + col);
            f32x4 o0, o1;
            o0[0] = bflo(hh.x) + sigmoidf_(s0[0] * rs) * bflo(pl.x); o0[1] = bfhi(hh.x) + sigmoidf_(s0[1] * rs) * bfhi(pl.x);
            o0[2] = bflo(hh.y) + sigmoidf_(s0[2] * rs) * bflo(pl.y); o0[3] = bfhi(hh.y) + sigmoidf_(s0[3] * rs) * bfhi(pl.y);
            o1[0] = bflo(hh.z) + sigmoidf_(s1[0] * rs) * bflo(pl.z); o1[1] = bfhi(hh.z) + sigmoidf_(s1[1] * rs) * bfhi(pl.z);
            o1[2] = bflo(hh.w) + sigmoidf_(s1[2] * rs) * bflo(pl.w); o1[3] = bfhi(hh.w) + sigmoidf_(s1[3] * rs) * bfhi(pl.w);
            float* yp = P.y_all + (size_t)row * DM + col; *(f32x4*)yp = o0; *(f32x4*)(yp + 4) = o1;
        }
    }
}

#ifndef REP_P0
#define REP_P0 1
#endif
#ifndef REP_P1
#define REP_P1 1
#endif
#ifndef REP_PREP
#define REP_PREP 1
#endif
#ifndef REP_ATTN
#define REP_ATTN 1
#endif
#ifndef REP_SCAN
#define REP_SCAN 1
#endif
#ifndef REP_CHA
#define REP_CHA 1
#endif
#ifndef REP_CHB
#define REP_CHB 1
#endif
#ifndef REP_P7
#define REP_P7 1
#endif
#ifndef REP_POST
#define REP_POST 1
#endif
#ifndef REP_ATTS
#define REP_ATTS 1
#endif
#ifndef REP_P5
#define REP_P5 1
#endif
__device__ __forceinline__ int opq(int x) { asm volatile("" : "+s"(x)); return x; }
typedef const __attribute__((address_space(4))) Params* KParams;
__device__ __forceinline__ KParams opq_kp(KParams p) { asm volatile("" : "+s"(p)); return p; }
#define LDS_RING 131072
#define LDS_TOTAL (LDS_RING + 1024 + 16384 + 512)
__global__ void __launch_bounds__(NTHR, 2) fwd_kernel(Params P0_) {
    extern __shared__ __attribute__((aligned(16))) unsigned char lds[];
    const int tid = threadIdx.x;
    volatile LAS unsigned* bst = (volatile LAS unsigned*)((LAS unsigned char*)lds + LDS_RING);
    if (tid < 4) bst[tid] = 0u;
    __syncthreads();
    int wid_s = __builtin_amdgcn_readfirstlane(tid >> 6); asm volatile("" : "+s"(wid_s));
    XcdBarrier bar = xcd_barrier_post(P0_.bar, bst, wid_s);
    const int G = gridDim.x, cu = blockIdx.x;
    const KParams Pk = (KParams)__builtin_amdgcn_kernarg_segment_ptr();
#if defined(__HIP_DEVICE_COMPILE__)
#define PLOAD Params P = *opq_kp(Pk); P.wid = wid_s;
#else
#define PLOAD Params P = P0_; P.wid = wid_s;
#endif

    for (int rep = 0, nrep_ = opq(REP_P0); rep < nrep_; ++rep) { PLOAD p0_prologue(P, lds); }
    xcd_barrier(bar);
    for (int rep = 0, nrep_ = opq(REP_P1); rep < nrep_; ++rep) { PLOAD Gemm g{P.XB, P.Wt_in, MT, DINP, DM, DM, P.wid}; StaticOrder S; S.init(MT, DINP, G, cu); EpiInProj E{P.H};
      gemm_phase<EpiInProj, StaticOrder, true, true>((LAS unsigned char*)lds, g, S, E); }
    { PLOAD Gemm g{P.PB, P.Wt_ple, MT, DM, 256, 256, P.wid}; TailOrder S{(MT / 256) * 4, G, (MT / 256) * (DINP / 256) - 7 * G, cu}; EpiPle E{P.y_all, P.PLS};
      gemm_phase<EpiPle, TailOrder, true, true>((LAS unsigned char*)lds, g, S, E); }
    xcd_barrier(bar);
    { int flip = ((int)blockIdx.x >> 7) & 1; asm volatile("" : "+s"(flip));
      if (flip == 0) {
          for (int rep = 0, nrep_ = opq(REP_ATTN); rep < nrep_; ++rep) { PLOAD p3_attn_prompt(P, lds); }
          for (int rep = 0, nrep_ = opq(REP_ATTS); rep < nrep_; ++rep) { PLOAD p3_attn_sample(P, lds); }
          for (int rep = 0, nrep_ = opq(REP_PREP); rep < nrep_; ++rep) { PLOAD p2_rwkv_prep(P, lds); }
      }
      for (int rep = 0, nrep_ = opq(REP_CHA); rep < nrep_; ++rep) { PLOAD p3_chunk_a(P, lds); }
      if (flip != 0) {
          for (int rep = 0, nrep_ = opq(REP_ATTN); rep < nrep_; ++rep) { PLOAD p3_attn_prompt(P, lds); }
          for (int rep = 0, nrep_ = opq(REP_ATTS); rep < nrep_; ++rep) { PLOAD p3_attn_sample(P, lds); }
          for (int rep = 0, nrep_ = opq(REP_PREP); rep < nrep_; ++rep) { PLOAD p2_rwkv_prep(P, lds); }
      }
    }
    xcd_barrier(bar);
    for (int rep = 0, nrep_ = opq(REP_CHB); rep < nrep_; ++rep) { PLOAD p4_chunk_b(P, lds); }
    for (int rep = 0, nrep_ = opq(REP_SCAN); rep < nrep_; ++rep) { PLOAD p3_scan(P, lds); }
    xcd_barrier(bar);
    for (int rep = 0, nrep_ = opq(REP_POST); rep < nrep_; ++rep) { PLOAD p4_post(P); }
    xcd_barrier(bar);
    for (int rep = 0, nrep_ = opq(REP_P5); rep < nrep_; ++rep) {
    { PLOAD Gemm g{P.H + OFF_ZR, P.Wt_out, MP, DM, DM, DIN, P.wid}; StaticOrder S; S.init(MP, DM, G, cu); EpiOut E{P.HB, P.part, P.rstd_x};
      gemm_phase<EpiOut, StaticOrder, true, true>((LAS unsigned char*)lds, g, S, E);
      }
      { PLOAD g64_phase<0>(P, lds, P.H + OFF_ZR, DIN, P.Wt_out); }
    }
    xcd_barrier(bar);
    for (int rep = 0, nrep_ = opq(REP_P7); rep < nrep_; ++rep) { { PLOAD Gemm g{P.HB, P.Wt_gate, MP, DM, DM, DM, P.wid}; StaticOrder S; S.init(MP, DM, G, cu); EpiGate E{P.y_all, P.HB, P.part};
      gemm_phase<EpiGate, StaticOrder, true, true>((LAS unsigned char*)lds, g, S, E);
      }
      { PLOAD g64_phase<1>(P, lds, P.HB, DM, P.Wt_gate); } }
}

extern "C" void kernel_launch(void* const* d_in, const int* in_sizes, int n_in, void* d_out, int out_size, void* d_ws, size_t ws_size, hipStream_t stream) {
    static int grid = 0;
    if (grid == 0) {
        int dev = 0, cus = 0, per_cu = 0;
        hipGetDevice(&dev);
        hipDeviceGetAttribute(&cus, hipDeviceAttributeMultiprocessorCount, dev);
        if (hipFuncSetAttribute((const void*)fwd_kernel, hipFuncAttributeMaxDynamicSharedMemorySize, LDS_TOTAL) != hipSuccess) { fprintf(stderr, "hipFuncSetAttribute failed\n"); }
        hipOccupancyMaxActiveBlocksPerMultiprocessor(&per_cu, (const void*)fwd_kernel, NTHR, LDS_TOTAL);
        (void)hipGetLastError();
        grid = 256;
        if (cus != 256) fprintf(stderr, "warning: %d CUs reported; this kernel is written for 256\n", cus);
        if (per_cu < 1) fprintf(stderr, "occupancy query says %d blocks/CU\n", per_cu);
    }
    Params P{};
    const float** in = (const float**)&P.x_prompt;
    for (int i = 0; i < 27; ++i) in[i] = (const float*)d_in[i];
    float* out = (float*)d_out;
    P.y_all = out;
    P.o_state_p = out + (size_t)MT * DM;
    P.o_state_s = P.o_state_p + 262144;
    P.o_shift_p = P.o_state_s + 4194304;
    P.o_shift_s = P.o_shift_p + 13312;
    P.o_ck_p = P.o_shift_s + 212992;
    P.o_ck_s = P.o_ck_p + 131072;
    P.o_cv_p = P.o_ck_s + 2097152;
    P.o_cv_s = P.o_cv_p + 131072;
    unsigned char* ws = (unsigned char*)d_ws;
    size_t off = 0;
    auto take = [&](size_t bytes) { unsigned char* p = ws + off; off += (bytes + 255) & ~(size_t)255; return p; };
    P.bar = (unsigned*)take(16384);
    P.Wt_in = (bf16_t*)take((size_t)DINP * DM * 2);
    P.Wt_out = (bf16_t*)take((size_t)DM * DM * 2);
    P.Wt_gate = (bf16_t*)take((size_t)DM * DM * 2);
    P.Wt_ple = (bf16_t*)take((size_t)DM * 256 * 2);
    P.rstd_x = (float*)take((size_t)MT * 4);
    P.part = (float*)take((size_t)MT * 16 * 4);
    P.rk = (float*)take((size_t)MT * 8 * 4);
    P.WLd = (bf16_t*)take(8 * 64 * 64 * 2);
    P.WLa = (bf16_t*)take(8 * 64 * 64 * 2);
    P.PLS = (bf16_t*)take((size_t)MS * DM * 2);
    P.H = (bf16_t*)take((size_t)MT * DIN * 2);
    P.XB = (bf16_t*)take((size_t)MT * DM * 2);
    P.SA_G1 = (bf16_t*)take((size_t)4096 * 4096 * 2);
    P.SA_PC = (bf16_t*)take((size_t)4096 * 4096 * 2);
    P.SA_QT = (bf16_t*)take((size_t)4096 * 4096 * 2);
    P.SA_YL = (bf16_t*)take((size_t)4096 * 4096 * 2);
    P.SA_GC = (float*)take((size_t)4096 * 64 * 4);
    P.YR = (bf16_t*)take((size_t)MT * 512 * 2);
    P.Rv = (bf16_t*)take((size_t)MT * 512 * 2);
    P.Rr = (bf16_t*)take((size_t)MS * 512 * 2) - (size_t)MP * 512;
    P.Re = (bf16_t*)take((size_t)MS * 512 * 2) - (size_t)MP * 512;
    P.Rk = (bf16_t*)take((size_t)MS * 512 * 2) - (size_t)MP * 512;
    P.Rkk = (bf16_t*)take((size_t)MS * 512 * 2) - (size_t)MP * 512;
    P.Reta = (bf16_t*)take((size_t)MS * 512 * 2) - (size_t)MP * 512;
    P.PB = (bf16_t*)P.o_state_p;
    P.PLE = nullptr;
    P.HB = P.XB;
    if (off > ws_size) { fprintf(stderr, "workspace too small: need %zu have %zu\n", off, ws_size); return; }
    hipMemsetAsync(P.bar, 0, 16384, stream);
    hipLaunchKernelGGL(fwd_kernel, dim3(grid), dim3(NTHR), LDS_TOTAL, stream, P);
}
```

```cpp
#define DESYNC_SLEEPS ((xc_ >> 1) & 3)
#include <hip/hip_runtime.h>
#include <stdint.h>
#include <cstdio>

#define LAS __attribute__((address_space(3)))
typedef float f32x16 __attribute__((ext_vector_type(16)));

#define MP 32768
#define MS 1024
#define MT 33792
#define TP 4096
#define TS 8
#define DM 1024
#define DIN 3456
#define DINP 3584
#define DSH 1664
#define OFF_ZR 1664
#define OFF_Q 2176
#define OFF_K 2688
#define OFF_V 2816
#define OFF_ZA 2944
#define NTHR 512

__device__ __forceinline__ int lane_id_() { int l; asm volatile("v_mbcnt_lo_u32_b32 %0, -1, 0\n\tv_mbcnt_hi_u32_b32 %0, -1, %0" : "=v"(l)); return l; }
#define TIDX_(wid) ((wid) * 64 + lane_id_())
namespace pg8 {
#define PG8_LAS __attribute__((address_space(3)))
typedef unsigned short bf16_t;
typedef short bf16x8 __attribute__((ext_vector_type(8)));
typedef float f32x4 __attribute__((ext_vector_type(4)));
typedef unsigned u32x4 __attribute__((ext_vector_type(4)));
constexpr int BM = 256, BK = 64, HALF = 128, HTB = HALF * BK * 2  , STAGE_BYTES = 8 * HTB, NXCD = 8, WGM = 8;

__host__ __device__ __forceinline__ int lds_byte(int r, int c) { const int st = (r >> 4) * 2 + (c >> 5), rr = r & 15, cc = c & 31, ob = rr * 64 + cc * 2; return st * 1024 + (ob ^ (((ob >> 9) & 1) << 5)); }
__host__ __device__ __forceinline__ void stage_rc(int b, int& R, int& C) { const int st = b / 1024, sb = b % 1024, swz = sb ^ (((sb >> 9) & 1) << 5); R = (st >> 1) * 16 + swz / 64; C = (st & 1) * 32 + (swz % 64) / 2; }
__host__ __device__ __forceinline__ int perm32(int rho) { const int n = rho >> 4, i = rho & 15; return 8 * (i >> 2) + 4 * n + (i & 3); }

struct Unit { int pm, pn; };
struct Gemm { const bf16_t* A; const bf16_t* Bt; int M, N, K, lda, wid; };

struct StaticOrder {
    int nM, nN, nwg, G, c;
    __host__ __device__ void init(int M, int N, int G_, int c_) { nM = M / BM; nN = N / BM; nwg = nM * nN; G = G_; c = c_; }
    __host__ __device__ bool next(int i, Unit& u) const {
        const long L = (long)i * G + c; if (L >= nwg) return false;
        int wgid = (int)L; { const int q = nwg / NXCD, r = nwg % NXCD, xcd = wgid % NXCD, off = wgid / NXCD; wgid = (xcd < r ? xcd * (q + 1) : r * (q + 1) + (xcd - r) * q) + off; }
        const int nig = WGM * nN, gid = wgid / nig, fm = gid * WGM, gsz = (nM - fm) < WGM ? (nM - fm) : WGM;
        u.pm = fm + ((wgid % nig) % gsz); u.pn = (wgid % nig) / gsz; return true;
    }
    __device__ __forceinline__ void a_ready(const Unit&) const {}
    __device__ __forceinline__ void done(const Unit&) const {}
};

typedef float f32x2_t __attribute__((ext_vector_type(2)));
typedef __bf16 bf16x2_t __attribute__((ext_vector_type(2)));
__device__ __forceinline__ unsigned pack2(float lo, float hi) { f32x2_t v = {lo, hi}; bf16x2_t b = __builtin_convertvector(v, bf16x2_t); return __builtin_bit_cast(unsigned, b); }
__device__ __forceinline__ bf16_t f2bf(float f) { return (bf16_t)(pack2(f, 0.f) & 0xffffu); }
__device__ __forceinline__ float bf2f(bf16_t h) { return __uint_as_float(((unsigned)h) << 16); }
__device__ __forceinline__ float bflo(unsigned u) { return __uint_as_float(u << 16); }
__device__ __forceinline__ float bfhi(unsigned u) { return __uint_as_float(u & 0xffff0000u); }
__device__ __forceinline__ float fexp2_(float x) { return __builtin_amdgcn_exp2f(x); }
__device__ __forceinline__ float frcp_(float x) { return __builtin_amdgcn_rcpf(x); }
__device__ __forceinline__ float sigmoidf_(float x) { return frcp_(1.0f + fexp2_(-1.44269504f * x)); }
__device__ __forceinline__ float wave_sum(float x) {
#pragma unroll
    for (int o = 32; o >= 1; o >>= 1) x += __shfl_xor(x, o);
    return x;
}
template <int CTRL> __device__ __forceinline__ float dpp_f(float x) {
    return __builtin_bit_cast(float, __builtin_amdgcn_update_dpp(0, __builtin_bit_cast(int, x), CTRL, 0xF, 0xF, false));
}
__device__ __forceinline__ float row16_allsum(float x) {
    x += dpp_f<0x128>(x); x += dpp_f<0x124>(x); x += dpp_f<0x122>(x); x += dpp_f<0x121>(x);
    return x;
}

struct EpiInProj {
    static constexpr bool PERM = true, AFTER_DRAIN = false;
    bf16_t* H;
    __device__ __forceinline__ void operator()(const f32x4 (&acc)[2][2][4][2], const Unit& u, int wr, int wc, int fr, int fq) const {
        const int row0 = u.pm * 256 + wr * 64 + fr, col0 = u.pn * 256 + wc * 32 + 8 * fq;
#pragma unroll
        for (int ai = 0; ai < 2; ++ai)
#pragma unroll
            for (int m = 0; m < 4; ++m) {
                const int row = row0 + ai * 128 + m * 16;
#pragma unroll
                for (int bj = 0; bj < 2; ++bj) {
                    const int col = col0 + bj * 128;
                    if (col < DIN) {
                        const f32x4 v0 = acc[ai][bj][m][0], v1 = acc[ai][bj][m][1];
                        u32x4 w; w.x = pack2(v0[0], v0[1]); w.y = pack2(v0[2], v0[3]); w.z = pack2(v1[0], v1[1]); w.w = pack2(v1[2], v1[3]);
                        *(u32x4*)(H + (size_t)row * DIN + col) = w;
                    }
                }
            }
    }
};
__device__ __forceinline__ unsigned char* ple_slot(float* y, int row, int pn, int wc, int fq) { return (unsigned char*)(y + (size_t)row * DM) + pn * 1024 + 512 + wc * 128 + fq * 32; }
struct EpiPle {
    static constexpr bool PERM = true, AFTER_DRAIN = false;
    float* y; bf16_t* pls;
    __device__ __forceinline__ void operator()(const f32x4 (&acc)[2][2][4][2], const Unit& u, int wr, int wc, int fr, int fq) const {
        const int row0 = u.pm * 256 + wr * 64 + fr;
#pragma unroll
        for (int ai = 0; ai < 2; ++ai)
#pragma unroll
            for (int m = 0; m < 4; ++m) {
                unsigned char* sl = ple_slot(y, row0 + ai * 128 + m * 16, u.pn, wc, fq);
#pragma unroll
                for (int bj = 0; bj < 2; ++bj) {
                    const f32x4 v0 = acc[ai][bj][m][0], v1 = acc[ai][bj][m][1];
                    u32x4 w; w.x = pack2(v0[0], v0[1]); w.y = pack2(v0[2], v0[3]); w.z = pack2(v1[0], v1[1]); w.w = pack2(v1[2], v1[3]);
                    *(u32x4*)(sl + bj * 16) = w;
                    if (u.pm >= MP / 256) *(u32x4*)(pls + (size_t)(row0 + ai * 128 + m * 16 - MP) * DM + u.pn * 256 + bj * 128 + wc * 32 + 8 * fq) = w;
                }
            }
    }
};
struct TailOrder {
    int n, G, c0, c;
    __device__ __forceinline__ bool next(int i, Unit& u) const { if (c < c0) return false; const int L = i * (G - c0) + (c - c0); if (L >= n) return false; u.pm = L >> 2; u.pn = L & 3; return true; }
    __device__ __forceinline__ void a_ready(const Unit&) const {}
    __device__ __forceinline__ void done(const Unit&) const {}
};
struct EpiOut {
    static constexpr bool PERM = true, AFTER_DRAIN = false;
    bf16_t* hb; float* part; const float* xs;
    __device__ __forceinline__ void operator()(const f32x4 (&acc)[2][2][4][2], const Unit& u, int wr, int wc, int fr, int fq) const {
        const int row0 = u.pm * 256 + wr * 64 + fr, col0 = u.pn * 256 + wc * 32 + 8 * fq;
        u32x4 xa[2], xb[2]; float sxa, sxb;
#define EO_LOAD(X, it) { const int row_ = row0 + ((it) >> 2) * 128 + ((it) & 3) * 16; const bf16_t* xr_ = hb + (size_t)row_ * DM + col0; X[0] = *(const u32x4*)xr_; X[1] = *(const u32x4*)(xr_ + 128); s##X = xs[row_]; }
#define EO_STEP(X, it) { const int ai_ = (it) >> 2, m_ = (it) & 3, row_ = row0 + ai_ * 128 + m_ * 16; float ss = 0.f; \
            _Pragma("unroll") for (int bj = 0; bj < 2; ++bj) { const u32x4 xv = X[bj]; \
                const f32x4 h0 = (f32x4){bflo(xv.x), bfhi(xv.x), bflo(xv.y), bfhi(xv.y)} * s##X + acc[ai_][bj][m_][0], h1 = (f32x4){bflo(xv.z), bfhi(xv.z), bflo(xv.w), bfhi(xv.w)} * s##X + acc[ai_][bj][m_][1]; \
                u32x4 w; w.x = pack2(h0[0], h0[1]); w.y = pack2(h0[2], h0[3]); w.z = pack2(h1[0], h1[1]); w.w = pack2(h1[2], h1[3]); \
                *(u32x4*)(hb + (size_t)row_ * DM + col0 + bj * 128) = w; \
                ss += (h0[0] * h0[0] + h0[1] * h0[1]) + (h0[2] * h0[2] + h0[3] * h0[3]) + (h1[0] * h1[0] + h1[1] * h1[1]) + (h1[2] * h1[2] + h1[3] * h1[3]); } \
            ss += __shfl_xor(ss, 16); ss += __shfl_xor(ss, 32); if (fq == 0) part[(size_t)row_ * 16 + u.pn * 4 + wc] = ss; }
        EO_LOAD(xa, 0)
        EO_LOAD(xb, 1) EO_STEP(xa, 0) EO_LOAD(xa, 2) EO_STEP(xb, 1) EO_LOAD(xb, 3) EO_STEP(xa, 2) EO_LOAD(xa, 4) EO_STEP(xb, 3)
        EO_LOAD(xb, 5) EO_STEP(xa, 4) EO_LOAD(xa, 6) EO_STEP(xb, 5) EO_LOAD(xb, 7) EO_STEP(xa, 6) EO_STEP(xb, 7)
#undef EO_LOAD
#undef EO_STEP
    }
};
struct EpiGate {
    static constexpr bool PERM = true, AFTER_DRAIN = false;
    float* y; const bf16_t* hb; const float* part;
    __device__ __forceinline__ void operator()(const f32x4 (&acc)[2][2][4][2], const Unit& u, int wr, int wc, int fr, int fq) const {
        const int row0 = u.pm * 256 + wr * 64 + fr, col0 = u.pn * 256 + wc * 32 + 8 * fq;
        u32x4 ha[2], hb2[2], pa[2], pb[2]; f32x4 qa[4], qb[4];
#define EG_LOAD(Hh, Pp, Qq, it) { const int row_ = row0 + ((it) >> 2) * 128 + ((it) & 3) * 16; \
            Hh[0] = *(const u32x4*)(hb + (size_t)row_ * DM + col0); Hh[1] = *(const u32x4*)(hb + (size_t)row_ * DM + col0 + 128); \
            { const unsigned char* sl_ = ple_slot(y, row_, u.pn, wc, fq); Pp[0] = *(const u32x4*)sl_; Pp[1] = *(const u32x4*)(sl_ + 16); } \
            _Pragma("unroll") for (int i = 0; i < 4; ++i) Qq[i] = *(const f32x4*)(part + (size_t)row_ * 16 + i * 4); }
#define EG_STEP(Hh, Pp, Qq, it) { const int ai_ = (it) >> 2, m_ = (it) & 3, row_ = row0 + ai_ * 128 + m_ * 16; \
            float ss = 0.f; _Pragma("unroll") for (int i = 0; i < 4; ++i) ss += (Qq[i][0] + Qq[i][1]) + (Qq[i][2] + Qq[i][3]); \
            const float rs = rsqrtf(ss * (1.0f / DM) + 1e-6f); \
            _Pragma("unroll") for (int bj = 0; bj < 2; ++bj) { const f32x4 a0 = acc[ai_][bj][m_][0], a1 = acc[ai_][bj][m_][1]; const u32x4 hh = Hh[bj], pl = Pp[bj]; f32x4 o0, o1; \
                o0[0] = bflo(hh.x) + sigmoidf_(a0[0] * rs) * bflo(pl.x); o0[1] = bfhi(hh.x) + sigmoidf_(a0[1] * rs) * bfhi(pl.x); \
                o0[2] = bflo(hh.y) + sigmoidf_(a0[2] * rs) * bflo(pl.y); o0[3] = bfhi(hh.y) + sigmoidf_(a0[3] * rs) * bfhi(pl.y); \
                o1[0] = bflo(hh.z) + sigmoidf_(a1[0] * rs) * bflo(pl.z); o1[1] = bfhi(hh.z) + sigmoidf_(a1[1] * rs) * bfhi(pl.z); \
                o1[2] = bflo(hh.w) + sigmoidf_(a1[2] * rs) * bflo(pl.w); o1[3] = bfhi(hh.w) + sigmoidf_(a1[3] * rs) * bfhi(pl.w); \
                float* yp = y + (size_t)row_ * DM + col0 + bj * 128; *(f32x4*)yp = o0; *(f32x4*)(yp + 4) = o1; } }
        EG_LOAD(ha, pa, qa, 0)
        EG_LOAD(hb2, pb, qb, 1) EG_STEP(ha, pa, qa, 0) EG_LOAD(ha, pa, qa, 2) EG_STEP(hb2, pb, qb, 1) EG_LOAD(hb2, pb, qb, 3) EG_STEP(ha, pa, qa, 2) EG_LOAD(ha, pa, qa, 4) EG_STEP(hb2, pb, qb, 3)
        EG_LOAD(hb2, pb, qb, 5) EG_STEP(ha, pa, qa, 4) EG_LOAD(ha, pa, qa, 6) EG_STEP(hb2, pb, qb, 5) EG_LOAD(hb2, pb, qb, 7) EG_STEP(ha, pa, qa, 6) EG_STEP(hb2, pb, qb, 7)
#undef EG_LOAD
#undef EG_STEP
    }
};

template <class Epi, class Sched, bool ALIGN_EPI = false, bool SP2 = false>
__device__ __forceinline__ void gemm_phase(PG8_LAS unsigned char* lds, const Gemm g, const Sched& S, const Epi& E) {
    int tid_o = TIDX_(g.wid); asm volatile("" : "+v"(tid_o));
    const int tid = tid_o, wid = __builtin_amdgcn_readfirstlane(tid >> 6), lane = tid & 63, wr = wid >> 2, wc = wid & 3, fr = lane & 15, fq = lane >> 4;
    const int K = g.K, nt = K / BK;
    unsigned voffA[2], voffB[2];
#pragma unroll
    for (int i = 0; i < 2; ++i) { int R, C; stage_rc(tid * 16 + i * 8192, R, C); const int Rb = Epi::PERM ? ((R & ~31) + perm32(R & 31)) : R;
        voffA[i] = (unsigned)(R * g.lda + C) * 2u; voffB[i] = (unsigned)(Rb * K + C) * 2u; }
    const size_t kstep = (size_t)(BK * 2);
    const size_t hstep = (size_t)HALF * K * 2;
    const size_t tstep = 2 * hstep;
    const size_t hstepA = (size_t)HALF * g.lda * 2, tstepA = 2 * hstepA;
    const unsigned ldsw = (unsigned)wid * 1024u;
    const int aoff = lds_byte(wr * 64 + fr, fq * 8), boff = lds_byte(wc * 32 + fr, fq * 8);
#define PG8_SA(b, h) (((b) * 2 + (h)) * HTB)
#define PG8_SB(b, h) ((4 + (b) * 2 + (h)) * HTB)
#define PG8_STAGE(bufoff, gbase, voff) do { _Pragma("unroll") for (int _i = 0; _i < 2; ++_i) \
        __builtin_amdgcn_global_load_lds((const unsigned*)((const char*)(gbase) + (voff)[_i]), (PG8_LAS unsigned*)(lds + (bufoff) + ldsw + _i * 8192), 16, 0, 0); } while (0)
#define PG8_LDA(dst, b, h) do { _Pragma("unroll") for (int m = 0; m < 4; ++m) _Pragma("unroll") for (int k = 0; k < 2; ++k) dst[m][k] = *(const PG8_LAS bf16x8*)(lds + PG8_SA(b, h) + aoff + m * 2048 + k * 1024); } while (0)
#define PG8_LDB(dst, b, h) do { _Pragma("unroll") for (int n = 0; n < 2; ++n) _Pragma("unroll") for (int k = 0; k < 2; ++k) dst[n][k] = *(const PG8_LAS bf16x8*)(lds + PG8_SB(b, h) + boff + n * 2048 + k * 1024); } while (0)
#define PG8_MMA(ai, bj, At, Bt) do { __builtin_amdgcn_s_setprio(1); _Pragma("unroll") for (int m = 0; m < 4; ++m) _Pragma("unroll") for (int n = 0; n < 2; ++n) _Pragma("unroll") for (int k = 0; k < 2; ++k) \
        acc[ai][bj][m][n] = __builtin_amdgcn_mfma_f32_16x16x32_bf16(Bt[n][k], At[m][k], acc[ai][bj][m][n], 0, 0, 0); __builtin_amdgcn_s_setprio(0); } while (0)
#define PG8_WAIT_V(n) asm volatile("s_waitcnt vmcnt(" #n ")" ::: "memory")
#define PG8_WAIT_L(n) asm volatile("s_waitcnt lgkmcnt(" #n ")" ::: "memory")
#define PG8_BAR __builtin_amdgcn_s_barrier()
#define PG8_SCHED __builtin_amdgcn_sched_barrier(0)
    Unit cur, nxt; int ui = 0;
    if (!S.next(0, cur)) return;
    f32x4 acc[2][2][4][2];
#pragma unroll
    for (int a = 0; a < 2; ++a)
#pragma unroll
        for (int b = 0; b < 2; ++b)
#pragma unroll
            for (int m = 0; m < 4; ++m)
#pragma unroll
                for (int n = 0; n < 2; ++n) acc[a][b][m][n] = (f32x4){0.f, 0.f, 0.f, 0.f};
    bf16x8 At[4][2], B0[2][2], B1[2][2];
    const char* cA = (const char*)g.A + (size_t)cur.pm * tstepA; const char* cB = (const char*)g.Bt + (size_t)cur.pn * tstep;
    S.a_ready(cur);
    if constexpr (SP2) {
        PG8_STAGE(PG8_SB(0, 0), cB, voffB); PG8_STAGE(PG8_SB(0, 1), cB + hstep, voffB); PG8_STAGE(PG8_SA(0, 0), cA, voffA); PG8_STAGE(PG8_SA(0, 1), cA + hstepA, voffA);
        if (wr == 1) PG8_BAR;
        PG8_WAIT_V(2); PG8_BAR;
        PG8_STAGE(PG8_SB(1, 0), cB + kstep, voffB); PG8_STAGE(PG8_SA(1, 0), cA + kstep, voffA); PG8_STAGE(PG8_SB(1, 1), cB + hstep + kstep, voffB);
        PG8_WAIT_V(6); PG8_BAR;
    } else {
        PG8_STAGE(PG8_SB(0, 0), cB, voffB); PG8_STAGE(PG8_SA(0, 0), cA, voffA); PG8_STAGE(PG8_SB(0, 1), cB + hstep, voffB); PG8_STAGE(PG8_SA(0, 1), cA + hstepA, voffA);
        if (wr == 1) PG8_BAR;
        PG8_WAIT_V(4); PG8_BAR;
        PG8_STAGE(PG8_SB(1, 0), cB + kstep, voffB); PG8_STAGE(PG8_SA(1, 0), cA + kstep, voffA); PG8_STAGE(PG8_SB(1, 1), cB + hstep + kstep, voffB);
        PG8_WAIT_V(6); PG8_BAR;
    }
    for (;;) {
        const bool has_next = S.next(ui + 1, nxt);
        const char* nA = has_next ? (const char*)g.A + (size_t)nxt.pm * tstepA : cA; const char* nB = has_next ? (const char*)g.Bt + (size_t)nxt.pn * tstep : cB;
#pragma unroll 1
        for (int t = 0; t < nt; t += 2) {
            const bool last = (t == nt - 2);
            const char* a1 = cA + (size_t)(t + 1) * kstep;
            const char* a2 = last ? nA : cA + (size_t)(t + 2) * kstep; const char* b2 = last ? nB : cB + (size_t)(t + 2) * kstep;
            const char* a3 = a2 + kstep; const char* b3 = b2 + kstep;
            if (last && has_next) S.a_ready(nxt);
            if constexpr (SP2) {
            PG8_LDB(B0, 0, 0); PG8_LDB(B1, 0, 1); PG8_SCHED; PG8_LDA(At, 0, 0); PG8_STAGE(PG8_SA(1, 1), a1 + hstepA, voffA);
            PG8_WAIT_V(8); PG8_WAIT_L(0); PG8_BAR; PG8_MMA(0, 0, At, B0); PG8_MMA(0, 1, At, B1); PG8_BAR; PG8_SCHED;
            PG8_LDA(At, 0, 1); PG8_STAGE(PG8_SB(0, 0), b2, voffB); PG8_STAGE(PG8_SB(0, 1), b2 + hstep, voffB); PG8_STAGE(PG8_SA(0, 0), a2, voffA);
            PG8_WAIT_V(8); PG8_WAIT_L(0); PG8_BAR; PG8_MMA(1, 0, At, B0); PG8_MMA(1, 1, At, B1); PG8_BAR; PG8_SCHED;
            PG8_LDB(B0, 1, 0); PG8_LDB(B1, 1, 1); PG8_SCHED; PG8_LDA(At, 1, 0); PG8_STAGE(PG8_SA(0, 1), a2 + hstepA, voffA);
            PG8_WAIT_V(8); PG8_WAIT_L(0); PG8_BAR; PG8_MMA(0, 0, At, B0); PG8_MMA(0, 1, At, B1); PG8_BAR; PG8_SCHED;
            PG8_LDA(At, 1, 1); PG8_STAGE(PG8_SB(1, 0), b3, voffB); PG8_STAGE(PG8_SB(1, 1), b3 + hstep, voffB); PG8_STAGE(PG8_SA(1, 0), a3, voffA);
            PG8_WAIT_V(8); PG8_WAIT_L(0); PG8_BAR; PG8_MMA(1, 0, At, B0); PG8_MMA(1, 1, At, B1); PG8_BAR; PG8_SCHED;
            } else {
            PG8_LDB(B0, 0, 0); PG8_SCHED; PG8_LDA(At, 0, 0); PG8_STAGE(PG8_SA(1, 1), a1 + hstepA, voffA);
            PG8_WAIT_L(8); PG8_BAR; PG8_WAIT_L(0); PG8_MMA(0, 0, At, B0); PG8_BAR; PG8_SCHED;
            PG8_LDB(B1, 0, 1); PG8_STAGE(PG8_SB(0, 0), b2, voffB);
            PG8_BAR; PG8_WAIT_L(0); PG8_MMA(0, 1, At, B1); PG8_BAR;
            PG8_LDA(At, 0, 1); PG8_STAGE(PG8_SA(0, 0), a2, voffA);
            PG8_BAR; PG8_WAIT_L(0); PG8_MMA(1, 0, At, B0); PG8_BAR; PG8_SCHED;
            PG8_STAGE(PG8_SB(0, 1), b2 + hstep, voffB);
            PG8_WAIT_V(6); PG8_BAR; PG8_MMA(1, 1, At, B1); PG8_BAR;
            PG8_LDB(B0, 1, 0); PG8_SCHED; PG8_LDA(At, 1, 0); PG8_STAGE(PG8_SA(0, 1), a2 + hstepA, voffA);
            PG8_WAIT_L(8); PG8_BAR; PG8_WAIT_L(0); PG8_MMA(0, 0, At, B0); PG8_BAR; PG8_SCHED;
            PG8_LDB(B1, 1, 1); PG8_STAGE(PG8_SB(1, 0), b3, voffB);
            PG8_BAR; PG8_WAIT_L(0); PG8_MMA(0, 1, At, B1); PG8_BAR;
            PG8_LDA(At, 1, 1); PG8_STAGE(PG8_SA(1, 0), a3, voffA);
            PG8_BAR; PG8_WAIT_L(0); PG8_MMA(1, 0, At, B0); PG8_BAR; PG8_SCHED;
            PG8_STAGE(PG8_SB(1, 1), b3 + hstep, voffB);
            PG8_WAIT_V(6); PG8_BAR; PG8_MMA(1, 1, At, B1); PG8_BAR;
            }
        }
        if constexpr (ALIGN_EPI) { if (wr == 0) PG8_BAR; }
        if constexpr (!Epi::AFTER_DRAIN) { E(acc, cur, wr, wc, fr, fq); S.done(cur); }
        if (!has_next) break;
#pragma unroll
        for (int a = 0; a < 2; ++a)
#pragma unroll
            for (int b = 0; b < 2; ++b)
#pragma unroll
                for (int m = 0; m < 4; ++m)
#pragma unroll
                    for (int n = 0; n < 2; ++n) acc[a][b][m][n] = (f32x4){0.f, 0.f, 0.f, 0.f};
        cur = nxt; cA = nA; cB = nB; ++ui;
        if constexpr (ALIGN_EPI) { if (wr == 1) PG8_BAR; }
    }
    PG8_WAIT_V(0);
    if constexpr (!ALIGN_EPI) { if (wr == 0) PG8_BAR; }
    PG8_BAR;
    if constexpr (Epi::AFTER_DRAIN) { E.fused(acc, cur, wr, wc, fr, fq, lds, wid, lane); S.done(cur); }
#undef PG8_SA
#undef PG8_SB
#undef PG8_STAGE
#undef PG8_LDA
#undef PG8_LDB
#undef PG8_MMA
#undef PG8_WAIT_V
#undef PG8_WAIT_L
#undef PG8_BAR
#undef PG8_SCHED
}
}
#define XB_TMO      128
#define XB_XCNT(j)  (256  + 64 * (j))
#define XB_XSUB(j)  (1280 + 64 * (j))
#define XB_XGEN(j)  (2304 + 64 * (j))
#define XB_TOP      3328
#define XB_TOPGEN   3392
#define XCD_BAR_WORDS 3456
#define XB_IDS      3520
#define XB_SPIN_CAP (1u << 18)
#define LAS __attribute__((address_space(3)))

__device__ __forceinline__ unsigned xb_ld(unsigned* p)              { return __hip_atomic_load(p, __ATOMIC_RELAXED, __HIP_MEMORY_SCOPE_AGENT); }
__device__ __forceinline__ unsigned xb_add(unsigned* p, unsigned v) { return __hip_atomic_fetch_add(p, v, __ATOMIC_RELAXED, __HIP_MEMORY_SCOPE_AGENT); }
__device__ __forceinline__ unsigned xb_xcc_id() { return (unsigned)__builtin_amdgcn_s_getreg((3 << 11) | 20) & 0xFu; }
#define XB_SPIN(cond, bar) do { unsigned _sp = 0; while (cond) { __builtin_amdgcn_s_sleep(1); \
    if ((++_sp & 255u) == 0u) { if (xb_ld(&(bar)[XB_TMO])) break; if (_sp > XB_SPIN_CAP) { atomicAdd(&(bar)[XB_TMO], 1u); break; } } } } while (0)

struct XcdBarrier {
    int wid; unsigned* bar; unsigned x;
    volatile LAS unsigned* st;
};

__device__ __forceinline__ XcdBarrier xcd_barrier_post(unsigned* bar, volatile LAS unsigned* st, int wid) {
    XcdBarrier b; b.wid = wid; b.bar = bar; b.x = xb_xcc_id(); b.st = st;
    if (TIDX_(wid) == 0) { (void)xb_add(&bar[XB_XCNT(b.x)], 1u); }
    return b;
}
__device__ __forceinline__ void xcd_barrier_complete(unsigned* bar, unsigned x, unsigned& nloc, unsigned& nx) {
    const unsigned G = gridDim.x * gridDim.y * gridDim.z;
    unsigned sum, cnt, mine, sp = 0u;
    for (;;) {
        sum = 0u; cnt = 0u; mine = 0u;
#pragma unroll
        for (unsigned j = 0; j < 16; ++j) { const unsigned c = xb_ld(&bar[XB_XCNT(j)]); sum += c; cnt += (c > 0u) ? 1u : 0u; mine = (j == x) ? c : mine; }
        if (sum == G) break;
        __builtin_amdgcn_s_sleep(1);
        if ((++sp & 255u) == 0u) { if (xb_ld(&bar[XB_TMO])) break; if (sp > XB_SPIN_CAP) { atomicAdd(&bar[XB_TMO], 1u); break; } }
    }
    nloc = mine > 0u ? mine : 1u; nx = cnt > 0u ? cnt : 1u;
}

__device__ __forceinline__ void xcd_barrier(const XcdBarrier& b) {
    asm volatile("s_waitcnt vmcnt(0)" ::: "memory");
    __syncthreads();
    if (TIDX_(b.wid) == 0) {
        unsigned* bar = b.bar;
        __builtin_amdgcn_s_waitcnt(0);
        unsigned nloc = b.st[0], nx = b.st[1];
        if (nloc == 0u) { xcd_barrier_complete(bar, b.x, nloc, nx); b.st[0] = nloc; b.st[1] = nx; }
        const unsigned old = xb_add(&bar[XB_XSUB(b.x)], 1u);
        const unsigned gen = old / nloc;
        if (old + 1u == (gen + 1u) * nloc) {
            __builtin_amdgcn_fence(__ATOMIC_RELEASE, "agent");
            asm volatile("s_waitcnt vmcnt(0)" ::: "memory");
            const unsigned og = xb_add(&bar[XB_TOP], 1u);
            const unsigned tg = og / nx;
            if (og + 1u == (tg + 1u) * nx) xb_add(&bar[XB_TOPGEN], 1u);
            else XB_SPIN(xb_ld(&bar[XB_TOPGEN]) == tg, bar);
            __builtin_amdgcn_fence(__ATOMIC_ACQUIRE, "agent");
            xb_add(&bar[XB_XGEN(b.x)], 1u);
            asm volatile("s_waitcnt vmcnt(0)" ::: "memory");
        } else {
            XB_SPIN(xb_ld(&bar[XB_XGEN(b.x)]) == gen, bar);
            __builtin_amdgcn_fence(__ATOMIC_ACQUIRE, "agent");
            asm volatile("s_waitcnt vmcnt(0)" ::: "memory");
        }
    }
    __syncthreads();
}

__device__ __forceinline__ void xcd_check(const XcdBarrier& b) {
    const int t = TIDX_(b.wid);
    bool ok = true;
    if (t < (int)gridDim.x && t < 512) { const unsigned v = xb_ld(&b.bar[XB_IDS + t]), r = xb_ld(&b.bar[XB_IDS + (t & 7)]); ok = (v != 0u) && (v == r); }
    if (!ok) b.st[3] = 1u;
    __syncthreads();
    if (t == 0) b.st[2] = (b.st[3] == 0u && b.st[0] == 32u && b.st[1] == 8u && gridDim.x == 256u) ? 1u : 2u;
    __syncthreads();
}
__device__ __forceinline__ void xcd_barrier_local(const XcdBarrier& b) {
    if (b.st[2] != 1u) { xcd_barrier(b); return; }
    asm volatile("s_waitcnt vmcnt(0)" ::: "memory");
    __syncthreads();
    if (TIDX_(b.wid) == 0) {
        unsigned* bar = b.bar;
        __builtin_amdgcn_s_waitcnt(0);
        const unsigned nloc = b.st[0];
        const unsigned old = xb_add(&bar[XB_XSUB(b.x)], 1u);
        const unsigned gen = old / nloc;
        if (old + 1u == (gen + 1u) * nloc) xb_add(&bar[XB_XGEN(b.x)], 1u);
        else XB_SPIN(xb_ld(&bar[XB_XGEN(b.x)]) == gen, bar);
        __builtin_amdgcn_fence(__ATOMIC_ACQUIRE, "agent");
        asm volatile("s_waitcnt vmcnt(0)" ::: "memory");
    }
    __syncthreads();
}

using namespace pg8;

struct Params {
    const float *x_prompt, *x_sample, *state_rwkv, *state_shift, *cache_k, *cache_v, *p_prompt, *p_sample, *g_norm, *w_in, *mu, *w0, *w_dec2, *a0, *w_a2,
        *k_k, *k_a, *r_k, *lnx_w, *lnx_b, *q_norm_w, *k_norm_w, *sinks, *w_out, *g_ple, *w_ple_gate, *w_ple_proj;
    float *y_all, *o_state_p, *o_state_s, *o_shift_p, *o_shift_s, *o_ck_p, *o_ck_s, *o_cv_p, *o_cv_s;
    unsigned* bar;
    bf16_t *Wt_in, *Wt_out, *Wt_gate, *Wt_ple, *H, *XB, *Rr, *Re, *Rk, *Rv, *Rkk, *Reta, *PB, *PLE, *HB, *SA_G1, *SA_PC, *SA_QT, *SA_YL, *YR, *WLd, *WLa, *PLS;
    float *rstd_x, *part, *rk, *SA_GC;
    int wid;
};

__device__ __forceinline__ void p0_prologue(const Params& P, unsigned char* lds) {
    int tid_o = TIDX_(P.wid); asm volatile("" : "+v"(tid_o)); const int tid = tid_o, lane = tid & 63, wave = tid >> 6;
    float* tile = (float*)lds;
#define P0_DECODE(it_) const float* src; const float* scale; bf16_t* dst; int K, N, kt, nt; { int r = (it_); \
        if (r < 864) { src = P.w_in; scale = P.g_norm; dst = P.Wt_in; K = DM; N = DIN; kt = r / 54; nt = r % 54; } \
        else if ((r -= 864) < 256) { src = P.w_out; scale = nullptr; dst = P.Wt_out; K = DM; N = DM; kt = r >> 4; nt = r & 15; } \
        else if ((r -= 256) < 256) { src = P.w_ple_gate; scale = P.g_ple; dst = P.Wt_gate; K = DM; N = DM; kt = r >> 4; nt = r & 15; } \
        else { r -= 256; src = P.w_ple_proj; scale = nullptr; dst = P.Wt_ple; K = 256; N = DM; kt = r >> 4; nt = r & 15; } } \
        const int k0 = kt * 64, n0 = nt * 64, tx = tid & 63, ty = tid >> 6;
    { const int gw = (int)blockIdx.x * 8 + wave;
      if (gw < 1440) {
        P0_DECODE(gw)
        unsigned char* T = lds + wave * (64 * 144);
        const int kr = lane >> 4, nc = lane & 15;
        f32x4 v[16];
#pragma unroll
        for (int i = 0; i < 16; ++i) { const int k = kr + 4 * i; v[i] = *(const f32x4*)(src + (size_t)(k0 + k) * N + n0 + 4 * nc); if (scale) v[i] *= scale[k0 + k]; }
#pragma unroll
        for (int i = 0; i < 16; ++i) { const int k = kr + 4 * i;
#pragma unroll
            for (int j = 0; j < 4; ++j) *(bf16_t*)(T + (4 * nc + j) * 144 + 2 * k) = f2bf(v[i][j]); }
        asm volatile("s_waitcnt lgkmcnt(0)" ::: "memory");
#pragma unroll
        for (int c = 0; c < 8; ++c) { const u32x4 w = *(const u32x4*)(T + lane * 144 + 16 * c); *(u32x4*)(dst + (size_t)(n0 + lane) * K + k0 + 8 * c) = w; }
        (void)tx; (void)ty; (void)tile;
      } }
#undef P0_DECODE
    for (int i = blockIdx.x * NTHR + tid; i < 2 * 8 * 64 * 8; i += gridDim.x * NTHR) {
        const int which = i >> 12, r = i & 4095, hh = r >> 9, ch = (r >> 3) & 63, jc = r & 7;
        const float* src = (which ? P.w_a2 : P.w_dec2) + hh * 64 + ch;
        u32x4 wv; wv.x = pack2(src[(8 * jc + 0) * 512], src[(8 * jc + 1) * 512]); wv.y = pack2(src[(8 * jc + 2) * 512], src[(8 * jc + 3) * 512]);
        wv.z = pack2(src[(8 * jc + 4) * 512], src[(8 * jc + 5) * 512]); wv.w = pack2(src[(8 * jc + 6) * 512], src[(8 * jc + 7) * 512]);
        *(u32x4*)((which ? P.WLa : P.WLd) + (size_t)hh * 4096 + ch * 64 + jc * 8) = wv;
    }
    for (int i = blockIdx.x * NTHR + tid; i < (DINP - DIN) * DM / 8; i += gridDim.x * NTHR) *(u32x4*)(P.Wt_in + (size_t)DIN * DM + (size_t)i * 8) = (u32x4){0u, 0u, 0u, 0u};
    for (int row0 = blockIdx.x * 8 + wave; row0 < MT; row0 += gridDim.x * 8 * 4) {
        f32x4 v[4][4];
#pragma unroll
        for (int q = 0; q < 4; ++q) { const int row = row0 + q * gridDim.x * 8;
            if (row < MT) { const float* src = row < MP ? P.x_prompt + (size_t)row * DM : P.x_sample + (size_t)(row - MP) * DM;
#pragma unroll
                for (int i = 0; i < 4; ++i) v[q][i] = *(const f32x4*)(src + (lane + 64 * i) * 4); } }
#pragma unroll
        for (int q = 0; q < 4; ++q) { const int row = row0 + q * gridDim.x * 8;
            if (row < MT) { float ss = 0.f;
#pragma unroll
                for (int i = 0; i < 4; ++i) { const f32x4 x = v[q][i]; ss += (x[0] * x[0] + x[1] * x[1]) + (x[2] * x[2] + x[3] * x[3]); }
                ss = wave_sum(ss);
                const float ms = ss * (1.0f / DM) + 1e-6f, rs = rsqrtf(ms);
#pragma unroll
                for (int i = 0; i < 4; ++i) { const f32x4 x = v[q][i] * rs;
                    *(uint2*)(P.XB + (size_t)row * DM + (lane + 64 * i) * 4) = make_uint2(pack2(x[0], x[1]), pack2(x[2], x[3])); }
                if (lane == 0) P.rstd_x[row] = sqrtf(ms); } }
    }
    for (size_t i = (size_t)blockIdx.x * NTHR + tid; i < (size_t)MT * 64; i += (size_t)gridDim.x * NTHR * 4) {
        f32x4 v[4];
#pragma unroll
        for (int q = 0; q < 4; ++q) { const size_t e = (i + (size_t)q * gridDim.x * NTHR) * 4; if (e < (size_t)MT * 256) v[q] = *(const f32x4*)(e < (size_t)MP * 256 ? P.p_prompt + e : P.p_sample + (e - (size_t)MP * 256)); }
#pragma unroll
        for (int q = 0; q < 4; ++q) { const size_t e = (i + (size_t)q * gridDim.x * NTHR) * 4; if (e < (size_t)MT * 256) *(uint2*)(P.PB + e) = make_uint2(pack2(v[q][0], v[q][1]), pack2(v[q][2], v[q][3])); }
    }

}


#define PR_ROWB 3344
#define PR_FS 0
#define PR_AT (18 * PR_ROWB)
#define PR_CONST (PR_AT + 4096)
__device__ __forceinline__ void p2_rwkv_prep(const Params& P, unsigned char* lds) {
    int tid_o = TIDX_(P.wid); asm volatile("" : "+v"(tid_o)); const int tid = tid_o, lane = tid & 63, h = tid >> 6;
    const bf16_t* H = P.H;
    float* cst = (float*)(lds + PR_CONST);
    __syncthreads();
    { cst[tid] = P.w0[tid]; cst[512 + tid] = P.a0[tid]; cst[1024 + tid] = P.mu[tid]; cst[1536 + tid] = P.mu[512 + tid]; cst[2048 + tid] = P.mu[1024 + tid];
      cst[2560 + tid] = P.k_k[tid]; cst[3072 + tid] = P.k_a[tid]; cst[3584 + tid] = P.r_k[tid]; }
    bf16x8 wdf[4][2], waf[4][2];
#pragma unroll
    for (int n = 0; n < 4; ++n)
#pragma unroll
        for (int s = 0; s < 2; ++s) {
            const int ch = h * 64 + 16 * n + (lane & 15), j0 = 32 * s + 8 * (lane >> 4);
            u32x4 a, b;
#pragma unroll
            for (int q = 0; q < 4; ++q) {
                a[q] = pack2(P.w_dec2[(j0 + 2 * q) * 512 + ch], P.w_dec2[(j0 + 2 * q + 1) * 512 + ch]);
                b[q] = pack2(P.w_a2[(j0 + 2 * q) * 512 + ch], P.w_a2[(j0 + 2 * q + 1) * 512 + ch]);
            }
            wdf[n][s] = __builtin_bit_cast(bf16x8, a); waf[n][s] = __builtin_bit_cast(bf16x8, b);
        }
    const int atok = tid >> 5, aj = (tid & 31) * 4;
    float amu[4];
#pragma unroll
    for (int q = 0; q < 4; ++q) amu[q] = P.mu[1536 + aj + q];
#define PR_FILL(unit) { const int r0_ = (unit) * 16; const bool smp_ = r0_ >= MP; int tid_ = tid; asm volatile("" : "+v"(tid_)); \
        _Pragma("unroll") for (int hb = 0; hb < 2; ++hb) { u32x4 pre[4]; \
        _Pragma("unroll") for (int i = 0; i < 4; ++i) { const int id = tid_ + NTHR * (hb * 4 + i); const int row = id / 208, cc = id - row * 208; u32x4 v = (u32x4){0u, 0u, 0u, 0u}; \
            if (row >= 1 && row <= 16) v = *(const u32x4*)(H + (size_t)(r0_ + row - 1) * DIN + cc * 8); \
            else if (row == 0 && !smp_) { if ((r0_ & (TP - 1)) != 0) v = *(const u32x4*)(H + (size_t)(r0_ - 1) * DIN + cc * 8); } \
            else if (row < 18 && smp_) { const float* sp = P.state_shift + (size_t)(((r0_ - MP) >> 3) + (row == 17 ? 1 : 0)) * DSH + cc * 8; \
                const f32x4 s0 = *(const f32x4*)sp, s1 = *(const f32x4*)(sp + 4); v.x = pack2(s0[0], s0[1]); v.y = pack2(s0[2], s0[3]); v.z = pack2(s1[0], s1[1]); v.w = pack2(s1[2], s1[3]); } \
            pre[i] = v; } \
        _Pragma("unroll") for (int i = 0; i < 4; ++i) { const int id = tid_ + NTHR * (hb * 4 + i); const int row = id / 208, cc = id - row * 208; if (id < 18 * 208) *(u32x4*)(lds + PR_FS + row * PR_ROWB + cc * 16) = pre[i]; } \
        asm volatile("" ::: "memory"); } }
    int unit = ((int)blockIdx.x >> 3) < 8 ? MP / 16 + ((int)blockIdx.x & 7) * 8 + ((int)blockIdx.x >> 3) : MT / 16;
    if (unit < MT / 16) { PR_FILL(unit); }
    __syncthreads();
    for (; unit < MT / 16; unit += gridDim.x) {
        const int r0 = unit * 16; const bool smp = r0 >= MP;
        const int nxt = unit + gridDim.x;
        {
            const int prow = (smp && atok == 8) ? 17 : atok;
            const uint2 fc = *(const uint2*)(lds + PR_FS + (atok + 1) * PR_ROWB + (1536 + aj) * 2), fp = *(const uint2*)(lds + PR_FS + prow * PR_ROWB + (1536 + aj) * 2);
            float x[4];
            x[0] = bflo(fc.x) + (bflo(fp.x) - bflo(fc.x)) * amu[0]; x[1] = bfhi(fc.x) + (bfhi(fp.x) - bfhi(fc.x)) * amu[1];
            x[2] = bflo(fc.y) + (bflo(fp.y) - bflo(fc.y)) * amu[2]; x[3] = bfhi(fc.y) + (bfhi(fp.y) - bfhi(fc.y)) * amu[3];
            if (aj < 64) {
#pragma unroll
                for (int q = 0; q < 4; ++q) x[q] = 1.0f - 2.0f * frcp_(1.0f + fexp2_(2.88539008f * x[q]));
            }
            *(uint2*)(lds + PR_AT + (aj < 64 ? 0 : 2048) + atok * 128 + (aj & 63) * 2) = make_uint2(pack2(x[0], x[1]), pack2(x[2], x[3]));
        }
        __syncthreads();
        f32x4 accw[4], acca[4];
        {
            bf16x8 tf[2], af[2];
#pragma unroll
            for (int s = 0; s < 2; ++s) {
                tf[s] = *(const bf16x8*)(lds + PR_AT + (lane & 15) * 128 + (32 * s + 8 * (lane >> 4)) * 2);
                af[s] = *(const bf16x8*)(lds + PR_AT + 2048 + (lane & 15) * 128 + (32 * s + 8 * (lane >> 4)) * 2);
            }
#pragma unroll
            for (int n = 0; n < 4; ++n) {
                f32x4 cw = (f32x4){0.f, 0.f, 0.f, 0.f}, ca = (f32x4){0.f, 0.f, 0.f, 0.f};
#pragma unroll
                for (int s = 0; s < 2; ++s) {
                    cw = __builtin_amdgcn_mfma_f32_16x16x32_bf16(wdf[n][s], tf[s], cw, 0, 0, 0);
                    ca = __builtin_amdgcn_mfma_f32_16x16x32_bf16(waf[n][s], af[s], ca, 0, 0, 0);
                }
                accw[n] = cw; acca[n] = ca;
            }
        }
        const int tok = lane & 15, row = r0 + tok;
        const int prow = (smp && tok == 8) ? 17 : tok;
        const unsigned char* fcur = lds + PR_FS + (tok + 1) * PR_ROWB;
        const unsigned char* fprv = lds + PR_FS + prow * PR_ROWB;
        float ss = 0.f, rks = 0.f;
#pragma unroll
        for (int n = 0; n < 4; ++n) {
            const int c0 = h * 64 + 16 * n + 4 * (lane >> 4);
            const f32x4 cmk = *(const f32x4*)(cst + 1536 + c0), ckk = *(const f32x4*)(cst + 2560 + c0);
            const uint2 kc = *(const uint2*)(fcur + (512 + c0) * 2), kp = *(const uint2*)(fprv + (512 + c0) * 2);
            const float fk[4] = {bflo(kc.x), bfhi(kc.x), bflo(kc.y), bfhi(kc.y)}, pk[4] = {bflo(kp.x), bfhi(kp.x), bflo(kp.y), bfhi(kp.y)};
#pragma unroll
            for (int q = 0; q < 4; ++q) { const float kk = (fk[q] + (pk[q] - fk[q]) * cmk[q]) * ckk[q]; ss += kk * kk; }
        }
        asm volatile("" ::: "memory"); __builtin_amdgcn_sched_barrier(0);
        ss += __shfl_xor(ss, 16); ss += __shfl_xor(ss, 32);
        const float kn = rsqrtf(fmaxf(ss, 1e-24f));
#pragma unroll
        for (int n = 0; n < 4; ++n) {
            const int c0 = h * 64 + 16 * n + 4 * (lane >> 4);
            const f32x4 cw0 = *(const f32x4*)(cst + c0), ca0 = *(const f32x4*)(cst + 512 + c0), cmr = *(const f32x4*)(cst + 1024 + c0), cmk = *(const f32x4*)(cst + 1536 + c0);
            const f32x4 cmv = *(const f32x4*)(cst + 2048 + c0), ckk = *(const f32x4*)(cst + 2560 + c0), cka = *(const f32x4*)(cst + 3072 + c0), crk = *(const f32x4*)(cst + 3584 + c0);
            const uint2 rc = *(const uint2*)(fcur + c0 * 2), rp = *(const uint2*)(fprv + c0 * 2);
            const uint2 kc = *(const uint2*)(fcur + (512 + c0) * 2), kp = *(const uint2*)(fprv + (512 + c0) * 2);
            const uint2 vc = *(const uint2*)(fcur + (1024 + c0) * 2), vp = *(const uint2*)(fprv + (1024 + c0) * 2);
            const float fr[4] = {bflo(rc.x), bfhi(rc.x), bflo(rc.y), bfhi(rc.y)}, pr[4] = {bflo(rp.x), bfhi(rp.x), bflo(rp.y), bfhi(rp.y)};
            const float fk[4] = {bflo(kc.x), bfhi(kc.x), bflo(kc.y), bfhi(kc.y)}, pk[4] = {bflo(kp.x), bfhi(kp.x), bflo(kp.y), bfhi(kp.y)};
            const float fv[4] = {bflo(vc.x), bfhi(vc.x), bflo(vc.y), bfhi(vc.y)}, pv[4] = {bflo(vp.x), bfhi(vp.x), bflo(vp.y), bfhi(vp.y)};
            float r[4], k2[4], v[4], e2[4], eta[4], kk[4];
#pragma unroll
            for (int q = 0; q < 4; ++q) {
                r[q] = fr[q] + (pr[q] - fr[q]) * cmr[q];
                const float k = fk[q] + (pk[q] - fk[q]) * cmk[q];
                v[q] = fv[q] + (pv[q] - fv[q]) * cmv[q];
                e2[q] = 0.87506123f * sigmoidf_(accw[n][q] + cw0[q]);
                eta[q] = sigmoidf_(acca[n][q] + ca0[q]);
                kk[q] = k * ckk[q] * kn;
                k2[q] = k * (1.0f + (eta[q] - 1.0f) * cka[q]);
                rks += r[q] * k2[q] * crk[q];
            }
            const size_t o = (size_t)row * 512 + c0;
            *(uint2*)(P.Rr + o) = make_uint2(pack2(r[0], r[1]), pack2(r[2], r[3])); *(uint2*)(P.Re + o) = make_uint2(pack2(e2[0], e2[1]), pack2(e2[2], e2[3]));
            *(uint2*)(P.Rk + o) = make_uint2(pack2(k2[0], k2[1]), pack2(k2[2], k2[3])); *(uint2*)(P.Rv + o) = make_uint2(pack2(v[0], v[1]), pack2(v[2], v[3]));
            *(uint2*)(P.Rkk + o) = make_uint2(pack2(kk[0], kk[1]), pack2(kk[2], kk[3])); *(uint2*)(P.Reta + o) = make_uint2(pack2(eta[0], eta[1]), pack2(eta[2], eta[3]));
            asm volatile("" ::: "memory"); __builtin_amdgcn_sched_barrier(0);
        }
        rks += __shfl_xor(rks, 16); rks += __shfl_xor(rks, 32);
        if ((lane >> 4) == 0) P.rk[(size_t)row * 8 + h] = rks;
        if (!smp) { if (((r0 + 15) & (TP - 1)) == TP - 1) { float* dst = P.o_shift_p + (size_t)(r0 >> 12) * DSH; for (int col = tid; col < DSH; col += NTHR) dst[col] = bf2f(*(const bf16_t*)(lds + PR_FS + 16 * PR_ROWB + col * 2)); } }
        else { const int b0 = (r0 - MP) >> 3;
            for (int col = tid; col < 2 * DSH; col += NTHR) { const int which = col >= DSH, cc = col - which * DSH; P.o_shift_s[(size_t)(b0 + which) * DSH + cc] = bf2f(*(const bf16_t*)(lds + PR_FS + (which ? 16 : 8) * PR_ROWB + cc * 2)); } }
        __syncthreads();
        if (nxt < MT / 16) { PR_FILL(nxt); }
        __syncthreads();
    }
#undef PR_FILL
    if (blockIdx.x < 8) { const bf16_t* hr = H + (size_t)(blockIdx.x * TP + TP - 1) * DIN; for (int col = tid; col < DSH; col += NTHR) P.o_shift_p[(size_t)blockIdx.x * DSH + col] = bf2f(hr[col]); }
}
template <int CTRL> __device__ __forceinline__ float dpp_qp(float x) {
    return __builtin_bit_cast(float, __builtin_amdgcn_update_dpp(0, __builtin_bit_cast(int, x), CTRL, 0xF, 0xF, false));
}
__device__ __forceinline__ float oct_allsum(float x) {
    x += dpp_qp<0xB1>(x);
    x += dpp_qp<0x4E>(x);
    x += dpp_qp<0x141>(x);
    return x;
}
__device__ __forceinline__ void p4_post(const Params& P) {
    int tid_o = TIDX_(P.wid); asm volatile("" : "+v"(tid_o)); const int tid = tid_o, lane = tid & 63, wave = tid >> 6;
    float lw[8], lb[8];
#pragma unroll
    for (int j = 0; j < 8; ++j) { lw[j] = P.lnx_w[lane * 8 + j]; lb[j] = P.lnx_b[lane * 8 + j]; }
    const int xc = (int)blockIdx.x & 7, lwv = ((int)blockIdx.x >> 3) * 8 + wave;
#define POST_ROW(kq) ((kq) < 16 ? xc * TP + lwv + 256 * (kq) : ((kq) == 16 && lwv < 128 ? MP + 128 * xc + lwv : MT))
    for (int it = 0; it < 5; ++it) {
        u32x4 yv[4], vv[4], zv[4]; float rkv[4];
#pragma unroll
        for (int q = 0; q < 4; ++q) {
            const int row = POST_ROW(it * 4 + q);
            if (row < MT) {
                yv[q] = *(const u32x4*)(P.YR + (size_t)row * 512 + lane * 8);
                vv[q] = *(const u32x4*)(P.Rv + (size_t)row * 512 + lane * 8);
                zv[q] = *(const u32x4*)(P.H + (size_t)row * DIN + OFF_ZR + lane * 8);
                rkv[q] = P.rk[(size_t)row * 8 + (lane >> 3)];
            }
        }
#pragma unroll
        for (int q = 0; q < 4; ++q) {
            const int row = POST_ROW(it * 4 + q);
            if (row < MT) {
                float y[8], v[8], z[8];
#pragma unroll
                for (int j = 0; j < 4; ++j) { y[2 * j] = bflo(yv[q][j]); y[2 * j + 1] = bfhi(yv[q][j]); v[2 * j] = bflo(vv[q][j]); v[2 * j + 1] = bfhi(vv[q][j]); z[2 * j] = bflo(zv[q][j]); z[2 * j + 1] = bfhi(zv[q][j]); }
                float s = ((y[0] + y[1]) + (y[2] + y[3])) + ((y[4] + y[5]) + (y[6] + y[7]));
                const float mean = oct_allsum(s) * (1.0f / 64.0f);
                float d[8]; float s2 = 0.f;
#pragma unroll
                for (int j = 0; j < 8; ++j) { d[j] = y[j] - mean; s2 += d[j] * d[j]; }
                const float rstd = rsqrtf(oct_allsum(s2) * (1.0f / 64.0f) + 64e-5f);
                float o[8];
#pragma unroll
                for (int j = 0; j < 8; ++j) { float t = d[j] * rstd * lw[j] + lb[j] + rkv[q] * v[j]; o[j] = t * z[j] * sigmoidf_(z[j]); }
                u32x4 w; w.x = pack2(o[0], o[1]); w.y = pack2(o[2], o[3]); w.z = pack2(o[4], o[5]); w.w = pack2(o[6], o[7]);
                *(u32x4*)(P.H + (size_t)row * DIN + OFF_ZR + lane * 8) = w;
            }
        }
    }
}

__device__ __forceinline__ void p2_zcopy(const Params& P) {
    int tid_o = TIDX_(P.wid); asm volatile("" : "+v"(tid_o)); const int tid = tid_o;
    const int NT_ = gridDim.x * NTHR;
    for (int i = blockIdx.x * NTHR + tid; i < MT * 64; i += NT_ * 4) {
        u32x4 v[4];
#pragma unroll
        for (int q = 0; q < 4; ++q) { const int id = i + q * NT_; if (id < MT * 64) v[q] = *(const u32x4*)(P.H + (size_t)(id >> 6) * DIN + OFF_ZR + (id & 63) * 8); }
#pragma unroll
        for (int q = 0; q < 4; ++q) { const int id = i + q * NT_; if (id < MT * 64) *(u32x4*)(P.XB + (size_t)(id >> 6) * DM + (id & 63) * 8) = v[q]; }
    }
}
#define VT_LD 264
__device__ __forceinline__ void p3_attn_prompt(const Params& P, unsigned char* lds) {
    unsigned char* ldsK = lds;
    bf16_t* ldsVT = (bf16_t*)(lds + 32768);
    const bf16_t* H = P.H;
    int tid_o = TIDX_(P.wid); asm volatile("" : "+v"(tid_o));
    for (int unit = blockIdx.x; unit < 512; unit += gridDim.x) {
        int tid_l = tid_o; asm volatile("" : "+v"(tid_l)); const int tid = tid_l, lane = tid & 63, wid = tid >> 6;
        float kwr[8];
#pragma unroll
        for (int q = 0; q < 8; ++q) kwr[q] = P.k_norm_w[(tid & 7) * 8 + q];
        const int nu_ = (unit & 7) * 64 + (unit >> 3), qb = nu_ & 31, kvh = (nu_ >> 5) & 1, b = nu_ >> 6;
        const int seq_base = b * TP, blk = qb * 128;
        u32x4 qraw[2][4];
        {
            const int g_ = wid & 3, half_ = wid >> 2, head_ = kvh * 4 + g_, ql_ = lane & 31, hh_ = lane >> 5;
            {
                const bf16_t* hr = H + (size_t)(seq_base + blk + half_ * 64 + ql_) * DIN;
#pragma unroll
                for (int s = 0; s < 4; ++s) qraw[0][s] = *(const u32x4*)(hr + OFF_Q + head_ * 64 + s * 16 + hh_ * 8);
            }
        }
        __syncthreads();
#pragma unroll
        for (int i = 0; i < 4; ++i) {
            const int id = tid + NTHR * i, idx = id >> 3, c = id & 7;
            const int pos = blk - 128 + idx;
            u32x4 kv = (u32x4){0u, 0u, 0u, 0u};
            if (pos >= 0) kv = *(const u32x4*)(H + (size_t)(seq_base + pos) * DIN + OFF_K + kvh * 64 + c * 8);
            const int idx2 = (tid & 63) + 64 * i, c2 = tid >> 6, pos2 = blk - 128 + idx2;
            u32x4 vv = (u32x4){0u, 0u, 0u, 0u};
            if (pos2 >= 0) vv = *(const u32x4*)(H + (size_t)(seq_base + pos2) * DIN + OFF_V + kvh * 64 + c2 * 8);
            {
                float kf[8];
#pragma unroll
                for (int q = 0; q < 4; ++q) { kf[2 * q] = bflo(kv[q]); kf[2 * q + 1] = bfhi(kv[q]); }
                float ss = 0.f;
#pragma unroll
                for (int q = 0; q < 8; ++q) ss += kf[q] * kf[q];
                ss = oct_allsum(ss);
                const float rs = rsqrtf(ss * (1.0f / 64.0f) + 1e-6f);
#pragma unroll
                for (int q = 0; q < 8; ++q) kf[q] *= rs * kwr[q];
                kv.x = pack2(kf[0], kf[1]); kv.y = pack2(kf[2], kf[3]); kv.z = pack2(kf[4], kf[5]); kv.w = pack2(kf[6], kf[7]);
                if (qb == 31 && idx >= 128) {
                    const size_t o = ((size_t)(b * 128 + (idx - 128)) * 2 + kvh) * 64 + c * 8;
                    *(f32x4*)(P.o_ck_p + o) = (f32x4){kf[0], kf[1], kf[2], kf[3]}; *(f32x4*)(P.o_ck_p + o + 4) = (f32x4){kf[4], kf[5], kf[6], kf[7]};
                }
            }
            if (qb == 31 && idx2 >= 128) {
                const size_t o = ((size_t)(b * 128 + (idx2 - 128)) * 2 + kvh) * 64 + c2 * 8;
                *(f32x4*)(P.o_cv_p + o) = (f32x4){bflo(vv.x), bfhi(vv.x), bflo(vv.y), bfhi(vv.y)}; *(f32x4*)(P.o_cv_p + o + 4) = (f32x4){bflo(vv.z), bfhi(vv.z), bflo(vv.w), bfhi(vv.w)};
            }
            *(u32x4*)(ldsK + idx * 128 + ((c ^ (idx & 7)) << 4)) = kv;
#pragma unroll
            for (int q = 0; q < 4; ++q) {
                ldsVT[(c2 * 8 + q * 2) * VT_LD + idx2] = (bf16_t)(vv[q] & 0xffffu);
                ldsVT[(c2 * 8 + q * 2 + 1) * VT_LD + idx2] = (bf16_t)(vv[q] >> 16);
            }
        }
        __syncthreads();
        const int g = wid & 3, half = wid >> 2, head = kvh * 4 + g;
        {
            const bf16_t* hr = H + (size_t)(seq_base + blk + half * 64 + 32 + (lane & 31)) * DIN;
#pragma unroll
            for (int s = 0; s < 4; ++s) qraw[1][s] = *(const u32x4*)(hr + OFF_Q + head * 64 + s * 16 + (lane >> 5) * 8);
        }
        const float sink = P.sinks[head] * 1.44269504f;
        const int ql = lane & 31, hh = lane >> 5;
#pragma unroll
        for (int sb = 0; sb < 2; ++sb) {
            const int q0 = half * 64 + sb * 32;
            const int qrow = seq_base + blk + q0 + ql;
            uint2 zz[8];
            { const bf16_t* zr_ = H + (size_t)qrow * DIN + OFF_ZA + head * 64;
#pragma unroll
              for (int dt = 0; dt < 2; ++dt)
#pragma unroll
                for (int gq = 0; gq < 4; ++gq) zz[dt * 4 + gq] = *(const uint2*)(zr_ + dt * 32 + 8 * gq + 4 * hh); }
            bf16x8 qf[4];
            {
                float ss = 0.f;
#pragma unroll
                for (int s = 0; s < 4; ++s) {
#pragma unroll
                    for (int q = 0; q < 4; ++q) { const float x0 = bflo(qraw[sb][s][q]), x1 = bfhi(qraw[sb][s][q]); ss += x0 * x0 + x1 * x1; } }
                ss += __shfl_xor(ss, 32);
                const float rs = rsqrtf(ss * (1.0f / 64.0f) + 1e-6f) * (0.125f * 1.44269504f);
#pragma unroll
                for (int s = 0; s < 4; ++s) { u32x4 w;
#pragma unroll
                    for (int q = 0; q < 4; ++q) { const int d = s * 16 + hh * 8 + q * 2; w[q] = pack2(bflo(qraw[sb][s][q]) * rs * P.q_norm_w[d], bfhi(qraw[sb][s][q]) * rs * P.q_norm_w[d + 1]); }
                    qf[s] = __builtin_bit_cast(bf16x8, w); }
            }
            const int t0 = q0 >> 5;
            f32x16 sc[5];
#pragma unroll
            for (int kt = 0; kt < 5; ++kt) {
                f32x16 a;
#pragma unroll
                for (int r = 0; r < 16; ++r) a[r] = 0.f;
                const int krow = (t0 + kt) * 32 + ql;
#pragma unroll
                for (int s = 0; s < 4; ++s) {
                    const int c = s * 2 + hh;
                    const bf16x8 kf = *(const bf16x8*)(ldsK + krow * 128 + ((c ^ (krow & 7)) << 4));
                    a = __builtin_amdgcn_mfma_f32_32x32x16_bf16(kf, qf[s], a, 0, 0, 0);
                }
                sc[kt] = a;
            }
            const int kt_min = (qb == 0) ? 4 - t0 : 0;
            const int xq = ql - 4 * hh;
            float m = sink;
#pragma unroll
            for (int kt = 0; kt < 5; ++kt) {
                const bool dead = kt < kt_min;
#pragma unroll
                for (int r = 0; r < 16; ++r) {
                    const int cr = (r & 3) + 8 * (r >> 2);
                    const bool bad = dead || (kt == 0 && cr <= xq) || (kt == 4 && cr > xq);
                    const float s = bad ? -1e30f : sc[kt][r];
                    sc[kt][r] = s;
                    m = fmaxf(m, s);
                }
            }
            m = fmaxf(m, __shfl_xor(m, 32));
            float sum = 0.f;
#pragma unroll
            for (int kt = 0; kt < 5; ++kt)
#pragma unroll
                for (int r = 0; r < 16; ++r) { const float p = fexp2_(sc[kt][r] - m); sc[kt][r] = p; sum += p; }
            sum += __shfl_xor(sum, 32);
            const float inv = frcp_(sum + fexp2_(sink - m));
            f32x16 o[2];
#pragma unroll
            for (int dt = 0; dt < 2; ++dt)
#pragma unroll
                for (int r = 0; r < 16; ++r) o[dt][r] = 0.f;
#pragma unroll
            for (int kt = 0; kt < 5; ++kt)
#pragma unroll
                for (int s = 0; s < 2; ++s) {
                    u32x4 pw;
                    pw.x = pack2(sc[kt][8 * s + 0], sc[kt][8 * s + 1]); pw.y = pack2(sc[kt][8 * s + 2], sc[kt][8 * s + 3]);
                    pw.z = pack2(sc[kt][8 * s + 4], sc[kt][8 * s + 5]); pw.w = pack2(sc[kt][8 * s + 6], sc[kt][8 * s + 7]);
                    const bf16x8 pf = __builtin_bit_cast(bf16x8, pw);
                    const int key0 = (t0 + kt) * 32 + 16 * s + 4 * hh;
#pragma unroll
                    for (int dt = 0; dt < 2; ++dt) {
                        const bf16_t* vp = ldsVT + (dt * 32 + ql) * VT_LD + key0;
                        const uint2 v0 = *(const uint2*)vp, v1 = *(const uint2*)(vp + 8);
                        u32x4 vw; vw.x = v0.x; vw.y = v0.y; vw.z = v1.x; vw.w = v1.y;
                        const bf16x8 vf = __builtin_bit_cast(bf16x8, vw);
                        o[dt] = __builtin_amdgcn_mfma_f32_32x32x16_bf16(vf, pf, o[dt], 0, 0, 0);
                    }
                }
            const bf16_t* zr = H + (size_t)qrow * DIN + OFF_ZA + head * 64;
            int qrow_o = qrow; asm volatile("" : "+v"(qrow_o));
            bf16_t* orow = (bf16_t*)((unsigned char*)P.H + ((unsigned)qrow_o * (unsigned)(DIN * 2) + (unsigned)((OFF_Q + head * 64) * 2)));
#pragma unroll
            for (int dt = 0; dt < 2; ++dt)
#pragma unroll
                for (int gq = 0; gq < 4; ++gq) {
                    const int d = dt * 32 + 8 * gq + 4 * hh;
                    const uint2 z2 = zz[dt * 4 + gq];
                    const float z0 = bflo(z2.x), z1 = bfhi(z2.x), z2f = bflo(z2.y), z3 = bfhi(z2.y);
                    const float o0 = o[dt][gq * 4 + 0] * inv * z0 * sigmoidf_(z0);
                    const float o1 = o[dt][gq * 4 + 1] * inv * z1 * sigmoidf_(z1);
                    const float o2 = o[dt][gq * 4 + 2] * inv * z2f * sigmoidf_(z2f);
                    const float o3 = o[dt][gq * 4 + 3] * inv * z3 * sigmoidf_(z3);
                    *(uint2*)(orow + d) = make_uint2(pack2(o0, o1), pack2(o2, o3));
                }
            __builtin_amdgcn_sched_barrier(0);
        }
    }
}

#define VS_LD 168
__device__ __forceinline__ void p3_attn_sample(const Params& P, unsigned char* lds) {
    unsigned char* ldsK = lds;
    bf16_t* ldsVT = (bf16_t*)(lds + 20480);
    const bf16_t* H = P.H;
    int tid_o = TIDX_(P.wid); asm volatile("" : "+v"(tid_o)); const int tid = tid_o, lane = tid & 63, wid = tid >> 6;
    for (int unit = blockIdx.x; unit < 256; unit += gridDim.x) {
        const int b = 16 * (unit & 7) + (unit >> 4), kvh = (unit >> 3) & 1;
        __syncthreads();
#pragma unroll
        for (int i = 0; i < 2; ++i) {
            const int id = tid + NTHR * i, j = id >> 3, c = id & 7;
            const float* kp = P.cache_k + ((size_t)(b * 128 + j) * 2 + kvh) * 64 + c * 8;
            const f32x4 k0 = *(const f32x4*)kp, k1 = *(const f32x4*)(kp + 4);
            *(u32x4*)(ldsK + j * 128 + ((c ^ (j & 7)) << 4)) = (u32x4){pack2(k0[0], k0[1]), pack2(k0[2], k0[3]), pack2(k1[0], k1[1]), pack2(k1[2], k1[3])};
            if (j >= 8) { float* op = P.o_ck_s + ((size_t)(b * 128 + j - 8) * 2 + kvh) * 64 + c * 8; *(f32x4*)op = k0; *(f32x4*)(op + 4) = k1; }
            const int j2 = (tid & 63) + 64 * i, c2 = tid >> 6;
            const float* vp = P.cache_v + ((size_t)(b * 128 + j2) * 2 + kvh) * 64 + c2 * 8;
            const f32x4 v0 = *(const f32x4*)vp, v1 = *(const f32x4*)(vp + 4);
#pragma unroll
            for (int q = 0; q < 4; ++q) { ldsVT[(c2 * 8 + q) * VS_LD + j2] = f2bf(v0[q]); ldsVT[(c2 * 8 + 4 + q) * VS_LD + j2] = f2bf(v1[q]); }
            if (j2 >= 8) { float* op = P.o_cv_s + ((size_t)(b * 128 + j2 - 8) * 2 + kvh) * 64 + c2 * 8; *(f32x4*)op = v0; *(f32x4*)(op + 4) = v1; }
        }
        if (tid < 64) {
            const int t = tid >> 3, c = tid & 7;
            const bf16_t* hr = H + (size_t)(MP + b * TS + t) * DIN;
            const u32x4 kv = *(const u32x4*)(hr + OFF_K + kvh * 64 + c * 8), vv = *(const u32x4*)(hr + OFF_V + kvh * 64 + c * 8);
            float kf[8], vf[8];
#pragma unroll
            for (int q = 0; q < 4; ++q) { kf[2 * q] = bflo(kv[q]); kf[2 * q + 1] = bfhi(kv[q]); vf[2 * q] = bflo(vv[q]); vf[2 * q + 1] = bfhi(vv[q]); }
            float ss = 0.f;
#pragma unroll
            for (int q = 0; q < 8; ++q) ss += kf[q] * kf[q];
            ss = oct_allsum(ss);
            const float rs = rsqrtf(ss * (1.0f / 64.0f) + 1e-6f);
#pragma unroll
            for (int q = 0; q < 8; ++q) kf[q] *= rs * P.k_norm_w[c * 8 + q];
            const int j = 128 + t;
            *(u32x4*)(ldsK + j * 128 + ((c ^ (j & 7)) << 4)) = (u32x4){pack2(kf[0], kf[1]), pack2(kf[2], kf[3]), pack2(kf[4], kf[5]), pack2(kf[6], kf[7])};
#pragma unroll
            for (int q = 0; q < 8; ++q) ldsVT[(c * 8 + q) * VS_LD + j] = f2bf(vf[q]);
            float* okp = P.o_ck_s + ((size_t)(b * 128 + 120 + t) * 2 + kvh) * 64 + c * 8; float* ovp = P.o_cv_s + ((size_t)(b * 128 + 120 + t) * 2 + kvh) * 64 + c * 8;
            *(f32x4*)okp = (f32x4){kf[0], kf[1], kf[2], kf[3]}; *(f32x4*)(okp + 4) = (f32x4){kf[4], kf[5], kf[6], kf[7]};
            *(f32x4*)ovp = (f32x4){vf[0], vf[1], vf[2], vf[3]}; *(f32x4*)(ovp + 4) = (f32x4){vf[4], vf[5], vf[6], vf[7]};
        } else if (tid < 64 + 192) {
            const int id = tid - 64, j = 136 + (id >> 3), c = id & 7;
            *(u32x4*)(ldsK + j * 128 + ((c ^ (j & 7)) << 4)) = (u32x4){0u, 0u, 0u, 0u};
#pragma unroll
            for (int q = 0; q < 8; ++q) ldsVT[(c * 8 + q) * VS_LD + j] = (bf16_t)0;
        }
        __syncthreads();
        if (wid == 0) {
            const int ql = lane & 31, hh = lane >> 5, t = ql >> 2, g = ql & 3, head = kvh * 4 + g;
            const int qrow = MP + b * TS + t;
            const float sink = P.sinks[head];
            uint2 zz[8];
            { const bf16_t* zr_ = H + (size_t)qrow * DIN + OFF_ZA + head * 64;
#pragma unroll
              for (int dt = 0; dt < 2; ++dt)
#pragma unroll
                for (int gq = 0; gq < 4; ++gq) zz[dt * 4 + gq] = *(const uint2*)(zr_ + dt * 32 + 8 * gq + 4 * hh); }
            bf16x8 qf[4];
            {
                u32x4 qraw[4]; float ss = 0.f;
#pragma unroll
                for (int s = 0; s < 4; ++s) { qraw[s] = *(const u32x4*)(H + (size_t)qrow * DIN + OFF_Q + head * 64 + s * 16 + hh * 8);
#pragma unroll
                    for (int q = 0; q < 4; ++q) { const float x0 = bflo(qraw[s][q]), x1 = bfhi(qraw[s][q]); ss += x0 * x0 + x1 * x1; } }
                ss += __shfl_xor(ss, 32);
                const float rs = rsqrtf(ss * (1.0f / 64.0f) + 1e-6f) * 0.125f;
#pragma unroll
                for (int s = 0; s < 4; ++s) { u32x4 w;
#pragma unroll
                    for (int q = 0; q < 4; ++q) { const int d = s * 16 + hh * 8 + q * 2; w[q] = pack2(bflo(qraw[s][q]) * rs * P.q_norm_w[d], bfhi(qraw[s][q]) * rs * P.q_norm_w[d + 1]); }
                    qf[s] = __builtin_bit_cast(bf16x8, w); }
            }
            f32x16 sc[5];
#pragma unroll
            for (int kt = 0; kt < 5; ++kt) {
                f32x16 a;
#pragma unroll
                for (int r = 0; r < 16; ++r) a[r] = 0.f;
                const int krow = kt * 32 + ql;
#pragma unroll
                for (int s = 0; s < 4; ++s) {
                    const int c = s * 2 + hh;
                    const bf16x8 kf = *(const bf16x8*)(ldsK + krow * 128 + ((c ^ (krow & 7)) << 4));
                    a = __builtin_amdgcn_mfma_f32_32x32x16_bf16(kf, qf[s], a, 0, 0, 0);
                }
                sc[kt] = a;
            }
            float m = sink;
#pragma unroll
            for (int kt = 0; kt < 5; ++kt)
#pragma unroll
                for (int r = 0; r < 16; ++r) {
                    const int kidx = kt * 32 + (r & 3) + 8 * (r >> 2) + 4 * hh;
                    const bool valid = (kidx > t) && (kidx <= t + 128);
                    const float s = valid ? sc[kt][r] : -1e30f;
                    sc[kt][r] = s;
                    m = fmaxf(m, s);
                }
            m = fmaxf(m, __shfl_xor(m, 32));
            float sum = 0.f;
#pragma unroll
            for (int kt = 0; kt < 5; ++kt)
#pragma unroll
                for (int r = 0; r < 16; ++r) { const float p = __expf(sc[kt][r] - m); sc[kt][r] = p; sum += p; }
            sum += __shfl_xor(sum, 32);
            const float inv = 1.0f / (sum + __expf(sink - m));
            f32x16 o[2];
#pragma unroll
            for (int dt = 0; dt < 2; ++dt)
#pragma unroll
                for (int r = 0; r < 16; ++r) o[dt][r] = 0.f;
#pragma unroll
            for (int kt = 0; kt < 5; ++kt)
#pragma unroll
                for (int s = 0; s < 2; ++s) {
                    u32x4 pw;
                    pw.x = pack2(sc[kt][8 * s + 0], sc[kt][8 * s + 1]); pw.y = pack2(sc[kt][8 * s + 2], sc[kt][8 * s + 3]);
                    pw.z = pack2(sc[kt][8 * s + 4], sc[kt][8 * s + 5]); pw.w = pack2(sc[kt][8 * s + 6], sc[kt][8 * s + 7]);
                    const bf16x8 pf = __builtin_bit_cast(bf16x8, pw);
                    const int key0 = kt * 32 + 16 * s + 4 * hh;
#pragma unroll
                    for (int dt = 0; dt < 2; ++dt) {
                        const bf16_t* vp = ldsVT + (dt * 32 + ql) * VS_LD + key0;
                        const uint2 v0 = *(const uint2*)vp, v1 = *(const uint2*)(vp + 8);
                        u32x4 vw; vw.x = v0.x; vw.y = v0.y; vw.z = v1.x; vw.w = v1.y;
                        const bf16x8 vf = __builtin_bit_cast(bf16x8, vw);
                        o[dt] = __builtin_amdgcn_mfma_f32_32x32x16_bf16(vf, pf, o[dt], 0, 0, 0);
                    }
                }
            bf16_t* orow = P.H + (size_t)qrow * DIN + OFF_Q + head * 64;
#pragma unroll
            for (int dt = 0; dt < 2; ++dt)
#pragma unroll
                for (int gq = 0; gq < 4; ++gq) {
                    const int d = dt * 32 + 8 * gq + 4 * hh;
                    const uint2 z2 = zz[dt * 4 + gq];
                    const float z0 = bflo(z2.x), z1 = bfhi(z2.x), z2f = bflo(z2.y), z3 = bfhi(z2.y);
                    const float o0 = o[dt][gq * 4 + 0] * inv * z0 * sigmoidf_(z0);
                    const float o1 = o[dt][gq * 4 + 1] * inv * z1 * sigmoidf_(z1);
                    const float o2 = o[dt][gq * 4 + 2] * inv * z2f * sigmoidf_(z2f);
                    const float o3 = o[dt][gq * 4 + 3] * inv * z3 * sigmoidf_(z3);
                    *(uint2*)(orow + d) = make_uint2(pack2(o0, o1), pack2(o2, o3));
                }
        }
    }
}
#define SS_BUF 2832
__device__ __forceinline__ void p3_scan(const Params& P, unsigned char* lds) {
    int tid_o = TIDX_(P.wid); asm volatile("" : "+v"(tid_o)); const int tid = tid_o, lane = tid & 63, wv = tid >> 6;
    const int grp = wv >> 2, tl = tid & 255;
    float* const B_ = (float*)lds + grp * SS_BUF;
    const int row_local = (wv & 3) * 4 + (lane >> 4), kq = lane & 15;
    const int stok = tl >> 3, scc = tl & 7; const bool stager = tl < 64;
    u32x4 gr = (u32x4){0u, 0u, 0u, 0u}, ge = gr, gk = gr, gv = gr, gkk = gr, get = gr;
    f32x4 Snext = (f32x4){0.f, 0.f, 0.f, 0.f};
#define SS_UNIT(p) (512 * ((int)blockIdx.x & 7) + ((int)blockIdx.x >> 3) * 16 + 2 * (p) + grp)
#define SS_PREFETCH(p) { const int un_ = SS_UNIT(p), b_ = un_ >> 5, h_ = (un_ >> 2) & 7, vq_ = un_ & 3; \
        Snext = *(const f32x4*)(P.state_rwkv + (size_t)(b_ * 8 + h_) * 4096 + (vq_ * 16 + row_local) * 64 + kq * 4); \
        if (stager) { const size_t o = (size_t)(MP + b_ * TS + stok) * 512 + h_ * 64 + scc * 8; \
            gr = *(const u32x4*)(P.Rr + o); ge = *(const u32x4*)(P.Re + o); gk = *(const u32x4*)(P.Rk + o); gv = *(const u32x4*)(P.Rv + o); gkk = *(const u32x4*)(P.Rkk + o); get = *(const u32x4*)(P.Reta + o); } }
    SS_PREFETCH(0)
    for (int p = 0; p < 8; ++p) {
        const int un = SS_UNIT(p), b = un >> 5, h = (un >> 2) & 7, vq = un & 3;
        __syncthreads();
        if (stager) {
            const int bo = stok * 64 + scc * 8; float fa[8], fwr[8], fw[8], fb[8], fk[8]; float br = 0.f, kr = 0.f;
#pragma unroll
            for (int q = 0; q < 4; ++q) {
                const float kk0 = bflo(gkk[q]), kk1 = bfhi(gkk[q]), r0 = bflo(gr[q]), r1 = bfhi(gr[q]);
                fa[2 * q] = -kk0; fa[2 * q + 1] = -kk1; fb[2 * q] = kk0 * bflo(get[q]); fb[2 * q + 1] = kk1 * bfhi(get[q]);
                fw[2 * q] = fexp2_(-bflo(ge[q])); fw[2 * q + 1] = fexp2_(-bfhi(ge[q])); fwr[2 * q] = fw[2 * q] * r0; fwr[2 * q + 1] = fw[2 * q + 1] * r1;
                fk[2 * q] = bflo(gk[q]); fk[2 * q + 1] = bfhi(gk[q]);
                br += fb[2 * q] * r0 + fb[2 * q + 1] * r1; kr += fk[2 * q] * r0 + fk[2 * q + 1] * r1; }
            *(f32x4*)(B_ + bo) = (f32x4){fa[0], fa[1], fa[2], fa[3]}; *(f32x4*)(B_ + bo + 4) = (f32x4){fa[4], fa[5], fa[6], fa[7]};
            *(f32x4*)(B_ + 512 + bo) = (f32x4){fwr[0], fwr[1], fwr[2], fwr[3]}; *(f32x4*)(B_ + 512 + bo + 4) = (f32x4){fwr[4], fwr[5], fwr[6], fwr[7]};
            *(f32x4*)(B_ + 1024 + bo) = (f32x4){fw[0], fw[1], fw[2], fw[3]}; *(f32x4*)(B_ + 1024 + bo + 4) = (f32x4){fw[4], fw[5], fw[6], fw[7]};
            *(f32x4*)(B_ + 1536 + bo) = (f32x4){fb[0], fb[1], fb[2], fb[3]}; *(f32x4*)(B_ + 1536 + bo + 4) = (f32x4){fb[4], fb[5], fb[6], fb[7]};
            *(f32x4*)(B_ + 2048 + bo) = (f32x4){fk[0], fk[1], fk[2], fk[3]}; *(f32x4*)(B_ + 2048 + bo + 4) = (f32x4){fk[4], fk[5], fk[6], fk[7]};
            if ((scc >> 1) == vq) { float* vp = B_ + 2560 + stok * 16 + (scc & 1) * 8;
                *(f32x4*)vp = (f32x4){bflo(gv[0]), bfhi(gv[0]), bflo(gv[1]), bfhi(gv[1])}; *(f32x4*)(vp + 4) = (f32x4){bflo(gv[2]), bfhi(gv[2]), bflo(gv[3]), bfhi(gv[3])}; }
            br = oct_allsum(br); kr = oct_allsum(kr);
            if (scc == 0) { B_[2688 + stok * 2] = br; B_[2688 + stok * 2 + 1] = kr; }
        }
        float S[4] = {Snext[0], Snext[1], Snext[2], Snext[3]};
        if (p + 1 < 8) SS_PREFETCH(p + 1)
        __syncthreads();
        {
            const float* pa = B_ + kq * 4; const float* pv = B_ + 2560 + row_local; const float* pbk = B_ + 2688; float* py = B_ + 2704 + row_local;
#define SS_LOAD(X, tt) const f32x4 a_##X = *(const f32x4*)(pa + (tt) * 64), wr_##X = *(const f32x4*)(pa + 512 + (tt) * 64), w_##X = *(const f32x4*)(pa + 1024 + (tt) * 64), \
                b_##X = *(const f32x4*)(pa + 1536 + (tt) * 64), k_##X = *(const f32x4*)(pa + 2048 + (tt) * 64); const float v_##X = pv[(tt) * 16]; const f32x2_t bk_##X = *(const f32x2_t*)(pbk + (tt) * 2);
#define SS_STEP(X, tt) { float u = (S[0] * a_##X[0] + S[1] * a_##X[1]) + (S[2] * a_##X[2] + S[3] * a_##X[3]); \
                float ya = (S[0] * wr_##X[0] + S[1] * wr_##X[1]) + (S[2] * wr_##X[2] + S[3] * wr_##X[3]); \
                u += dpp_f<0x128>(u); ya += dpp_f<0x128>(ya); u += dpp_f<0x124>(u); ya += dpp_f<0x124>(ya); \
                u += dpp_f<0x122>(u); ya += dpp_f<0x122>(ya); u += dpp_f<0x121>(u); ya += dpp_f<0x121>(ya); \
                S[0] = S[0] * w_##X[0] + (v_##X * k_##X[0] + u * b_##X[0]); S[1] = S[1] * w_##X[1] + (v_##X * k_##X[1] + u * b_##X[1]); \
                S[2] = S[2] * w_##X[2] + (v_##X * k_##X[2] + u * b_##X[2]); S[3] = S[3] * w_##X[3] + (v_##X * k_##X[3] + u * b_##X[3]); \
                const float y = ya + (u * bk_##X[0] + v_##X * bk_##X[1]); if (kq == 0) py[(tt) * 16] = y; }
            { SS_LOAD(A, 0) SS_LOAD(B, 1) SS_STEP(A, 0) SS_LOAD(C, 2) SS_STEP(B, 1) SS_LOAD(D, 3) SS_STEP(C, 2) SS_STEP(D, 3) }
            { SS_LOAD(A, 4) SS_LOAD(B, 5) SS_STEP(A, 4) SS_LOAD(C, 6) SS_STEP(B, 5) SS_LOAD(D, 7) SS_STEP(C, 6) SS_STEP(D, 7) }
#undef SS_LOAD
#undef SS_STEP
            f32x4 s4; s4[0] = S[0]; s4[1] = S[1]; s4[2] = S[2]; s4[3] = S[3];
            *(f32x4*)(P.o_state_s + (size_t)(b * 8 + h) * 4096 + (vq * 16 + row_local) * 64 + kq * 4) = s4;
        }
        __syncthreads();
        if (tl < 16) { const int tok = tl >> 1, hf = tl & 1; const float* yp = B_ + 2704 + tok * 16 + hf * 8;
            u32x4 o4; o4.x = pack2(yp[0], yp[1]); o4.y = pack2(yp[2], yp[3]); o4.z = pack2(yp[4], yp[5]); o4.w = pack2(yp[6], yp[7]);
            *(u32x4*)(P.YR + (size_t)(MP + b * TS + tok) * 512 + h * 64 + vq * 16 + hf * 8) = o4; }
    }
#undef SS_UNIT
#undef SS_PREFETCH
}
#define CH_EF 0
#define CH_ZF 17408
#define CH_A 21760
#define CH_R 29952
#define CH_B 38144
#define CH_K 46336
#define CH_AT 54528
#define CH_BH 62720
#define CH_KH 70912
#define CH_VT 79104
#define CH_T 87296
#define CH_AK 95488
#define CH_RB 103680
#define CH_G2 111872
#define CH_QV 120064
__device__ __forceinline__ int sw_ch(int row, int ch) { return (ch ^ row ^ (int)(0x63417250u >> ((row >> 1) & 0x1c))) & 7; }
__device__ __forceinline__ int sw_off(int row, int col) { return row * 128 + ((sw_ch(row, col >> 3) << 4) | ((col & 7) << 1)); }
__device__ __forceinline__ void nt_prod(const unsigned char* Y, const unsigned char* X, f32x4 (&acc)[2], int w, int lane) {
#pragma unroll
    for (int s = 0; s < 2; ++s) {
        const int yr = 16 * (w & 3) + (lane & 15), ch = 4 * s + (lane >> 4);
        const bf16x8 af = *(const bf16x8*)(Y + yr * 128 + (sw_ch(yr, ch) << 4));
#pragma unroll
        for (int n = 0; n < 2; ++n) {
            const int xr = 32 * (w >> 2) + 8 * ((lane & 15) >> 2) + 4 * n + (lane & 3);
            const bf16x8 bf = *(const bf16x8*)(X + xr * 128 + (sw_ch(xr, ch) << 4));
            acc[n] = __builtin_amdgcn_mfma_f32_16x16x32_bf16(bf, af, acc[n], 0, 0, 0);
        }
    }
}
template <int MODE> __device__ __forceinline__ void nt_mask(f32x4 (&acc)[2], int w, int lane) {
    if (MODE == 0) return;
    const int r = 16 * (w & 3) + (lane & 15);
#pragma unroll
    for (int n = 0; n < 2; ++n)
#pragma unroll
        for (int q = 0; q < 4; ++q) {
            const int c = 32 * (w >> 2) + 8 * (lane >> 4) + 4 * n + q;
            const bool keep = MODE == 1 ? (c < r) : MODE == 2 ? (c > r) : (c <= r);
            if (!keep) acc[n][q] = 0.f;
        }
}
__device__ __forceinline__ void nt_init_lds(const unsigned char* I, f32x4 (&acc)[2], int w, int lane) {
    const int r = 16 * (w & 3) + (lane & 15);
    const u32x4 v = *(const u32x4*)(I + sw_off(r, 32 * (w >> 2) + 8 * (lane >> 4)));
    acc[0] = (f32x4){bflo(v.x), bfhi(v.x), bflo(v.y), bfhi(v.y)}; acc[1] = (f32x4){bflo(v.z), bfhi(v.z), bflo(v.w), bfhi(v.w)};
}
__device__ __forceinline__ void nt_store_lds(unsigned char* O, const f32x4 (&acc)[2], int w, int lane) {
    const int r = 16 * (w & 3) + (lane & 15);
    *(u32x4*)(O + sw_off(r, 32 * (w >> 2) + 8 * (lane >> 4))) = (u32x4){pack2(acc[0][0], acc[0][1]), pack2(acc[0][2], acc[0][3]), pack2(acc[1][0], acc[1][1]), pack2(acc[1][2], acc[1][3])};
}
__device__ __forceinline__ void nt_store_f32(float* O, const f32x4 (&acc)[2], int w, int lane) {
    const int r = 16 * (w & 3) + (lane & 15);
#pragma unroll
    for (int n = 0; n < 2; ++n) { const int c = 32 * (w >> 2) + 8 * (lane >> 4) + 4 * n; *(f32x4*)(O + r * 68 + c) = acc[n]; }
}
__device__ __forceinline__ void nt_store_glb(bf16_t* O, const f32x4 (&acc)[2], int w, int lane) {
    const int r = 16 * (w & 3) + (lane & 15);
    *(u32x4*)(O + r * 64 + 32 * (w >> 2) + 8 * (lane >> 4)) = (u32x4){pack2(acc[0][0], acc[0][1]), pack2(acc[0][2], acc[0][3]), pack2(acc[1][0], acc[1][1]), pack2(acc[1][2], acc[1][3])};
}
#define ZACC(a) { a[0] = (f32x4){0.f, 0.f, 0.f, 0.f}; a[1] = (f32x4){0.f, 0.f, 0.f, 0.f}; }

#define CH_TH CH_A
#define CH_AL CH_R
#define CH_WD CH_B
#define CH_WA CH_K
#define CH_ZW CH_AT
#define CH_ZA 71936
#define CH_CST (131072 + 1024)
__device__ __forceinline__ void p3_chunk_a(const Params& P, unsigned char* lds) {
    int tid_o = TIDX_(P.wid); asm volatile("" : "+v"(tid_o)); const int tid = tid_o, lane = tid & 63, w = tid >> 6;
    float* EF = (float*)(lds + CH_EF); float* ZF = (float*)(lds + CH_ZF); float* cst = (float*)(lds + CH_CST);
    const bf16_t* H = P.H;
    const int tok = tid >> 3, cc = tid & 7;
    const int tok2 = (tid & 255) >> 2, cc2 = (tid >> 8) * 4 + (tid & 3);
    __syncthreads();
    { cst[tid] = P.w0[tid]; cst[512 + tid] = P.a0[tid]; cst[1024 + tid] = P.mu[tid]; cst[1536 + tid] = P.mu[512 + tid]; cst[2048 + tid] = P.mu[1024 + tid];
      cst[2560 + tid] = P.k_k[tid]; cst[3072 + tid] = P.k_a[tid]; cst[3584 + tid] = P.r_k[tid]; }
    if (tid < 128) cst[4096 + tid] = P.mu[1536 + tid];
    u32x4 nhr, nhk, nhv, npr, npk, npv, nl0, nl1, nq0, nq1, nwd, nwa;
#define CH_GLOAD(un) { const int bh_ = (un) >> 6, c_ = (un) & 63, h_ = bh_ & 7; const size_t R_ = (size_t)((bh_ >> 3) * TP + c_ * 64 + tok); const bf16_t* hc = H + R_ * DIN; \
        nhr = *(const u32x4*)(hc + h_ * 64 + cc * 8); nhk = *(const u32x4*)(hc + 512 + h_ * 64 + cc * 8); nhv = *(const u32x4*)(hc + 1024 + h_ * 64 + cc * 8); \
        const bf16_t* hl = H + (size_t)((bh_ >> 3) * TP + c_ * 64 + tok2) * DIN + 1536 + 16 * cc2; nl0 = *(const u32x4*)hl; nl1 = *(const u32x4*)(hl + 8); \
        if (c_ == 0 && tok == 0) { npr = (u32x4){0u, 0u, 0u, 0u}; npk = npr; npv = npr; } \
        else { const bf16_t* hp = hc - DIN; npr = *(const u32x4*)(hp + h_ * 64 + cc * 8); npk = *(const u32x4*)(hp + 512 + h_ * 64 + cc * 8); npv = *(const u32x4*)(hp + 1024 + h_ * 64 + cc * 8); } \
        if (c_ == 0 && tok2 == 0) { nq0 = (u32x4){0u, 0u, 0u, 0u}; nq1 = nq0; } else { nq0 = *(const u32x4*)(hl - DIN); nq1 = *(const u32x4*)(hl - DIN + 8); } \
        nwd = *(const u32x4*)(P.WLd + (size_t)h_ * 4096 + tid * 8); nwa = *(const u32x4*)(P.WLa + (size_t)h_ * 4096 + tid * 8); }
#define CH_UNIT(k) ((8 * ((int)blockIdx.x & 7) + (((int)blockIdx.x >> 3) & 7)) * 64 + ((int)blockIdx.x >> 6) + 4 * (k))
    CH_GLOAD(CH_UNIT(0))
    __syncthreads();
    for (int ku = 0; ku < 16; ++ku) { const int unit = CH_UNIT(ku);
        int tid_l = tid; asm volatile("" : "+v"(tid_l));
        const int tok = tid_l >> 3, cc = tid_l & 7, lane = tid_l & 63, w = tid_l >> 6, tok2 = (tid_l & 255) >> 2, cc2 = (tid_l >> 8) * 4 + (tid_l & 3);
        const int bh = unit >> 6, c = unit & 63, b = bh >> 3, h = bh & 7;
        const size_t R = (size_t)(b * TP + c * 64 + tok);
        float r[8], k2[8], v[8], e2[8], kk[8], eta[8];
        {
            const int c0 = h * 64 + cc * 8;
            const f32x4 mr0 = *(const f32x4*)(cst + 1024 + c0), mr1 = *(const f32x4*)(cst + 1024 + c0 + 4), mk0 = *(const f32x4*)(cst + 1536 + c0), mk1 = *(const f32x4*)(cst + 1536 + c0 + 4);
            const f32x4 mv0 = *(const f32x4*)(cst + 2048 + c0), mv1 = *(const f32x4*)(cst + 2048 + c0 + 4);
#pragma unroll
            for (int q = 0; q < 8; ++q) {
                const float fr = (q & 1) ? bfhi(nhr[q >> 1]) : bflo(nhr[q >> 1]), pr = (q & 1) ? bfhi(npr[q >> 1]) : bflo(npr[q >> 1]);
                const float fk = (q & 1) ? bfhi(nhk[q >> 1]) : bflo(nhk[q >> 1]), pk = (q & 1) ? bfhi(npk[q >> 1]) : bflo(npk[q >> 1]);
                const float fv = (q & 1) ? bfhi(nhv[q >> 1]) : bflo(nhv[q >> 1]), pv = (q & 1) ? bfhi(npv[q >> 1]) : bflo(npv[q >> 1]);
                r[q] = fr + (pr - fr) * (q < 4 ? mr0[q & 3] : mr1[q & 3]);
                k2[q] = fk + (pk - fk) * (q < 4 ? mk0[q & 3] : mk1[q & 3]);
                v[q] = fv + (pv - fv) * (q < 4 ? mv0[q & 3] : mv1[q & 3]);
            }
            float x[16];
#pragma unroll
            for (int j = 0; j < 16; ++j) { const unsigned wc_ = j < 8 ? nl0[(j & 7) >> 1] : nl1[(j & 7) >> 1], wp_ = j < 8 ? nq0[(j & 7) >> 1] : nq1[(j & 7) >> 1];
                const float f = (j & 1) ? bfhi(wc_) : bflo(wc_), fp = (j & 1) ? bfhi(wp_) : bflo(wp_);
                x[j] = f + (fp - f) * cst[4096 + 16 * cc2 + j]; }
            if (cc2 < 4) {
#pragma unroll
                for (int j = 0; j < 16; ++j) x[j] = 1.0f - 2.0f * frcp_(1.0f + fexp2_(2.88539008f * x[j]));
            }
            unsigned char* dst = lds + (cc2 < 4 ? CH_TH : CH_AL) + tok2 * 128; const int ch0 = 2 * (cc2 & 3);
            *(u32x4*)(dst + (sw_ch(tok2, ch0) << 4)) = (u32x4){pack2(x[0], x[1]), pack2(x[2], x[3]), pack2(x[4], x[5]), pack2(x[6], x[7])};
            *(u32x4*)(dst + (sw_ch(tok2, ch0 + 1) << 4)) = (u32x4){pack2(x[8], x[9]), pack2(x[10], x[11]), pack2(x[12], x[13]), pack2(x[14], x[15])};
            const int wrow = tid >> 3, wch = tid & 7;
            *(u32x4*)(lds + CH_WD + wrow * 128 + (sw_ch(wrow, wch) << 4)) = nwd; *(u32x4*)(lds + CH_WA + wrow * 128 + (sw_ch(wrow, wch) << 4)) = nwa;
        }
        __syncthreads();
        {
            f32x4 a0[2], a1[2]; ZACC(a0) ZACC(a1)
            nt_prod(lds + CH_TH, lds + CH_WD, a0, w, lane); nt_prod(lds + CH_AL, lds + CH_WA, a1, w, lane);
            nt_store_f32((float*)(lds + CH_ZW), a0, w, lane); nt_store_f32((float*)(lds + CH_ZA), a1, w, lane);
        }
        __syncthreads();
        {
            const int c0 = h * 64 + cc * 8;
            const float* zwp = (const float*)(lds + CH_ZW) + tok * 68 + cc * 8; const float* zap = (const float*)(lds + CH_ZA) + tok * 68 + cc * 8;
            const f32x4 zw0 = *(const f32x4*)zwp + *(const f32x4*)(cst + c0), zw1 = *(const f32x4*)(zwp + 4) + *(const f32x4*)(cst + c0 + 4);
            const f32x4 za0 = *(const f32x4*)zap + *(const f32x4*)(cst + 512 + c0), za1 = *(const f32x4*)(zap + 4) + *(const f32x4*)(cst + 512 + c0 + 4);
            const f32x4 kk0 = *(const f32x4*)(cst + 2560 + c0), kk1 = *(const f32x4*)(cst + 2560 + c0 + 4), ka0 = *(const f32x4*)(cst + 3072 + c0), ka1 = *(const f32x4*)(cst + 3072 + c0 + 4);
            const f32x4 rk0 = *(const f32x4*)(cst + 3584 + c0), rk1 = *(const f32x4*)(cst + 3584 + c0 + 4);
            float ss = 0.f, rks = 0.f;
#pragma unroll
            for (int q = 0; q < 8; ++q) {
                e2[q] = 0.87506123f * sigmoidf_(q < 4 ? zw0[q & 3] : zw1[q & 3]);
                eta[q] = sigmoidf_(q < 4 ? za0[q & 3] : za1[q & 3]);
                const float km = k2[q];
                kk[q] = km * (q < 4 ? kk0[q & 3] : kk1[q & 3]); ss += kk[q] * kk[q];
                k2[q] = km * (1.0f + (eta[q] - 1.0f) * (q < 4 ? ka0[q & 3] : ka1[q & 3]));
                rks += r[q] * k2[q] * (q < 4 ? rk0[q & 3] : rk1[q & 3]);
            }
            ss = oct_allsum(ss); rks = oct_allsum(rks);
            const float kn = rsqrtf(fmaxf(ss, 1e-24f));
#pragma unroll
            for (int q = 0; q < 8; ++q) kk[q] *= kn;
            *(u32x4*)(P.Rv + R * 512 + c0) = (u32x4){pack2(v[0], v[1]), pack2(v[2], v[3]), pack2(v[4], v[5]), pack2(v[6], v[7])};
            if (cc == 0) P.rk[R * 8 + h] = rks;
            *(f32x4*)(EF + tok * 68 + cc * 8) = (f32x4){e2[0], e2[1], e2[2], e2[3]}; *(f32x4*)(EF + tok * 68 + cc * 8 + 4) = (f32x4){e2[4], e2[5], e2[6], e2[7]};
        }
        __syncthreads();
        *(u32x4*)(lds + CH_T + tid * 16) = (u32x4){0u, 0u, 0u, 0u};
        {
            const int ch = tid & 63, seg = tid >> 6;
            float p[8]; float run = 0.f;
#pragma unroll
            for (int q = 0; q < 8; ++q) { run += EF[(8 * seg + q) * 68 + ch]; p[q] = run; }
            ZF[seg * 64 + ch] = run;
            __syncthreads();
            float offs = 0.f;
#pragma unroll
            for (int s2 = 0; s2 < 7; ++s2) if (s2 < seg) offs += ZF[s2 * 64 + ch];
#pragma unroll
            for (int q = 0; q < 8; ++q) EF[(8 * seg + q) * 68 + ch] = p[q] + offs;
            if (seg == 7) ZF[512 + ch] = __builtin_amdgcn_exp2f(-(p[7] + offs));
        }
        __syncthreads();
        {
            const f32x4 E0 = *(const f32x4*)(EF + tok * 68 + cc * 8), E1 = *(const f32x4*)(EF + tok * 68 + cc * 8 + 4);
            const f32x4 C0 = *(const f32x4*)(ZF + 512 + cc * 8), C1 = *(const f32x4*)(ZF + 512 + cc * 8 + 4);
            float At[8], Rt[8], Bt[8], Kt[8], Bh[8], Kh[8];
#pragma unroll
            for (int q = 0; q < 8; ++q) {
                const float E = q < 4 ? E0[q & 3] : E1[q & 3];
                const float g = __builtin_amdgcn_exp2f(-E), gi = __builtin_amdgcn_exp2f(E), gp = __builtin_amdgcn_exp2f(e2[q] - E), gc = gi * (q < 4 ? C0[q & 3] : C1[q & 3]);
                const float bb = kk[q] * eta[q];
                At[q] = -kk[q] * gp; Rt[q] = r[q] * g; Bt[q] = bb * gi; Kt[q] = k2[q] * gi; Bh[q] = bb * gc; Kh[q] = k2[q] * gc;
            }
            const int so = tok * 128 + (sw_ch(tok, cc) << 4);
            *(u32x4*)(lds + CH_A + so) = (u32x4){pack2(At[0], At[1]), pack2(At[2], At[3]), pack2(At[4], At[5]), pack2(At[6], At[7])};
            *(u32x4*)(lds + CH_R + so) = (u32x4){pack2(Rt[0], Rt[1]), pack2(Rt[2], Rt[3]), pack2(Rt[4], Rt[5]), pack2(Rt[6], Rt[7])};
            *(u32x4*)(lds + CH_B + so) = (u32x4){pack2(Bt[0], Bt[1]), pack2(Bt[2], Bt[3]), pack2(Bt[4], Bt[5]), pack2(Bt[6], Bt[7])};
            *(u32x4*)(lds + CH_K + so) = (u32x4){pack2(Kt[0], Kt[1]), pack2(Kt[2], Kt[3]), pack2(Kt[4], Kt[5]), pack2(Kt[6], Kt[7])};
#pragma unroll
            for (int q = 0; q < 8; ++q) {
                const int to = sw_off(cc * 8 + q, tok);
                *(bf16_t*)(lds + CH_AT + to) = f2bf(At[q]); *(bf16_t*)(lds + CH_BH + to) = f2bf(Bh[q]); *(bf16_t*)(lds + CH_KH + to) = f2bf(Kh[q]); *(bf16_t*)(lds + CH_VT + to) = f2bf(v[q]);
            }
            if (tok == 63) { float* gcp = P.SA_GC + (size_t)unit * 64 + cc * 8;
                *(f32x4*)gcp = C0; *(f32x4*)(gcp + 4) = C1; }
        }
        __syncthreads();
        if (ku + 1 < 16) CH_GLOAD(CH_UNIT(ku + 1))
        {
            f32x4 a0[2], a1[2], a2[2]; ZACC(a0) ZACC(a1) ZACC(a2)
            nt_prod(lds + CH_A, lds + CH_B, a0, w, lane); nt_prod(lds + CH_K, lds + CH_A, a1, w, lane); nt_prod(lds + CH_R, lds + CH_B, a2, w, lane);
            nt_mask<1>(a0, w, lane); nt_mask<2>(a1, w, lane); nt_mask<3>(a2, w, lane);
            nt_store_f32(EF, a0, w, lane); nt_store_lds(lds + CH_G2, a0, w, lane); nt_store_lds(lds + CH_AK, a1, w, lane); nt_store_lds(lds + CH_RB, a2, w, lane);
            *(u32x4*)(lds + CH_QV + tid * 16) = (u32x4){0u, 0u, 0u, 0u};
            if (tid < 272) *(u32x4*)(lds + CH_ZF + tid * 16) = (u32x4){0u, 0u, 0u, 0u};
        }
        __syncthreads();
        if (tid < 64) {
            const int d = tid >> 4, j = tid & 15; const float* Ad = EF + (16 * d) * 68 + 16 * d;
            f32x4 ar[16][4]; float col[16];
#pragma unroll
            for (int t = 1; t < 10; ++t)
#pragma unroll
                for (int c4 = 0; c4 * 4 < t; ++c4) ar[t][c4] = *(const f32x4*)(Ad + t * 68 + 4 * c4);
#pragma unroll
            for (int t = 0; t < 10; ++t) { float v = (t == j) ? 1.f : 0.f;
#pragma unroll
                for (int i = 0; i < t; ++i) v += ar[t][i >> 2][i & 3] * col[i];
                col[t] = v; }
#pragma unroll
            for (int t = 10; t < 16; ++t)
#pragma unroll
                for (int c4 = 0; c4 * 4 < t; ++c4) ar[t][c4] = *(const f32x4*)(Ad + t * 68 + 4 * c4);
#pragma unroll
            for (int t = 10; t < 16; ++t) { float v = (t == j) ? 1.f : 0.f;
#pragma unroll
                for (int i = 0; i < t; ++i) v += ar[t][i >> 2][i & 3] * col[i];
                col[t] = v; }
#pragma unroll
            for (int t = 0; t < 16; ++t) { const bf16_t tv = f2bf(col[t]); *(bf16_t*)(lds + CH_T + sw_off(16 * d + t, 16 * d + j)) = tv; *(bf16_t*)(lds + CH_QV + sw_off(16 * d + j, 16 * d + t)) = tv; }
            const int l15 = lane & 15, g4 = lane >> 4;
#define CH_LVL(dd) { _Pragma("unroll") for (int jb = 0; jb < (dd); ++jb) { f32x4 z = (f32x4){0.f, 0.f, 0.f, 0.f}; \
                    _Pragma("unroll") for (int s = 0; s < ((dd) + 1) / 2; ++s) { const int yr = 16 * jb + l15, xr = 16 * (dd) + l15, ch = 4 * s + g4; \
                        const bf16x8 yf = *(const bf16x8*)(lds + CH_QV + yr * 128 + (sw_ch(yr, ch) << 4)), xf = *(const bf16x8*)(lds + CH_G2 + xr * 128 + (sw_ch(xr, ch) << 4)); \
                        z = __builtin_amdgcn_mfma_f32_16x16x32_bf16(xf, yf, z, 0, 0, 0); } \
                    *(uint2*)(lds + CH_ZF + (16 * jb + l15) * 64 + 32 + 8 * g4) = make_uint2(pack2(z[0], z[1]), pack2(z[2], z[3])); } \
                asm volatile("s_waitcnt lgkmcnt(0)" ::: "memory"); \
                _Pragma("unroll") for (int jb = 0; jb < (dd); ++jb) { const int yr = 16 * (dd) + l15, ch = 2 * (dd) - 2 + g4; \
                    const bf16x8 yf = *(const bf16x8*)(lds + CH_T + yr * 128 + (sw_ch(yr, ch) << 4)), xf = *(const bf16x8*)(lds + CH_ZF + (16 * jb + l15) * 64 + 16 * g4); \
                    f32x4 t = __builtin_amdgcn_mfma_f32_16x16x32_bf16(xf, yf, (f32x4){0.f, 0.f, 0.f, 0.f}, 0, 0, 0); \
                    tq[jb] = t; } \
                _Pragma("unroll") for (int jb = 0; jb < (dd); ++jb) { const f32x4 t = tq[jb]; const int rr = 16 * (dd) + l15, cc0 = 16 * jb + 4 * g4; \
                    *(uint2*)(lds + CH_T + sw_off(rr, cc0)) = make_uint2(pack2(t[0], t[1]), pack2(t[2], t[3])); \
                    _Pragma("unroll") for (int q = 0; q < 4; ++q) *(bf16_t*)(lds + CH_QV + sw_off(cc0 + q, rr)) = f2bf(t[q]); } \
                asm volatile("s_waitcnt lgkmcnt(0)" ::: "memory"); }
            asm volatile("s_waitcnt lgkmcnt(0)" ::: "memory");
            f32x4 tq[3];
            CH_LVL(1) CH_LVL(2) CH_LVL(3)
#undef CH_LVL
        }
        __syncthreads();
        {
            f32x4 a0[2], a1[2]; ZACC(a0) ZACC(a1)
            nt_prod(lds + CH_AT, lds + CH_T, a0, w, lane); nt_prod(lds + CH_AK, lds + CH_T, a1, w, lane);
            nt_store_lds(lds + CH_B, a0, w, lane); nt_store_lds(lds + CH_A, a1, w, lane);
        }
        __syncthreads();
        {
            f32x4 a0[2], a1[2], a2[2], a3[2];
            nt_init_lds(lds + CH_R, a0, w, lane); nt_prod(lds + CH_RB, lds + CH_B, a0, w, lane);
            ZACC(a1) nt_prod(lds + CH_R, lds + CH_K, a1, w, lane); nt_mask<3>(a1, w, lane); nt_prod(lds + CH_RB, lds + CH_A, a1, w, lane);
            ZACC(a2) nt_prod(lds + CH_BH, lds + CH_B, a2, w, lane);
            nt_init_lds(lds + CH_KH, a3, w, lane); nt_prod(lds + CH_BH, lds + CH_A, a3, w, lane);
            nt_store_glb(P.SA_G1 + (size_t)unit * 4096, a0, w, lane); nt_store_lds(lds + CH_G2, a1, w, lane);
            nt_store_glb(P.SA_PC + (size_t)unit * 4096, a2, w, lane); nt_store_lds(lds + CH_QV, a3, w, lane);
        }
        __syncthreads();
        {
            f32x4 a0[2], a1[2]; ZACC(a0) ZACC(a1)
            nt_prod(lds + CH_VT, lds + CH_G2, a0, w, lane); nt_prod(lds + CH_VT, lds + CH_QV, a1, w, lane);
            nt_store_glb(P.SA_YL + (size_t)unit * 4096, a0, w, lane); nt_store_glb(P.SA_QT + (size_t)unit * 4096, a1, w, lane);
        }
    }
}

#undef CH_GLOAD
#undef CH_UNIT
#define CB_PC 0
#define CB_G1 8192
#define CB_QT 16384
#define CB_YL 18432
#define CB_GC 20480
#define CB_SLOT 20736
#define CB_SF (2 * CB_SLOT)
__device__ __forceinline__ void p4_chunk_b(const Params& P, unsigned char* lds) {
    int tid_o = TIDX_(P.wid); asm volatile("" : "+v"(tid_o)); const int tid = tid_o, lane = tid & 63, w = tid >> 6;
    for (int unit = blockIdx.x; unit < 256; unit += gridDim.x) {
        const int bh = (unit & 7) * 8 + (unit >> 5), vq = (unit >> 3) & 3, b = bh >> 3, h = bh & 7;
        const size_t u0 = (size_t)bh * 64;
        const int crow = tid >> 3, cch = tid & 7, cdst = crow * 128 + (sw_ch(crow, cch) << 4);
        const size_t x2off = tid < 128 ? (size_t)(16 * vq + (tid >> 3)) * 64 + (tid & 7) * 8 : tid < 256 ? (size_t)(16 * vq + ((tid - 128) >> 3)) * 64 + (tid & 7) * 8 : (size_t)((tid < 272 ? tid - 256 : 0) * 8);
        const int x2dst = tid < 128 ? CB_QT + cdst : tid < 256 ? CB_YL + (crow - 16) * 128 + (sw_ch(crow - 16, cch) << 4) : CB_GC + (tid < 272 ? tid - 256 : 0) * 16;
#define CB_LOAD(X, c) { const size_t uu = u0 + (c); X##0 = *(const u32x4*)(P.SA_PC + uu * 4096 + tid * 8); X##1 = *(const u32x4*)(P.SA_G1 + uu * 4096 + tid * 8); \
        const bf16_t* p2_ = tid < 128 ? P.SA_QT + uu * 4096 : tid < 256 ? P.SA_YL + uu * 4096 : (const bf16_t*)(P.SA_GC + uu * 64); X##2 = *(const u32x4*)(p2_ + x2off); }
#define CB_STORE(X, slot) { unsigned char* sl_ = lds + (slot) * CB_SLOT; *(u32x4*)(sl_ + CB_PC + cdst) = X##0; *(u32x4*)(sl_ + CB_G1 + cdst) = X##1; \
        if (tid < 272) *(u32x4*)(sl_ + x2dst) = X##2; }
        u32x4 A0, A1, A2 = (u32x4){0u, 0u, 0u, 0u}, B0, B1, B2 = A2, C0, C1, C2 = A2, D0, D1, D2 = A2, E0, E1, E2 = A2, F0, F1, F2 = A2;
        f32x4 Sn = (f32x4){0.f, 0.f, 0.f, 0.f};
        __syncthreads();
        if (tid < 128) *(u32x4*)(lds + CB_SF + tid * 16) = (u32x4){0u, 0u, 0u, 0u};
        CB_LOAD(A, 0) CB_STORE(A, 0)
        CB_LOAD(B, 1) CB_LOAD(C, 2) CB_LOAD(D, 3) CB_LOAD(E, 4) CB_LOAD(F, 5)
        asm volatile("s_waitcnt lgkmcnt(0)" ::: "memory"); __builtin_amdgcn_s_barrier(); asm volatile("" ::: "memory");
#define CB_STEP(c, CUR, NXT) { \
        { const unsigned char* sl_ = lds + ((c) & 1) * CB_SLOT; const int v_ = lane & 15, g_ = lane >> 4, n = w & 3, xr = 16 * n + v_; \
            bf16x8 sf[2]; sf[0] = *(const bf16x8*)(lds + CB_SF + ((c) & 1) * 2048 + lane * 16); sf[1] = *(const bf16x8*)(lds + CB_SF + ((c) & 1) * 2048 + 1024 + lane * 16); \
            if (w < 4) {     \
                const uint2 qt = *(const uint2*)(sl_ + CB_QT + sw_off(v_, 16 * n + 4 * g_)); const f32x4 gc = *(const f32x4*)(sl_ + CB_GC + (16 * n + 4 * g_) * 4); \
                f32x4 as = (f32x4){bflo(qt.x), bfhi(qt.x), bflo(qt.y), bfhi(qt.y)} + gc * Sn; \
                _Pragma("unroll") for (int s = 0; s < 2; ++s) { \
                    const uint2 p0 = *(const uint2*)(sl_ + CB_PC + sw_off(xr, 32 * s + 4 * g_)), p1 = *(const uint2*)(sl_ + CB_PC + sw_off(xr, 32 * s + 16 + 4 * g_)); \
                    u32x4 pf; pf.x = p0.x; pf.y = p0.y; pf.z = p1.x; pf.w = p1.y; \
                    as = __builtin_amdgcn_mfma_f32_16x16x32_bf16(__builtin_bit_cast(bf16x8, pf), sf[s], as, 0, 0, 0); } \
                Sn = as; \
                *(uint2*)(lds + CB_SF + (((c) + 1) & 1) * 2048 + (n >> 1) * 1024 + lane * 16 + (n & 1) * 8) = make_uint2(pack2(as[0], as[1]), pack2(as[2], as[3])); \
            } else {         \
                const uint2 yl = *(const uint2*)(sl_ + CB_YL + sw_off(v_, 16 * n + 4 * g_)); f32x4 ay = (f32x4){bflo(yl.x), bfhi(yl.x), bflo(yl.y), bfhi(yl.y)}; \
                _Pragma("unroll") for (int s = 0; s < 2; ++s) { \
                    const uint2 q0 = *(const uint2*)(sl_ + CB_G1 + sw_off(xr, 32 * s + 4 * g_)), q1 = *(const uint2*)(sl_ + CB_G1 + sw_off(xr, 32 * s + 16 + 4 * g_)); \
                    u32x4 gf; gf.x = q0.x; gf.y = q0.y; gf.z = q1.x; gf.w = q1.y; \
                    ay = __builtin_amdgcn_mfma_f32_16x16x32_bf16(__builtin_bit_cast(bf16x8, gf), sf[s], ay, 0, 0, 0); } \
                bf16_t* yo = P.YR + (size_t)(b * TP + (c) * 64) * 512 + h * 64 + 16 * vq + v_; \
                _Pragma("unroll") for (int q = 0; q < 4; ++q) yo[(size_t)(16 * n + 4 * g_ + q) * 512] = f2bf(ay[q]); } } \
        if ((c) + 1 < 64) CB_STORE(NXT, ((c) + 1) & 1) \
        if ((c) + 6 < 64) CB_LOAD(CUR, (c) + 6) \
        asm volatile("s_waitcnt lgkmcnt(0)" ::: "memory"); __builtin_amdgcn_s_barrier(); asm volatile("" ::: "memory"); }
        for (int c = 0; c < 60; c += 6) { CB_STEP(c, A, B) CB_STEP(c + 1, B, C) CB_STEP(c + 2, C, D) CB_STEP(c + 3, D, E) CB_STEP(c + 4, E, F) CB_STEP(c + 5, F, A) }
        CB_STEP(60, A, B) CB_STEP(61, B, C) CB_STEP(62, C, D) CB_STEP(63, D, E)
        if (w < 4) { float* so = P.o_state_p + (size_t)bh * 4096 + (size_t)(16 * vq + (lane & 15)) * 64 + 4 * (lane >> 4); *(f32x4*)(so + 16 * w) = Sn; }
#undef CB_LOAD
#undef CB_STORE
#undef CB_STEP
    }
}
template <int MODE>
__device__ __forceinline__ void g64_phase(const Params& P, unsigned char* lds, const bf16_t* A, const int lda, const bf16_t* Bt) {
    int tid_o = TIDX_(P.wid); asm volatile("" : "+v"(tid_o)); const int tid = tid_o, lane = tid & 63, w = tid >> 6;
    for (int tile = blockIdx.x; tile < 256; tile += gridDim.x) {
        const int row0 = MP + 64 * ((tile & 7) * 2 + (tile >> 7)), col0 = 64 * ((tile >> 3) & 15);
        u32x4 af[4][4], bf[4][4];
#pragma unroll
        for (int s = 0; s < 4; ++s)
#pragma unroll
            for (int m = 0; m < 4; ++m) {
                af[m][s] = *(const u32x4*)(A + (size_t)(row0 + 16 * m + (lane & 15)) * lda + 128 * w + 32 * s + 8 * (lane >> 4));
                bf[m][s] = *(const u32x4*)(Bt + (size_t)(col0 + 16 * m + (lane & 15)) * DM + 128 * w + 32 * s + 8 * (lane >> 4));
            }
        f32x4 acc[4][4];
#pragma unroll
        for (int m = 0; m < 4; ++m)
#pragma unroll
            for (int n = 0; n < 4; ++n) acc[m][n] = (f32x4){0.f, 0.f, 0.f, 0.f};
#pragma unroll
        for (int s = 0; s < 4; ++s)
#pragma unroll
            for (int m = 0; m < 4; ++m)
#pragma unroll
                for (int n = 0; n < 4; ++n) acc[m][n] = __builtin_amdgcn_mfma_f32_16x16x32_bf16(__builtin_bit_cast(bf16x8, bf[n][s]), __builtin_bit_cast(bf16x8, af[m][s]), acc[m][n], 0, 0, 0);
        __syncthreads();
        float* part_l = (float*)lds + w * 4096;
#pragma unroll
        for (int m = 0; m < 4; ++m)
#pragma unroll
            for (int n = 0; n < 4; ++n) { const int r = 16 * m + (lane & 15), ch = 4 * n + (lane >> 4); *(f32x4*)(part_l + r * 64 + ((ch ^ (r & 15)) << 2)) = acc[m][n]; }
        __syncthreads();
        const int r = tid >> 3, j = tid & 7, row = row0 + r, col = col0 + 8 * j;
        f32x4 s0 = (f32x4){0.f, 0.f, 0.f, 0.f}, s1 = s0;
#pragma unroll
        for (int ww = 0; ww < 8; ++ww) { const float* pl = (const float*)lds + ww * 4096 + r * 64; s0 += *(const f32x4*)(pl + (((2 * j) ^ (r & 15)) << 2)); s1 += *(const f32x4*)(pl + (((2 * j + 1) ^ (r & 15)) << 2)); }
        if (MODE == 0) {
            const float* xr = P.x_sample + (size_t)(row - MP) * DM + col;
            const f32x4 h0 = *(const f32x4*)xr + s0, h1 = *(const f32x4*)(xr + 4) + s1;
            u32x4 wv; wv.x = pack2(h0[0], h0[1]); wv.y = pack2(h0[2], h0[3]); wv.z = pack2(h1[0], h1[1]); wv.w = pack2(h1[2], h1[3]);
            *(u32x4*)(P.HB + (size_t)row * DM + col) = wv;
            float ss = (h0[0] * h0[0] + h0[1] * h0[1]) + (h0[2] * h0[2] + h0[3] * h0[3]) + (h1[0] * h1[0] + h1[1] * h1[1]) + (h1[2] * h1[2] + h1[3] * h1[3]);
            ss = oct_allsum(ss);
            if (j == 0) P.part[(size_t)row * 16 + (col0 >> 6)] = ss;
        } else {
            float ss = 0.f;
#pragma unroll
            for (int i = 0; i < 4; ++i) { const f32x4 p4 = *(const f32x4*)(P.part + (size_t)row * 16 + i * 4); ss += (p4[0] + p4[1]) + (p4[2] + p4[3]); }
            const float rs = rsqrtf(ss * (1.0f / DM) + 1e-6f);
            const u32x4 hh = *(const u32x4*)(P.HB + (size_t)row * DM + col), pl = *(const u32x4*)(P.PLS + (size_t)(row - MP) * DM + col);
            f32x4 o0, o1;
            o0[0] = bflo(hh.x) + sigmoidf_(s0[0] * rs) * bflo(pl.x); o0[1] = bfhi(hh.x) + sigmoidf_(s0[1] * rs) * bfhi(pl.x);
            o0[2] = bflo(hh.y) + sigmoidf_(s0[2] * rs) * bflo(pl.y); o0[3] = bfhi(hh.y) + sigmoidf_(s0[3] * rs) * bfhi(pl.y);
            o1[0] = bflo(hh.z) + sigmoidf_(s1[0] * rs) * bflo(pl.z); o1[1] = bfhi(hh.z) + sigmoidf_(s1[1] * rs) * bfhi(pl.z);
            o1[2] = bflo(hh.w) + sigmoidf_(s1[2] * rs) * bflo(pl.w); o1[3] = bfhi(hh.w) + sigmoidf_(s1[3] * rs) * bfhi(pl.w);
            float* yp = P.y_all + (size_t)row * DM + col; *(f32x4*)yp = o0; *(f32x4*)(yp + 4) = o1;
        }
    }
}

#ifndef REP_P0
#define REP_P0 1
#endif
#ifndef REP_P1
#define REP_P1 1
#endif
#ifndef REP_PREP
#define REP_PREP 1
#endif
#ifndef REP_ATTN
#define REP_ATTN 1
#endif
#ifndef REP_SCAN
#define REP_SCAN 1
#endif
#ifndef REP_CHA
#define REP_CHA 1
#endif
#ifndef REP_CHB
#define REP_CHB 1
#endif
#ifndef REP_P7
#define REP_P7 1
#endif
#ifndef REP_POST
#define REP_POST 1
#endif
#ifndef REP_ATTS
#define REP_ATTS 1
#endif
#ifndef REP_P5
#define REP_P5 1
#endif
__device__ __forceinline__ int opq(int x) { asm volatile("" : "+s"(x)); return x; }
typedef const __attribute__((address_space(4))) Params* KParams;
__device__ __forceinline__ KParams opq_kp(KParams p) { asm volatile("" : "+s"(p)); return p; }
#define LDS_RING 131072
#define LDS_TOTAL (LDS_RING + 1024 + 16384 + 512)
__global__ void __launch_bounds__(NTHR, 2) fwd_kernel(Params P0_) {
    extern __shared__ __attribute__((aligned(16))) unsigned char lds[];
#ifdef PADNOPS
    asm volatile(".rept " PADNOPS "\n\ts_nop 0\n\t.endr");
#endif
    const int tid = threadIdx.x;
    volatile LAS unsigned* bst = (volatile LAS unsigned*)((LAS unsigned char*)lds + LDS_RING);
    if (tid < 4) bst[tid] = 0u;
    __syncthreads();
    int wid_s = __builtin_amdgcn_readfirstlane(tid >> 6); asm volatile("" : "+s"(wid_s));
    XcdBarrier bar = xcd_barrier_post(P0_.bar, bst, wid_s);
    if (tid == 0) P0_.bar[XB_IDS + blockIdx.x] = bar.x + 1u;
    const int G = gridDim.x, cu = blockIdx.x;
    const KParams Pk = (KParams)__builtin_amdgcn_kernarg_segment_ptr();
#if defined(__HIP_DEVICE_COMPILE__)
#define PLOAD Params P = *opq_kp(Pk); P.wid = wid_s;
#else
#define PLOAD Params P = P0_; P.wid = wid_s;
#endif

    for (int rep = 0, nrep_ = opq(REP_P0); rep < nrep_; ++rep) { PLOAD p0_prologue(P, lds); }
    xcd_barrier(bar);
    xcd_check(bar);
    for (int rep = 0, nrep_ = opq(REP_P1); rep < nrep_; ++rep) { PLOAD Gemm g{P.XB, P.Wt_in, MT, DINP, DM, DM, P.wid}; StaticOrder S; S.init(MT, DINP, G, cu); EpiInProj E{P.H};
      gemm_phase<EpiInProj, StaticOrder, true, true>((LAS unsigned char*)lds, g, S, E); }
    { PLOAD Gemm g{P.PB, P.Wt_ple, MT, DM, 256, 256, P.wid}; TailOrder S{(MT / 256) * 4, G, (MT / 256) * (DINP / 256) - 7 * G, cu}; EpiPle E{P.y_all, P.PLS};
      gemm_phase<EpiPle, TailOrder, true, true>((LAS unsigned char*)lds, g, S, E); }
    xcd_barrier(bar);
#ifdef DESYNC_SLEEPS
    { const int xc_ = (int)blockIdx.x & 7; const int nsl_ = (DESYNC_SLEEPS); for (int i = 0; i < nsl_; ++i) __builtin_amdgcn_s_sleep(127); }
#endif
    { int flip = ((int)blockIdx.x >> 7) & 1; asm volatile("" : "+s"(flip));
      if (flip == 0) {
          for (int rep = 0, nrep_ = opq(REP_ATTN); rep < nrep_; ++rep) { PLOAD p3_attn_prompt(P, lds); }
          for (int rep = 0, nrep_ = opq(REP_ATTS); rep < nrep_; ++rep) { PLOAD p3_attn_sample(P, lds); }
          for (int rep = 0, nrep_ = opq(REP_PREP); rep < nrep_; ++rep) { PLOAD p2_rwkv_prep(P, lds); }
      }
      for (int rep = 0, nrep_ = opq(REP_CHA); rep < nrep_; ++rep) { PLOAD p3_chunk_a(P, lds); }
      if (flip != 0) {
          for (int rep = 0, nrep_ = opq(REP_ATTN); rep < nrep_; ++rep) { PLOAD p3_attn_prompt(P, lds); }
          for (int rep = 0, nrep_ = opq(REP_ATTS); rep < nrep_; ++rep) { PLOAD p3_attn_sample(P, lds); }
          for (int rep = 0, nrep_ = opq(REP_PREP); rep < nrep_; ++rep) { PLOAD p2_rwkv_prep(P, lds); }
      }
    }
    xcd_barrier_local(bar);
    for (int rep = 0, nrep_ = opq(REP_CHB); rep < nrep_; ++rep) { PLOAD p4_chunk_b(P, lds); }
    for (int rep = 0, nrep_ = opq(REP_SCAN); rep < nrep_; ++rep) { PLOAD p3_scan(P, lds); }
    xcd_barrier_local(bar);
    for (int rep = 0, nrep_ = opq(REP_POST); rep < nrep_; ++rep) { PLOAD p4_post(P); }
    xcd_barrier_local(bar);
    for (int rep = 0, nrep_ = opq(REP_P5); rep < nrep_; ++rep) {
    { PLOAD Gemm g{P.H + OFF_ZR, P.Wt_out, MP, DM, DM, DIN, P.wid}; StaticOrder S; S.init(MP, DM, G, cu); EpiOut E{P.HB, P.part, P.rstd_x};
      gemm_phase<EpiOut, StaticOrder, true, true>((LAS unsigned char*)lds, g, S, E);
      }
      { PLOAD g64_phase<0>(P, lds, P.H + OFF_ZR, DIN, P.Wt_out); }
    }
    xcd_barrier_local(bar);
    for (int rep = 0, nrep_ = opq(REP_P7); rep < nrep_; ++rep) { { PLOAD Gemm g{P.HB, P.Wt_gate, MP, DM, DM, DM, P.wid}; StaticOrder S; S.init(MP, DM, G, cu); EpiGate E{P.y_all, P.HB, P.part};
      gemm_phase<EpiGate, StaticOrder, true, true>((LAS unsigned char*)lds, g, S, E);
      }
      { PLOAD g64_phase<1>(P, lds, P.HB, DM, P.Wt_gate); } }
}

extern "C" void kernel_launch(void* const* d_in, const int* in_sizes, int n_in, void* d_out, int out_size, void* d_ws, size_t ws_size, hipStream_t stream) {
    static int grid = 0;
    if (grid == 0) {
        int dev = 0, cus = 0, per_cu = 0;
        hipGetDevice(&dev);
        hipDeviceGetAttribute(&cus, hipDeviceAttributeMultiprocessorCount, dev);
        if (hipFuncSetAttribute((const void*)fwd_kernel, hipFuncAttributeMaxDynamicSharedMemorySize, LDS_TOTAL) != hipSuccess) { fprintf(stderr, "hipFuncSetAttribute failed\n"); }
        hipOccupancyMaxActiveBlocksPerMultiprocessor(&per_cu, (const void*)fwd_kernel, NTHR, LDS_TOTAL);
        (void)hipGetLastError();
        grid = 256;
        if (cus != 256) fprintf(stderr, "warning: %d CUs reported; this kernel is written for 256\n", cus);
        if (per_cu < 1) fprintf(stderr, "occupancy query says %d blocks/CU\n", per_cu);
    }
    Params P{};
    const float** in = (const float**)&P.x_prompt;
    for (int i = 0; i < 27; ++i) in[i] = (const float*)d_in[i];
    float* out = (float*)d_out;
    P.y_all = out;
    P.o_state_p = out + (size_t)MT * DM;
    P.o_state_s = P.o_state_p + 262144;
    P.o_shift_p = P.o_state_s + 4194304;
    P.o_shift_s = P.o_shift_p + 13312;
    P.o_ck_p = P.o_shift_s + 212992;
    P.o_ck_s = P.o_ck_p + 131072;
    P.o_cv_p = P.o_ck_s + 2097152;
    P.o_cv_s = P.o_cv_p + 131072;
    unsigned char* ws = (unsigned char*)d_ws;
    size_t off = 0;
    auto take = [&](size_t bytes) { unsigned char* p = ws + off; off += (bytes + 255) & ~(size_t)255; return p; };
    P.bar = (unsigned*)take(16384);
    P.Wt_in = (bf16_t*)take((size_t)DINP * DM * 2);
    P.Wt_out = (bf16_t*)take((size_t)DM * DM * 2);
    P.Wt_gate = (bf16_t*)take((size_t)DM * DM * 2);
    P.Wt_ple = (bf16_t*)take((size_t)DM * 256 * 2);
    P.rstd_x = (float*)take((size_t)MT * 4);
    P.part = (float*)take((size_t)MT * 16 * 4);
    P.rk = (float*)take((size_t)MT * 8 * 4);
    P.WLd = (bf16_t*)take(8 * 64 * 64 * 2);
    P.WLa = (bf16_t*)take(8 * 64 * 64 * 2);
    P.PLS = (bf16_t*)take((size_t)MS * DM * 2);
    P.H = (bf16_t*)take((size_t)MT * DIN * 2);
    P.XB = (bf16_t*)take((size_t)MT * DM * 2);
    P.SA_G1 = (bf16_t*)take((size_t)4096 * 4096 * 2);
    P.SA_PC = (bf16_t*)take((size_t)4096 * 4096 * 2);
    P.SA_QT = (bf16_t*)take((size_t)4096 * 4096 * 2);
    P.SA_YL = (bf16_t*)take((size_t)4096 * 4096 * 2);
    P.SA_GC = (float*)take((size_t)4096 * 64 * 4);
    P.YR = (bf16_t*)take((size_t)MT * 512 * 2);
    P.Rv = (bf16_t*)take((size_t)MT * 512 * 2);
    P.Rr = (bf16_t*)take((size_t)MS * 512 * 2) - (size_t)MP * 512;
    P.Re = (bf16_t*)take((size_t)MS * 512 * 2) - (size_t)MP * 512;
    P.Rk = (bf16_t*)take((size_t)MS * 512 * 2) - (size_t)MP * 512;
    P.Rkk = (bf16_t*)take((size_t)MS * 512 * 2) - (size_t)MP * 512;
    P.Reta = (bf16_t*)take((size_t)MS * 512 * 2) - (size_t)MP * 512;
    P.PB = (bf16_t*)P.o_state_p;
    P.PLE = nullptr;
    P.HB = P.XB;
    if (off > ws_size) { fprintf(stderr, "workspace too small: need %zu have %zu\n", off, ws_size); return; }
    hipMemsetAsync(P.bar, 0, 16384, stream);
    hipLaunchKernelGGL(fwd_kernel, dim3(grid), dim3(NTHR), LDS_TOTAL, stream, P);
}
```

```cpp
#define DESYNC_SLEEPS ((xc_ & 4) ? 4 : 0)
#include <hip/hip_runtime.h>
#include <stdint.h>
#include <cstdio>

#define LAS __attribute__((address_space(3)))
typedef float f32x16 __attribute__((ext_vector_type(16)));

#define MP 32768
#define MS 1024
#define MT 33792
#define TP 4096
#define TS 8
#define DM 1024
#define DIN 3456
#define DINP 3584
#define DSH 1664
#define OFF_ZR 1664
#define OFF_Q 2176
#define OFF_K 2688
#define OFF_V 2816
#define OFF_ZA 2944
#define NTHR 512

__device__ __forceinline__ int lane_id_() { int l; asm volatile("v_mbcnt_lo_u32_b32 %0, -1, 0\n\tv_mbcnt_hi_u32_b32 %0, -1, %0" : "=v"(l)); return l; }
#define TIDX_(wid) ((wid) * 64 + lane_id_())
namespace pg8 {
#define PG8_LAS __attribute__((address_space(3)))
typedef unsigned short bf16_t;
typedef short bf16x8 __attribute__((ext_vector_type(8)));
typedef float f32x4 __attribute__((ext_vector_type(4)));
typedef unsigned u32x4 __attribute__((ext_vector_type(4)));
constexpr int BM = 256, BK = 64, HALF = 128, HTB = HALF * BK * 2  , STAGE_BYTES = 8 * HTB, NXCD = 8, WGM = 8;

__host__ __device__ __forceinline__ int lds_byte(int r, int c) { const int st = (r >> 4) * 2 + (c >> 5), rr = r & 15, cc = c & 31, ob = rr * 64 + cc * 2; return st * 1024 + (ob ^ (((ob >> 9) & 1) << 5)); }
__host__ __device__ __forceinline__ void stage_rc(int b, int& R, int& C) { const int st = b / 1024, sb = b % 1024, swz = sb ^ (((sb >> 9) & 1) << 5); R = (st >> 1) * 16 + swz / 64; C = (st & 1) * 32 + (swz % 64) / 2; }
__host__ __device__ __forceinline__ int perm32(int rho) { const int n = rho >> 4, i = rho & 15; return 8 * (i >> 2) + 4 * n + (i & 3); }

struct Unit { int pm, pn; };
struct Gemm { const bf16_t* A; const bf16_t* Bt; int M, N, K, lda, wid; };

struct StaticOrder {
    int nM, nN, nwg, G, c;
    __host__ __device__ void init(int M, int N, int G_, int c_) { nM = M / BM; nN = N / BM; nwg = nM * nN; G = G_; c = c_; }
    __host__ __device__ bool next(int i, Unit& u) const {
        const long L = (long)i * G + c; if (L >= nwg) return false;
        int wgid = (int)L; { const int q = nwg / NXCD, r = nwg % NXCD, xcd = wgid % NXCD, off = wgid / NXCD; wgid = (xcd < r ? xcd * (q + 1) : r * (q + 1) + (xcd - r) * q) + off; }
        const int nig = WGM * nN, gid = wgid / nig, fm = gid * WGM, gsz = (nM - fm) < WGM ? (nM - fm) : WGM;
        u.pm = fm + ((wgid % nig) % gsz); u.pn = (wgid % nig) / gsz; return true;
    }
    __device__ __forceinline__ void a_ready(const Unit&) const {}
    __device__ __forceinline__ void done(const Unit&) const {}
};

typedef float f32x2_t __attribute__((ext_vector_type(2)));
typedef __bf16 bf16x2_t __attribute__((ext_vector_type(2)));
__device__ __forceinline__ unsigned pack2(float lo, float hi) { f32x2_t v = {lo, hi}; bf16x2_t b = __builtin_convertvector(v, bf16x2_t); return __builtin_bit_cast(unsigned, b); }
__device__ __forceinline__ bf16_t f2bf(float f) { return (bf16_t)(pack2(f, 0.f) & 0xffffu); }
__device__ __forceinline__ float bf2f(bf16_t h) { return __uint_as_float(((unsigned)h) << 16); }
__device__ __forceinline__ float bflo(unsigned u) { return __uint_as_float(u << 16); }
__device__ __forceinline__ float bfhi(unsigned u) { return __uint_as_float(u & 0xffff0000u); }
__device__ __forceinline__ float fexp2_(float x) { return __builtin_amdgcn_exp2f(x); }
__device__ __forceinline__ float frcp_(float x) { return __builtin_amdgcn_rcpf(x); }
__device__ __forceinline__ float sigmoidf_(float x) { return frcp_(1.0f + fexp2_(-1.44269504f * x)); }
__device__ __forceinline__ float wave_sum(float x) {
#pragma unroll
    for (int o = 32; o >= 1; o >>= 1) x += __shfl_xor(x, o);
    return x;
}
template <int CTRL> __device__ __forceinline__ float dpp_f(float x) {
    return __builtin_bit_cast(float, __builtin_amdgcn_update_dpp(0, __builtin_bit_cast(int, x), CTRL, 0xF, 0xF, false));
}
__device__ __forceinline__ float row16_allsum(float x) {
    x += dpp_f<0x128>(x); x += dpp_f<0x124>(x); x += dpp_f<0x122>(x); x += dpp_f<0x121>(x);
    return x;
}

struct EpiInProj {
    static constexpr bool PERM = true, AFTER_DRAIN = false;
    bf16_t* H;
    __device__ __forceinline__ void operator()(const f32x4 (&acc)[2][2][4][2], const Unit& u, int wr, int wc, int fr, int fq) const {
        const int row0 = u.pm * 256 + wr * 64 + fr, col0 = u.pn * 256 + wc * 32 + 8 * fq;
#pragma unroll
        for (int ai = 0; ai < 2; ++ai)
#pragma unroll
            for (int m = 0; m < 4; ++m) {
                const int row = row0 + ai * 128 + m * 16;
#pragma unroll
                for (int bj = 0; bj < 2; ++bj) {
                    const int col = col0 + bj * 128;
                    if (col < DIN) {
                        const f32x4 v0 = acc[ai][bj][m][0], v1 = acc[ai][bj][m][1];
                        u32x4 w; w.x = pack2(v0[0], v0[1]); w.y = pack2(v0[2], v0[3]); w.z = pack2(v1[0], v1[1]); w.w = pack2(v1[2], v1[3]);
                        *(u32x4*)(H + (size_t)row * DIN + col) = w;
                    }
                }
            }
    }
};
__device__ __forceinline__ unsigned char* ple_slot(float* y, int row, int pn, int wc, int fq) { return (unsigned char*)(y + (size_t)row * DM) + pn * 1024 + 512 + wc * 128 + fq * 32; }
struct EpiPle {
    static constexpr bool PERM = true, AFTER_DRAIN = false;
    float* y; bf16_t* pls;
    __device__ __forceinline__ void operator()(const f32x4 (&acc)[2][2][4][2], const Unit& u, int wr, int wc, int fr, int fq) const {
        const int row0 = u.pm * 256 + wr * 64 + fr;
#pragma unroll
        for (int ai = 0; ai < 2; ++ai)
#pragma unroll
            for (int m = 0; m < 4; ++m) {
                unsigned char* sl = ple_slot(y, row0 + ai * 128 + m * 16, u.pn, wc, fq);
#pragma unroll
                for (int bj = 0; bj < 2; ++bj) {
                    const f32x4 v0 = acc[ai][bj][m][0], v1 = acc[ai][bj][m][1];
                    u32x4 w; w.x = pack2(v0[0], v0[1]); w.y = pack2(v0[2], v0[3]); w.z = pack2(v1[0], v1[1]); w.w = pack2(v1[2], v1[3]);
                    *(u32x4*)(sl + bj * 16) = w;
                    if (u.pm >= MP / 256) *(u32x4*)(pls + (size_t)(row0 + ai * 128 + m * 16 - MP) * DM + u.pn * 256 + bj * 128 + wc * 32 + 8 * fq) = w;
                }
            }
    }
};
struct TailOrder {
    int n, G, c0, c;
    __device__ __forceinline__ bool next(int i, Unit& u) const { if (c < c0) return false; const int L = i * (G - c0) + (c - c0); if (L >= n) return false; u.pm = L >> 2; u.pn = L & 3; return true; }
    __device__ __forceinline__ void a_ready(const Unit&) const {}
    __device__ __forceinline__ void done(const Unit&) const {}
};
struct EpiOut {
    static constexpr bool PERM = true, AFTER_DRAIN = false;
    bf16_t* hb; float* part; const float* xs;
    __device__ __forceinline__ void operator()(const f32x4 (&acc)[2][2][4][2], const Unit& u, int wr, int wc, int fr, int fq) const {
        const int row0 = u.pm * 256 + wr * 64 + fr, col0 = u.pn * 256 + wc * 32 + 8 * fq;
        u32x4 xa[2], xb[2]; float sxa, sxb;
#define EO_LOAD(X, it) { const int row_ = row0 + ((it) >> 2) * 128 + ((it) & 3) * 16; const bf16_t* xr_ = hb + (size_t)row_ * DM + col0; X[0] = *(const u32x4*)xr_; X[1] = *(const u32x4*)(xr_ + 128); s##X = xs[row_]; }
#define EO_STEP(X, it) { const int ai_ = (it) >> 2, m_ = (it) & 3, row_ = row0 + ai_ * 128 + m_ * 16; float ss = 0.f; \
            _Pragma("unroll") for (int bj = 0; bj < 2; ++bj) { const u32x4 xv = X[bj]; \
                const f32x4 h0 = (f32x4){bflo(xv.x), bfhi(xv.x), bflo(xv.y), bfhi(xv.y)} * s##X + acc[ai_][bj][m_][0], h1 = (f32x4){bflo(xv.z), bfhi(xv.z), bflo(xv.w), bfhi(xv.w)} * s##X + acc[ai_][bj][m_][1]; \
                u32x4 w; w.x = pack2(h0[0], h0[1]); w.y = pack2(h0[2], h0[3]); w.z = pack2(h1[0], h1[1]); w.w = pack2(h1[2], h1[3]); \
                *(u32x4*)(hb + (size_t)row_ * DM + col0 + bj * 128) = w; \
                ss += (h0[0] * h0[0] + h0[1] * h0[1]) + (h0[2] * h0[2] + h0[3] * h0[3]) + (h1[0] * h1[0] + h1[1] * h1[1]) + (h1[2] * h1[2] + h1[3] * h1[3]); } \
            ss += __shfl_xor(ss, 16); ss += __shfl_xor(ss, 32); if (fq == 0) part[(size_t)row_ * 16 + u.pn * 4 + wc] = ss; }
        EO_LOAD(xa, 0)
        EO_LOAD(xb, 1) EO_STEP(xa, 0) EO_LOAD(xa, 2) EO_STEP(xb, 1) EO_LOAD(xb, 3) EO_STEP(xa, 2) EO_LOAD(xa, 4) EO_STEP(xb, 3)
        EO_LOAD(xb, 5) EO_STEP(xa, 4) EO_LOAD(xa, 6) EO_STEP(xb, 5) EO_LOAD(xb, 7) EO_STEP(xa, 6) EO_STEP(xb, 7)
#undef EO_LOAD
#undef EO_STEP
    }
};
struct EpiGate {
    static constexpr bool PERM = true, AFTER_DRAIN = false;
    float* y; const bf16_t* hb; const float* part;
    __device__ __forceinline__ void operator()(const f32x4 (&acc)[2][2][4][2], const Unit& u, int wr, int wc, int fr, int fq) const {
        const int row0 = u.pm * 256 + wr * 64 + fr, col0 = u.pn * 256 + wc * 32 + 8 * fq;
        u32x4 ha[2], hb2[2], pa[2], pb[2]; f32x4 qa[4], qb[4];
#define EG_LOAD(Hh, Pp, Qq, it) { const int row_ = row0 + ((it) >> 2) * 128 + ((it) & 3) * 16; \
            Hh[0] = *(const u32x4*)(hb + (size_t)row_ * DM + col0); Hh[1] = *(const u32x4*)(hb + (size_t)row_ * DM + col0 + 128); \
            { const unsigned char* sl_ = ple_slot(y, row_, u.pn, wc, fq); Pp[0] = *(const u32x4*)sl_; Pp[1] = *(const u32x4*)(sl_ + 16); } \
            _Pragma("unroll") for (int i = 0; i < 4; ++i) Qq[i] = *(const f32x4*)(part + (size_t)row_ * 16 + i * 4); }
#define EG_STEP(Hh, Pp, Qq, it) { const int ai_ = (it) >> 2, m_ = (it) & 3, row_ = row0 + ai_ * 128 + m_ * 16; \
            float ss = 0.f; _Pragma("unroll") for (int i = 0; i < 4; ++i) ss += (Qq[i][0] + Qq[i][1]) + (Qq[i][2] + Qq[i][3]); \
            const float rs = rsqrtf(ss * (1.0f / DM) + 1e-6f); \
            _Pragma("unroll") for (int bj = 0; bj < 2; ++bj) { const f32x4 a0 = acc[ai_][bj][m_][0], a1 = acc[ai_][bj][m_][1]; const u32x4 hh = Hh[bj], pl = Pp[bj]; f32x4 o0, o1; \
                o0[0] = bflo(hh.x) + sigmoidf_(a0[0] * rs) * bflo(pl.x); o0[1] = bfhi(hh.x) + sigmoidf_(a0[1] * rs) * bfhi(pl.x); \
                o0[2] = bflo(hh.y) + sigmoidf_(a0[2] * rs) * bflo(pl.y); o0[3] = bfhi(hh.y) + sigmoidf_(a0[3] * rs) * bfhi(pl.y); \
                o1[0] = bflo(hh.z) + sigmoidf_(a1[0] * rs) * bflo(pl.z); o1[1] = bfhi(hh.z) + sigmoidf_(a1[1] * rs) * bfhi(pl.z); \
                o1[2] = bflo(hh.w) + sigmoidf_(a1[2] * rs) * bflo(pl.w); o1[3] = bfhi(hh.w) + sigmoidf_(a1[3] * rs) * bfhi(pl.w); \
                float* yp = y + (size_t)row_ * DM + col0 + bj * 128; *(f32x4*)yp = o0; *(f32x4*)(yp + 4) = o1; } }
        EG_LOAD(ha, pa, qa, 0)
        EG_LOAD(hb2, pb, qb, 1) EG_STEP(ha, pa, qa, 0) EG_LOAD(ha, pa, qa, 2) EG_STEP(hb2, pb, qb, 1) EG_LOAD(hb2, pb, qb, 3) EG_STEP(ha, pa, qa, 2) EG_LOAD(ha, pa, qa, 4) EG_STEP(hb2, pb, qb, 3)
        EG_LOAD(hb2, pb, qb, 5) EG_STEP(ha, pa, qa, 4) EG_LOAD(ha, pa, qa, 6) EG_STEP(hb2, pb, qb, 5) EG_LOAD(hb2, pb, qb, 7) EG_STEP(ha, pa, qa, 6) EG_STEP(hb2, pb, qb, 7)
#undef EG_LOAD
#undef EG_STEP
    }
};

template <class Epi, class Sched, bool ALIGN_EPI = false, bool SP2 = false>
__device__ __forceinline__ void gemm_phase(PG8_LAS unsigned char* lds, const Gemm g, const Sched& S, const Epi& E) {
    int tid_o = TIDX_(g.wid); asm volatile("" : "+v"(tid_o));
    const int tid = tid_o, wid = __builtin_amdgcn_readfirstlane(tid >> 6), lane = tid & 63, wr = wid >> 2, wc = wid & 3, fr = lane & 15, fq = lane >> 4;
    const int K = g.K, nt = K / BK;
    unsigned voffA[2], voffB[2];
#pragma unroll
    for (int i = 0; i < 2; ++i) { int R, C; stage_rc(tid * 16 + i * 8192, R, C); const int Rb = Epi::PERM ? ((R & ~31) + perm32(R & 31)) : R;
        voffA[i] = (unsigned)(R * g.lda + C) * 2u; voffB[i] = (unsigned)(Rb * K + C) * 2u; }
    const size_t kstep = (size_t)(BK * 2);
    const size_t hstep = (size_t)HALF * K * 2;
    const size_t tstep = 2 * hstep;
    const size_t hstepA = (size_t)HALF * g.lda * 2, tstepA = 2 * hstepA;
    const unsigned ldsw = (unsigned)wid * 1024u;
    const int aoff = lds_byte(wr * 64 + fr, fq * 8), boff = lds_byte(wc * 32 + fr, fq * 8);
#define PG8_SA(b, h) (((b) * 2 + (h)) * HTB)
#define PG8_SB(b, h) ((4 + (b) * 2 + (h)) * HTB)
#define PG8_STAGE(bufoff, gbase, voff) do { _Pragma("unroll") for (int _i = 0; _i < 2; ++_i) \
        __builtin_amdgcn_global_load_lds((const unsigned*)((const char*)(gbase) + (voff)[_i]), (PG8_LAS unsigned*)(lds + (bufoff) + ldsw + _i * 8192), 16, 0, 0); } while (0)
#define PG8_LDA(dst, b, h) do { _Pragma("unroll") for (int m = 0; m < 4; ++m) _Pragma("unroll") for (int k = 0; k < 2; ++k) dst[m][k] = *(const PG8_LAS bf16x8*)(lds + PG8_SA(b, h) + aoff + m * 2048 + k * 1024); } while (0)
#define PG8_LDB(dst, b, h) do { _Pragma("unroll") for (int n = 0; n < 2; ++n) _Pragma("unroll") for (int k = 0; k < 2; ++k) dst[n][k] = *(const PG8_LAS bf16x8*)(lds + PG8_SB(b, h) + boff + n * 2048 + k * 1024); } while (0)
#define PG8_MMA(ai, bj, At, Bt) do { __builtin_amdgcn_s_setprio(1); _Pragma("unroll") for (int m = 0; m < 4; ++m) _Pragma("unroll") for (int n = 0; n < 2; ++n) _Pragma("unroll") for (int k = 0; k < 2; ++k) \
        acc[ai][bj][m][n] = __builtin_amdgcn_mfma_f32_16x16x32_bf16(Bt[n][k], At[m][k], acc[ai][bj][m][n], 0, 0, 0); __builtin_amdgcn_s_setprio(0); } while (0)
#define PG8_WAIT_V(n) asm volatile("s_waitcnt vmcnt(" #n ")" ::: "memory")
#define PG8_WAIT_L(n) asm volatile("s_waitcnt lgkmcnt(" #n ")" ::: "memory")
#define PG8_BAR __builtin_amdgcn_s_barrier()
#define PG8_SCHED __builtin_amdgcn_sched_barrier(0)
    Unit cur, nxt; int ui = 0;
    if (!S.next(0, cur)) return;
    f32x4 acc[2][2][4][2];
#pragma unroll
    for (int a = 0; a < 2; ++a)
#pragma unroll
        for (int b = 0; b < 2; ++b)
#pragma unroll
            for (int m = 0; m < 4; ++m)
#pragma unroll
                for (int n = 0; n < 2; ++n) acc[a][b][m][n] = (f32x4){0.f, 0.f, 0.f, 0.f};
    bf16x8 At[4][2], B0[2][2], B1[2][2];
    const char* cA = (const char*)g.A + (size_t)cur.pm * tstepA; const char* cB = (const char*)g.Bt + (size_t)cur.pn * tstep;
    S.a_ready(cur);
    if constexpr (SP2) {
        PG8_STAGE(PG8_SB(0, 0), cB, voffB); PG8_STAGE(PG8_SB(0, 1), cB + hstep, voffB); PG8_STAGE(PG8_SA(0, 0), cA, voffA); PG8_STAGE(PG8_SA(0, 1), cA + hstepA, voffA);
        if (wr == 1) PG8_BAR;
        PG8_WAIT_V(2); PG8_BAR;
        PG8_STAGE(PG8_SB(1, 0), cB + kstep, voffB); PG8_STAGE(PG8_SA(1, 0), cA + kstep, voffA); PG8_STAGE(PG8_SB(1, 1), cB + hstep + kstep, voffB);
        PG8_WAIT_V(6); PG8_BAR;
    } else {
        PG8_STAGE(PG8_SB(0, 0), cB, voffB); PG8_STAGE(PG8_SA(0, 0), cA, voffA); PG8_STAGE(PG8_SB(0, 1), cB + hstep, voffB); PG8_STAGE(PG8_SA(0, 1), cA + hstepA, voffA);
        if (wr == 1) PG8_BAR;
        PG8_WAIT_V(4); PG8_BAR;
        PG8_STAGE(PG8_SB(1, 0), cB + kstep, voffB); PG8_STAGE(PG8_SA(1, 0), cA + kstep, voffA); PG8_STAGE(PG8_SB(1, 1), cB + hstep + kstep, voffB);
        PG8_WAIT_V(6); PG8_BAR;
    }
    for (;;) {
        const bool has_next = S.next(ui + 1, nxt);
        const char* nA = has_next ? (const char*)g.A + (size_t)nxt.pm * tstepA : cA; const char* nB = has_next ? (const char*)g.Bt + (size_t)nxt.pn * tstep : cB;
#pragma unroll 1
        for (int t = 0; t < nt; t += 2) {
            const bool last = (t == nt - 2);
            const char* a1 = cA + (size_t)(t + 1) * kstep;
            const char* a2 = last ? nA : cA + (size_t)(t + 2) * kstep; const char* b2 = last ? nB : cB + (size_t)(t + 2) * kstep;
            const char* a3 = a2 + kstep; const char* b3 = b2 + kstep;
            if (last && has_next) S.a_ready(nxt);
            if constexpr (SP2) {
            PG8_LDB(B0, 0, 0); PG8_LDB(B1, 0, 1); PG8_SCHED; PG8_LDA(At, 0, 0); PG8_STAGE(PG8_SA(1, 1), a1 + hstepA, voffA);
            PG8_WAIT_V(8); PG8_WAIT_L(0); PG8_BAR; PG8_MMA(0, 0, At, B0); PG8_MMA(0, 1, At, B1); PG8_BAR; PG8_SCHED;
            PG8_LDA(At, 0, 1); PG8_STAGE(PG8_SB(0, 0), b2, voffB); PG8_STAGE(PG8_SB(0, 1), b2 + hstep, voffB); PG8_STAGE(PG8_SA(0, 0), a2, voffA);
            PG8_WAIT_V(8); PG8_WAIT_L(0); PG8_BAR; PG8_MMA(1, 0, At, B0); PG8_MMA(1, 1, At, B1); PG8_BAR; PG8_SCHED;
            PG8_LDB(B0, 1, 0); PG8_LDB(B1, 1, 1); PG8_SCHED; PG8_LDA(At, 1, 0); PG8_STAGE(PG8_SA(0, 1), a2 + hstepA, voffA);
            PG8_WAIT_V(8); PG8_WAIT_L(0); PG8_BAR; PG8_MMA(0, 0, At, B0); PG8_MMA(0, 1, At, B1); PG8_BAR; PG8_SCHED;
            PG8_LDA(At, 1, 1); PG8_STAGE(PG8_SB(1, 0), b3, voffB); PG8_STAGE(PG8_SB(1, 1), b3 + hstep, voffB); PG8_STAGE(PG8_SA(1, 0), a3, voffA);
            PG8_WAIT_V(8); PG8_WAIT_L(0); PG8_BAR; PG8_MMA(1, 0, At, B0); PG8_MMA(1, 1, At, B1); PG8_BAR; PG8_SCHED;
            } else {
            PG8_LDB(B0, 0, 0); PG8_SCHED; PG8_LDA(At, 0, 0); PG8_STAGE(PG8_SA(1, 1), a1 + hstepA, voffA);
            PG8_WAIT_L(8); PG8_BAR; PG8_WAIT_L(0); PG8_MMA(0, 0, At, B0); PG8_BAR; PG8_SCHED;
            PG8_LDB(B1, 0, 1); PG8_STAGE(PG8_SB(0, 0), b2, voffB);
            PG8_BAR; PG8_WAIT_L(0); PG8_MMA(0, 1, At, B1); PG8_BAR;
            PG8_LDA(At, 0, 1); PG8_STAGE(PG8_SA(0, 0), a2, voffA);
            PG8_BAR; PG8_WAIT_L(0); PG8_MMA(1, 0, At, B0); PG8_BAR; PG8_SCHED;
            PG8_STAGE(PG8_SB(0, 1), b2 + hstep, voffB);
            PG8_WAIT_V(6); PG8_BAR; PG8_MMA(1, 1, At, B1); PG8_BAR;
            PG8_LDB(B0, 1, 0); PG8_SCHED; PG8_LDA(At, 1, 0); PG8_STAGE(PG8_SA(0, 1), a2 + hstepA, voffA);
            PG8_WAIT_L(8); PG8_BAR; PG8_WAIT_L(0); PG8_MMA(0, 0, At, B0); PG8_BAR; PG8_SCHED;
            PG8_LDB(B1, 1, 1); PG8_STAGE(PG8_SB(1, 0), b3, voffB);
            PG8_BAR; PG8_WAIT_L(0); PG8_MMA(0, 1, At, B1); PG8_BAR;
            PG8_LDA(At, 1, 1); PG8_STAGE(PG8_SA(1, 0), a3, voffA);
            PG8_BAR; PG8_WAIT_L(0); PG8_MMA(1, 0, At, B0); PG8_BAR; PG8_SCHED;
            PG8_STAGE(PG8_SB(1, 1), b3 + hstep, voffB);
            PG8_WAIT_V(6); PG8_BAR; PG8_MMA(1, 1, At, B1); PG8_BAR;
            }
        }
        if constexpr (ALIGN_EPI) { if (wr == 0) PG8_BAR; }
        if constexpr (!Epi::AFTER_DRAIN) { E(acc, cur, wr, wc, fr, fq); S.done(cur); }
        if (!has_next) break;
#pragma unroll
        for (int a = 0; a < 2; ++a)
#pragma unroll
            for (int b = 0; b < 2; ++b)
#pragma unroll
                for (int m = 0; m < 4; ++m)
#pragma unroll
                    for (int n = 0; n < 2; ++n) acc[a][b][m][n] = (f32x4){0.f, 0.f, 0.f, 0.f};
        cur = nxt; cA = nA; cB = nB; ++ui;
        if constexpr (ALIGN_EPI) { if (wr == 1) PG8_BAR; }
    }
    PG8_WAIT_V(0);
    if constexpr (!ALIGN_EPI) { if (wr == 0) PG8_BAR; }
    PG8_BAR;
    if constexpr (Epi::AFTER_DRAIN) { E.fused(acc, cur, wr, wc, fr, fq, lds, wid, lane); S.done(cur); }
#undef PG8_SA
#undef PG8_SB
#undef PG8_STAGE
#undef PG8_LDA
#undef PG8_LDB
#undef PG8_MMA
#undef PG8_WAIT_V
#undef PG8_WAIT_L
#undef PG8_BAR
#undef PG8_SCHED
}
}
#define XB_TMO      128
#define XB_XCNT(j)  (256  + 64 * (j))
#define XB_XSUB(j)  (1280 + 64 * (j))
#define XB_XGEN(j)  (2304 + 64 * (j))
#define XB_TOP      3328
#define XB_TOPGEN   3392
#define XCD_BAR_WORDS 3456
#define XB_IDS      3520
#define XB_SPIN_CAP (1u << 18)
#define LAS __attribute__((address_space(3)))

__device__ __forceinline__ unsigned xb_ld(unsigned* p)              { return __hip_atomic_load(p, __ATOMIC_RELAXED, __HIP_MEMORY_SCOPE_AGENT); }
__device__ __forceinline__ unsigned xb_add(unsigned* p, unsigned v) { return __hip_atomic_fetch_add(p, v, __ATOMIC_RELAXED, __HIP_MEMORY_SCOPE_AGENT); }
__device__ __forceinline__ unsigned xb_xcc_id() { return (unsigned)__builtin_amdgcn_s_getreg((3 << 11) | 20) & 0xFu; }
#define XB_SPIN(cond, bar) do { unsigned _sp = 0; while (cond) { __builtin_amdgcn_s_sleep(1); \
    if ((++_sp & 255u) == 0u) { if (xb_ld(&(bar)[XB_TMO])) break; if (_sp > XB_SPIN_CAP) { atomicAdd(&(bar)[XB_TMO], 1u); break; } } } } while (0)

struct XcdBarrier {
    int wid; unsigned* bar; unsigned x;
    volatile LAS unsigned* st;
};

__device__ __forceinline__ XcdBarrier xcd_barrier_post(unsigned* bar, volatile LAS unsigned* st, int wid) {
    XcdBarrier b; b.wid = wid; b.bar = bar; b.x = xb_xcc_id(); b.st = st;
    if (TIDX_(wid) == 0) { (void)xb_add(&bar[XB_XCNT(b.x)], 1u); }
    return b;
}
__device__ __forceinline__ void xcd_barrier_complete(unsigned* bar, unsigned x, unsigned& nloc, unsigned& nx) {
    const unsigned G = gridDim.x * gridDim.y * gridDim.z;
    unsigned sum, cnt, mine, sp = 0u;
    for (;;) {
        sum = 0u; cnt = 0u; mine = 0u;
#pragma unroll
        for (unsigned j = 0; j < 16; ++j) { const unsigned c = xb_ld(&bar[XB_XCNT(j)]); sum += c; cnt += (c > 0u) ? 1u : 0u; mine = (j == x) ? c : mine; }
        if (sum == G) break;
        __builtin_amdgcn_s_sleep(1);
        if ((++sp & 255u) == 0u) { if (xb_ld(&bar[XB_TMO])) break; if (sp > XB_SPIN_CAP) { atomicAdd(&bar[XB_TMO], 1u); break; } }
    }
    nloc = mine > 0u ? mine : 1u; nx = cnt > 0u ? cnt : 1u;
}

__device__ __forceinline__ void xcd_barrier(const XcdBarrier& b) {
    asm volatile("s_waitcnt vmcnt(0)" ::: "memory");
    __syncthreads();
    if (TIDX_(b.wid) == 0) {
        unsigned* bar = b.bar;
        __builtin_amdgcn_s_waitcnt(0);
        unsigned nloc = b.st[0], nx = b.st[1];
        if (nloc == 0u) { xcd_barrier_complete(bar, b.x, nloc, nx); b.st[0] = nloc; b.st[1] = nx; }
        const unsigned old = xb_add(&bar[XB_XSUB(b.x)], 1u);
        const unsigned gen = old / nloc;
        if (old + 1u == (gen + 1u) * nloc) {
            __builtin_amdgcn_fence(__ATOMIC_RELEASE, "agent");
            asm volatile("s_waitcnt vmcnt(0)" ::: "memory");
            const unsigned og = xb_add(&bar[XB_TOP], 1u);
            const unsigned tg = og / nx;
            if (og + 1u == (tg + 1u) * nx) xb_add(&bar[XB_TOPGEN], 1u);
            else XB_SPIN(xb_ld(&bar[XB_TOPGEN]) == tg, bar);
            __builtin_amdgcn_fence(__ATOMIC_ACQUIRE, "agent");
            xb_add(&bar[XB_XGEN(b.x)], 1u);
            asm volatile("s_waitcnt vmcnt(0)" ::: "memory");
        } else {
            XB_SPIN(xb_ld(&bar[XB_XGEN(b.x)]) == gen, bar);
            __builtin_amdgcn_fence(__ATOMIC_ACQUIRE, "agent");
            asm volatile("s_waitcnt vmcnt(0)" ::: "memory");
        }
    }
    __syncthreads();
}

__device__ __forceinline__ void xcd_check(const XcdBarrier& b) {
    const int t = TIDX_(b.wid);
    bool ok = true;
    if (t < (int)gridDim.x && t < 512) { const unsigned v = xb_ld(&b.bar[XB_IDS + t]), r = xb_ld(&b.bar[XB_IDS + (t & 7)]); ok = (v != 0u) && (v == r); }
    if (!ok) b.st[3] = 1u;
    __syncthreads();
    if (t == 0) b.st[2] = (b.st[3] == 0u && b.st[0] == 32u && b.st[1] == 8u && gridDim.x == 256u) ? 1u : 2u;
    __syncthreads();
}
__device__ __forceinline__ void xcd_barrier_local(const XcdBarrier& b) {
    if (b.st[2] != 1u) { xcd_barrier(b); return; }
    asm volatile("s_waitcnt vmcnt(0)" ::: "memory");
    __syncthreads();
    if (TIDX_(b.wid) == 0) {
        unsigned* bar = b.bar;
        __builtin_amdgcn_s_waitcnt(0);
        const unsigned nloc = b.st[0];
        const unsigned old = xb_add(&bar[XB_XSUB(b.x)], 1u);
        const unsigned gen = old / nloc;
        if (old + 1u == (gen + 1u) * nloc) xb_add(&bar[XB_XGEN(b.x)], 1u);
        else XB_SPIN(xb_ld(&bar[XB_XGEN(b.x)]) == gen, bar);
        __builtin_amdgcn_fence(__ATOMIC_ACQUIRE, "agent");
        asm volatile("s_waitcnt vmcnt(0)" ::: "memory");
    }
    __syncthreads();
}

using namespace pg8;

struct Params {
    const float *x_prompt, *x_sample, *state_rwkv, *state_shift, *cache_k, *cache_v, *p_prompt, *p_sample, *g_norm, *w_in, *mu, *w0, *w_dec2, *a0, *w_a2,
        *k_k, *k_a, *r_k, *lnx_w, *lnx_b, *q_norm_w, *k_norm_w, *sinks, *w_out, *g_ple, *w_ple_gate, *w_ple_proj;
    float *y_all, *o_state_p, *o_state_s, *o_shift_p, *o_shift_s, *o_ck_p, *o_ck_s, *o_cv_p, *o_cv_s;
    unsigned* bar;
    bf16_t *Wt_in, *Wt_out, *Wt_gate, *Wt_ple, *H, *XB, *Rr, *Re, *Rk, *Rv, *Rkk, *Reta, *PB, *PLE, *HB, *SA_G1, *SA_PC, *SA_QT, *SA_YL, *YR, *WLd, *WLa, *PLS;
    float *rstd_x, *part, *rk, *SA_GC;
    int wid;
};

__device__ __forceinline__ void p0_prologue(const Params& P, unsigned char* lds) {
    int tid_o = TIDX_(P.wid); asm volatile("" : "+v"(tid_o)); const int tid = tid_o, lane = tid & 63, wave = tid >> 6;
    float* tile = (float*)lds;
#define P0_DECODE(it_) const float* src; const float* scale; bf16_t* dst; int K, N, kt, nt; { int r = (it_); \
        if (r < 864) { src = P.w_in; scale = P.g_norm; dst = P.Wt_in; K = DM; N = DIN; kt = r / 54; nt = r % 54; } \
        else if ((r -= 864) < 256) { src = P.w_out; scale = nullptr; dst = P.Wt_out; K = DM; N = DM; kt = r >> 4; nt = r & 15; } \
        else if ((r -= 256) < 256) { src = P.w_ple_gate; scale = P.g_ple; dst = P.Wt_gate; K = DM; N = DM; kt = r >> 4; nt = r & 15; } \
        else { r -= 256; src = P.w_ple_proj; scale = nullptr; dst = P.Wt_ple; K = 256; N = DM; kt = r >> 4; nt = r & 15; } } \
        const int k0 = kt * 64, n0 = nt * 64, tx = tid & 63, ty = tid >> 6;
    { const int gw = (int)blockIdx.x * 8 + wave;
      if (gw < 1440) {
        P0_DECODE(gw)
        unsigned char* T = lds + wave * (64 * 144);
        const int kr = lane >> 4, nc = lane & 15;
        f32x4 v[16];
#pragma unroll
        for (int i = 0; i < 16; ++i) { const int k = kr + 4 * i; v[i] = *(const f32x4*)(src + (size_t)(k0 + k) * N + n0 + 4 * nc); if (scale) v[i] *= scale[k0 + k]; }
#pragma unroll
        for (int i = 0; i < 16; ++i) { const int k = kr + 4 * i;
#pragma unroll
            for (int j = 0; j < 4; ++j) *(bf16_t*)(T + (4 * nc + j) * 144 + 2 * k) = f2bf(v[i][j]); }
        asm volatile("s_waitcnt lgkmcnt(0)" ::: "memory");
#pragma unroll
        for (int c = 0; c < 8; ++c) { const u32x4 w = *(const u32x4*)(T + lane * 144 + 16 * c); *(u32x4*)(dst + (size_t)(n0 + lane) * K + k0 + 8 * c) = w; }
        (void)tx; (void)ty; (void)tile;
      } }
#undef P0_DECODE
    for (int i = blockIdx.x * NTHR + tid; i < 2 * 8 * 64 * 8; i += gridDim.x * NTHR) {
        const int which = i >> 12, r = i & 4095, hh = r >> 9, ch = (r >> 3) & 63, jc = r & 7;
        const float* src = (which ? P.w_a2 : P.w_dec2) + hh * 64 + ch;
        u32x4 wv; wv.x = pack2(src[(8 * jc + 0) * 512], src[(8 * jc + 1) * 512]); wv.y = pack2(src[(8 * jc + 2) * 512], src[(8 * jc + 3) * 512]);
        wv.z = pack2(src[(8 * jc + 4) * 512], src[(8 * jc + 5) * 512]); wv.w = pack2(src[(8 * jc + 6) * 512], src[(8 * jc + 7) * 512]);
        *(u32x4*)((which ? P.WLa : P.WLd) + (size_t)hh * 4096 + ch * 64 + jc * 8) = wv;
    }
    for (int i = blockIdx.x * NTHR + tid; i < (DINP - DIN) * DM / 8; i += gridDim.x * NTHR) *(u32x4*)(P.Wt_in + (size_t)DIN * DM + (size_t)i * 8) = (u32x4){0u, 0u, 0u, 0u};
    for (int row0 = blockIdx.x * 8 + wave; row0 < MT; row0 += gridDim.x * 8 * 4) {
        f32x4 v[4][4];
#pragma unroll
        for (int q = 0; q < 4; ++q) { const int row = row0 + q * gridDim.x * 8;
            if (row < MT) { const float* src = row < MP ? P.x_prompt + (size_t)row * DM : P.x_sample + (size_t)(row - MP) * DM;
#pragma unroll
                for (int i = 0; i < 4; ++i) v[q][i] = *(const f32x4*)(src + (lane + 64 * i) * 4); } }
#pragma unroll
        for (int q = 0; q < 4; ++q) { const int row = row0 + q * gridDim.x * 8;
            if (row < MT) { float ss = 0.f;
#pragma unroll
                for (int i = 0; i < 4; ++i) { const f32x4 x = v[q][i]; ss += (x[0] * x[0] + x[1] * x[1]) + (x[2] * x[2] + x[3] * x[3]); }
                ss = wave_sum(ss);
                const float ms = ss * (1.0f / DM) + 1e-6f, rs = rsqrtf(ms);
#pragma unroll
                for (int i = 0; i < 4; ++i) { const f32x4 x = v[q][i] * rs;
                    *(uint2*)(P.XB + (size_t)row * DM + (lane + 64 * i) * 4) = make_uint2(pack2(x[0], x[1]), pack2(x[2], x[3])); }
                if (lane == 0) P.rstd_x[row] = sqrtf(ms); } }
    }
    for (size_t i = (size_t)blockIdx.x * NTHR + tid; i < (size_t)MT * 64; i += (size_t)gridDim.x * NTHR * 4) {
        f32x4 v[4];
#pragma unroll
        for (int q = 0; q < 4; ++q) { const size_t e = (i + (size_t)q * gridDim.x * NTHR) * 4; if (e < (size_t)MT * 256) v[q] = *(const f32x4*)(e < (size_t)MP * 256 ? P.p_prompt + e : P.p_sample + (e - (size_t)MP * 256)); }
#pragma unroll
        for (int q = 0; q < 4; ++q) { const size_t e = (i + (size_t)q * gridDim.x * NTHR) * 4; if (e < (size_t)MT * 256) *(uint2*)(P.PB + e) = make_uint2(pack2(v[q][0], v[q][1]), pack2(v[q][2], v[q][3])); }
    }

}


#define PR_ROWB 3344
#define PR_FS 0
#define PR_AT (18 * PR_ROWB)
#define PR_CONST (PR_AT + 4096)
__device__ __forceinline__ void p2_rwkv_prep(const Params& P, unsigned char* lds) {
    int tid_o = TIDX_(P.wid); asm volatile("" : "+v"(tid_o)); const int tid = tid_o, lane = tid & 63, h = tid >> 6;
    const bf16_t* H = P.H;
    float* cst = (float*)(lds + PR_CONST);
    __syncthreads();
    { cst[tid] = P.w0[tid]; cst[512 + tid] = P.a0[tid]; cst[1024 + tid] = P.mu[tid]; cst[1536 + tid] = P.mu[512 + tid]; cst[2048 + tid] = P.mu[1024 + tid];
      cst[2560 + tid] = P.k_k[tid]; cst[3072 + tid] = P.k_a[tid]; cst[3584 + tid] = P.r_k[tid]; }
    bf16x8 wdf[4][2], waf[4][2];
#pragma unroll
    for (int n = 0; n < 4; ++n)
#pragma unroll
        for (int s = 0; s < 2; ++s) {
            const int ch = h * 64 + 16 * n + (lane & 15), j0 = 32 * s + 8 * (lane >> 4);
            u32x4 a, b;
#pragma unroll
            for (int q = 0; q < 4; ++q) {
                a[q] = pack2(P.w_dec2[(j0 + 2 * q) * 512 + ch], P.w_dec2[(j0 + 2 * q + 1) * 512 + ch]);
                b[q] = pack2(P.w_a2[(j0 + 2 * q) * 512 + ch], P.w_a2[(j0 + 2 * q + 1) * 512 + ch]);
            }
            wdf[n][s] = __builtin_bit_cast(bf16x8, a); waf[n][s] = __builtin_bit_cast(bf16x8, b);
        }
    const int atok = tid >> 5, aj = (tid & 31) * 4;
    float amu[4];
#pragma unroll
    for (int q = 0; q < 4; ++q) amu[q] = P.mu[1536 + aj + q];
#define PR_FILL(unit) { const int r0_ = (unit) * 16; const bool smp_ = r0_ >= MP; int tid_ = tid; asm volatile("" : "+v"(tid_)); \
        _Pragma("unroll") for (int hb = 0; hb < 2; ++hb) { u32x4 pre[4]; \
        _Pragma("unroll") for (int i = 0; i < 4; ++i) { const int id = tid_ + NTHR * (hb * 4 + i); const int row = id / 208, cc = id - row * 208; u32x4 v = (u32x4){0u, 0u, 0u, 0u}; \
            if (row >= 1 && row <= 16) v = *(const u32x4*)(H + (size_t)(r0_ + row - 1) * DIN + cc * 8); \
            else if (row == 0 && !smp_) { if ((r0_ & (TP - 1)) != 0) v = *(const u32x4*)(H + (size_t)(r0_ - 1) * DIN + cc * 8); } \
            else if (row < 18 && smp_) { const float* sp = P.state_shift + (size_t)(((r0_ - MP) >> 3) + (row == 17 ? 1 : 0)) * DSH + cc * 8; \
                const f32x4 s0 = *(const f32x4*)sp, s1 = *(const f32x4*)(sp + 4); v.x = pack2(s0[0], s0[1]); v.y = pack2(s0[2], s0[3]); v.z = pack2(s1[0], s1[1]); v.w = pack2(s1[2], s1[3]); } \
            pre[i] = v; } \
        _Pragma("unroll") for (int i = 0; i < 4; ++i) { const int id = tid_ + NTHR * (hb * 4 + i); const int row = id / 208, cc = id - row * 208; if (id < 18 * 208) *(u32x4*)(lds + PR_FS + row * PR_ROWB + cc * 16) = pre[i]; } \
        asm volatile("" ::: "memory"); } }
    int unit = ((int)blockIdx.x >> 3) < 8 ? MP / 16 + ((int)blockIdx.x & 7) * 8 + ((int)blockIdx.x >> 3) : MT / 16;
    if (unit < MT / 16) { PR_FILL(unit); }
    __syncthreads();
    for (; unit < MT / 16; unit += gridDim.x) {
        const int r0 = unit * 16; const bool smp = r0 >= MP;
        const int nxt = unit + gridDim.x;
        {
            const int prow = (smp && atok == 8) ? 17 : atok;
            const uint2 fc = *(const uint2*)(lds + PR_FS + (atok + 1) * PR_ROWB + (1536 + aj) * 2), fp = *(const uint2*)(lds + PR_FS + prow * PR_ROWB + (1536 + aj) * 2);
            float x[4];
            x[0] = bflo(fc.x) + (bflo(fp.x) - bflo(fc.x)) * amu[0]; x[1] = bfhi(fc.x) + (bfhi(fp.x) - bfhi(fc.x)) * amu[1];
            x[2] = bflo(fc.y) + (bflo(fp.y) - bflo(fc.y)) * amu[2]; x[3] = bfhi(fc.y) + (bfhi(fp.y) - bfhi(fc.y)) * amu[3];
            if (aj < 64) {
#pragma unroll
                for (int q = 0; q < 4; ++q) x[q] = 1.0f - 2.0f * frcp_(1.0f + fexp2_(2.88539008f * x[q]));
            }
            *(uint2*)(lds + PR_AT + (aj < 64 ? 0 : 2048) + atok * 128 + (aj & 63) * 2) = make_uint2(pack2(x[0], x[1]), pack2(x[2], x[3]));
        }
        __syncthreads();
        f32x4 accw[4], acca[4];
        {
            bf16x8 tf[2], af[2];
#pragma unroll
            for (int s = 0; s < 2; ++s) {
                tf[s] = *(const bf16x8*)(lds + PR_AT + (lane & 15) * 128 + (32 * s + 8 * (lane >> 4)) * 2);
                af[s] = *(const bf16x8*)(lds + PR_AT + 2048 + (lane & 15) * 128 + (32 * s + 8 * (lane >> 4)) * 2);
            }
#pragma unroll
            for (int n = 0; n < 4; ++n) {
                f32x4 cw = (f32x4){0.f, 0.f, 0.f, 0.f}, ca = (f32x4){0.f, 0.f, 0.f, 0.f};
#pragma unroll
                for (int s = 0; s < 2; ++s) {
                    cw = __builtin_amdgcn_mfma_f32_16x16x32_bf16(wdf[n][s], tf[s], cw, 0, 0, 0);
                    ca = __builtin_amdgcn_mfma_f32_16x16x32_bf16(waf[n][s], af[s], ca, 0, 0, 0);
                }
                accw[n] = cw; acca[n] = ca;
            }
        }
        const int tok = lane & 15, row = r0 + tok;
        const int prow = (smp && tok == 8) ? 17 : tok;
        const unsigned char* fcur = lds + PR_FS + (tok + 1) * PR_ROWB;
        const unsigned char* fprv = lds + PR_FS + prow * PR_ROWB;
        float ss = 0.f, rks = 0.f;
#pragma unroll
        for (int n = 0; n < 4; ++n) {
            const int c0 = h * 64 + 16 * n + 4 * (lane >> 4);
            const f32x4 cmk = *(const f32x4*)(cst + 1536 + c0), ckk = *(const f32x4*)(cst + 2560 + c0);
            const uint2 kc = *(const uint2*)(fcur + (512 + c0) * 2), kp = *(const uint2*)(fprv + (512 + c0) * 2);
            const float fk[4] = {bflo(kc.x), bfhi(kc.x), bflo(kc.y), bfhi(kc.y)}, pk[4] = {bflo(kp.x), bfhi(kp.x), bflo(kp.y), bfhi(kp.y)};
#pragma unroll
            for (int q = 0; q < 4; ++q) { const float kk = (fk[q] + (pk[q] - fk[q]) * cmk[q]) * ckk[q]; ss += kk * kk; }
        }
        asm volatile("" ::: "memory"); __builtin_amdgcn_sched_barrier(0);
        ss += __shfl_xor(ss, 16); ss += __shfl_xor(ss, 32);
        const float kn = rsqrtf(fmaxf(ss, 1e-24f));
#pragma unroll
        for (int n = 0; n < 4; ++n) {
            const int c0 = h * 64 + 16 * n + 4 * (lane >> 4);
            const f32x4 cw0 = *(const f32x4*)(cst + c0), ca0 = *(const f32x4*)(cst + 512 + c0), cmr = *(const f32x4*)(cst + 1024 + c0), cmk = *(const f32x4*)(cst + 1536 + c0);
            const f32x4 cmv = *(const f32x4*)(cst + 2048 + c0), ckk = *(const f32x4*)(cst + 2560 + c0), cka = *(const f32x4*)(cst + 3072 + c0), crk = *(const f32x4*)(cst + 3584 + c0);
            const uint2 rc = *(const uint2*)(fcur + c0 * 2), rp = *(const uint2*)(fprv + c0 * 2);
            const uint2 kc = *(const uint2*)(fcur + (512 + c0) * 2), kp = *(const uint2*)(fprv + (512 + c0) * 2);
            const uint2 vc = *(const uint2*)(fcur + (1024 + c0) * 2), vp = *(const uint2*)(fprv + (1024 + c0) * 2);
            const float fr[4] = {bflo(rc.x), bfhi(rc.x), bflo(rc.y), bfhi(rc.y)}, pr[4] = {bflo(rp.x), bfhi(rp.x), bflo(rp.y), bfhi(rp.y)};
            const float fk[4] = {bflo(kc.x), bfhi(kc.x), bflo(kc.y), bfhi(kc.y)}, pk[4] = {bflo(kp.x), bfhi(kp.x), bflo(kp.y), bfhi(kp.y)};
            const float fv[4] = {bflo(vc.x), bfhi(vc.x), bflo(vc.y), bfhi(vc.y)}, pv[4] = {bflo(vp.x), bfhi(vp.x), bflo(vp.y), bfhi(vp.y)};
            float r[4], k2[4], v[4], e2[4], eta[4], kk[4];
#pragma unroll
            for (int q = 0; q < 4; ++q) {
                r[q] = fr[q] + (pr[q] - fr[q]) * cmr[q];
                const float k = fk[q] + (pk[q] - fk[q]) * cmk[q];
                v[q] = fv[q] + (pv[q] - fv[q]) * cmv[q];
                e2[q] = 0.87506123f * sigmoidf_(accw[n][q] + cw0[q]);
                eta[q] = sigmoidf_(acca[n][q] + ca0[q]);
                kk[q] = k * ckk[q] * kn;
                k2[q] = k * (1.0f + (eta[q] - 1.0f) * cka[q]);
                rks += r[q] * k2[q] * crk[q];
            }
            const size_t o = (size_t)row * 512 + c0;
            *(uint2*)(P.Rr + o) = make_uint2(pack2(r[0], r[1]), pack2(r[2], r[3])); *(uint2*)(P.Re + o) = make_uint2(pack2(e2[0], e2[1]), pack2(e2[2], e2[3]));
            *(uint2*)(P.Rk + o) = make_uint2(pack2(k2[0], k2[1]), pack2(k2[2], k2[3])); *(uint2*)(P.Rv + o) = make_uint2(pack2(v[0], v[1]), pack2(v[2], v[3]));
            *(uint2*)(P.Rkk + o) = make_uint2(pack2(kk[0], kk[1]), pack2(kk[2], kk[3])); *(uint2*)(P.Reta + o) = make_uint2(pack2(eta[0], eta[1]), pack2(eta[2], eta[3]));
            asm volatile("" ::: "memory"); __builtin_amdgcn_sched_barrier(0);
        }
        rks += __shfl_xor(rks, 16); rks += __shfl_xor(rks, 32);
        if ((lane >> 4) == 0) P.rk[(size_t)row * 8 + h] = rks;
        if (!smp) { if (((r0 + 15) & (TP - 1)) == TP - 1) { float* dst = P.o_shift_p + (size_t)(r0 >> 12) * DSH; for (int col = tid; col < DSH; col += NTHR) dst[col] = bf2f(*(const bf16_t*)(lds + PR_FS + 16 * PR_ROWB + col * 2)); } }
        else { const int b0 = (r0 - MP) >> 3;
            for (int col = tid; col < 2 * DSH; col += NTHR) { const int which = col >= DSH, cc = col - which * DSH; P.o_shift_s[(size_t)(b0 + which) * DSH + cc] = bf2f(*(const bf16_t*)(lds + PR_FS + (which ? 16 : 8) * PR_ROWB + cc * 2)); } }
        __syncthreads();
        if (nxt < MT / 16) { PR_FILL(nxt); }
        __syncthreads();
    }
#undef PR_FILL
    if (blockIdx.x < 8) { const bf16_t* hr = H + (size_t)(blockIdx.x * TP + TP - 1) * DIN; for (int col = tid; col < DSH; col += NTHR) P.o_shift_p[(size_t)blockIdx.x * DSH + col] = bf2f(hr[col]); }
}
template <int CTRL> __device__ __forceinline__ float dpp_qp(float x) {
    return __builtin_bit_cast(float, __builtin_amdgcn_update_dpp(0, __builtin_bit_cast(int, x), CTRL, 0xF, 0xF, false));
}
__device__ __forceinline__ float oct_allsum(float x) {
    x += dpp_qp<0xB1>(x);
    x += dpp_qp<0x4E>(x);
    x += dpp_qp<0x141>(x);
    return x;
}
__device__ __forceinline__ void p4_post(const Params& P) {
    int tid_o = TIDX_(P.wid); asm volatile("" : "+v"(tid_o)); const int tid = tid_o, lane = tid & 63, wave = tid >> 6;
    float lw[8], lb[8];
#pragma unroll
    for (int j = 0; j < 8; ++j) { lw[j] = P.lnx_w[lane * 8 + j]; lb[j] = P.lnx_b[lane * 8 + j]; }
    const int xc = (int)blockIdx.x & 7, lwv = ((int)blockIdx.x >> 3) * 8 + wave;
#define POST_ROW(kq) ((kq) < 16 ? xc * TP + lwv + 256 * (kq) : ((kq) == 16 && lwv < 128 ? MP + 128 * xc + lwv : MT))
    for (int it = 0; it < 5; ++it) {
        u32x4 yv[4], vv[4], zv[4]; float rkv[4];
#pragma unroll
        for (int q = 0; q < 4; ++q) {
            const int row = POST_ROW(it * 4 + q);
            if (row < MT) {
                yv[q] = *(const u32x4*)(P.YR + (size_t)row * 512 + lane * 8);
                vv[q] = *(const u32x4*)(P.Rv + (size_t)row * 512 + lane * 8);
                zv[q] = *(const u32x4*)(P.H + (size_t)row * DIN + OFF_ZR + lane * 8);
                rkv[q] = P.rk[(size_t)row * 8 + (lane >> 3)];
            }
        }
#pragma unroll
        for (int q = 0; q < 4; ++q) {
            const int row = POST_ROW(it * 4 + q);
            if (row < MT) {
                float y[8], v[8], z[8];
#pragma unroll
                for (int j = 0; j < 4; ++j) { y[2 * j] = bflo(yv[q][j]); y[2 * j + 1] = bfhi(yv[q][j]); v[2 * j] = bflo(vv[q][j]); v[2 * j + 1] = bfhi(vv[q][j]); z[2 * j] = bflo(zv[q][j]); z[2 * j + 1] = bfhi(zv[q][j]); }
                float s = ((y[0] + y[1]) + (y[2] + y[3])) + ((y[4] + y[5]) + (y[6] + y[7]));
                const float mean = oct_allsum(s) * (1.0f / 64.0f);
                float d[8]; float s2 = 0.f;
#pragma unroll
                for (int j = 0; j < 8; ++j) { d[j] = y[j] - mean; s2 += d[j] * d[j]; }
                const float rstd = rsqrtf(oct_allsum(s2) * (1.0f / 64.0f) + 64e-5f);
                float o[8];
#pragma unroll
                for (int j = 0; j < 8; ++j) { float t = d[j] * rstd * lw[j] + lb[j] + rkv[q] * v[j]; o[j] = t * z[j] * sigmoidf_(z[j]); }
                u32x4 w; w.x = pack2(o[0], o[1]); w.y = pack2(o[2], o[3]); w.z = pack2(o[4], o[5]); w.w = pack2(o[6], o[7]);
                *(u32x4*)(P.H + (size_t)row * DIN + OFF_ZR + lane * 8) = w;
            }
        }
    }
}

__device__ __forceinline__ void p2_zcopy(const Params& P) {
    int tid_o = TIDX_(P.wid); asm volatile("" : "+v"(tid_o)); const int tid = tid_o;
    const int NT_ = gridDim.x * NTHR;
    for (int i = blockIdx.x * NTHR + tid; i < MT * 64; i += NT_ * 4) {
        u32x4 v[4];
#pragma unroll
        for (int q = 0; q < 4; ++q) { const int id = i + q * NT_; if (id < MT * 64) v[q] = *(const u32x4*)(P.H + (size_t)(id >> 6) * DIN + OFF_ZR + (id & 63) * 8); }
#pragma unroll
        for (int q = 0; q < 4; ++q) { const int id = i + q * NT_; if (id < MT * 64) *(u32x4*)(P.XB + (size_t)(id >> 6) * DM + (id & 63) * 8) = v[q]; }
    }
}
#define VT_LD 264
__device__ __forceinline__ void p3_attn_prompt(const Params& P, unsigned char* lds) {
    unsigned char* ldsK = lds;
    bf16_t* ldsVT = (bf16_t*)(lds + 32768);
    const bf16_t* H = P.H;
    int tid_o = TIDX_(P.wid); asm volatile("" : "+v"(tid_o));
    for (int unit = blockIdx.x; unit < 512; unit += gridDim.x) {
        int tid_l = tid_o; asm volatile("" : "+v"(tid_l)); const int tid = tid_l, lane = tid & 63, wid = tid >> 6;
        float kwr[8];
#pragma unroll
        for (int q = 0; q < 8; ++q) kwr[q] = P.k_norm_w[(tid & 7) * 8 + q];
        const int nu_ = (unit & 7) * 64 + (unit >> 3), qb = nu_ & 31, kvh = (nu_ >> 5) & 1, b = nu_ >> 6;
        const int seq_base = b * TP, blk = qb * 128;
        u32x4 qraw[2][4];
        {
            const int g_ = wid & 3, half_ = wid >> 2, head_ = kvh * 4 + g_, ql_ = lane & 31, hh_ = lane >> 5;
            {
                const bf16_t* hr = H + (size_t)(seq_base + blk + half_ * 64 + ql_) * DIN;
#pragma unroll
                for (int s = 0; s < 4; ++s) qraw[0][s] = *(const u32x4*)(hr + OFF_Q + head_ * 64 + s * 16 + hh_ * 8);
            }
        }
        __syncthreads();
#pragma unroll
        for (int i = 0; i < 4; ++i) {
            const int id = tid + NTHR * i, idx = id >> 3, c = id & 7;
            const int pos = blk - 128 + idx;
            u32x4 kv = (u32x4){0u, 0u, 0u, 0u};
            if (pos >= 0) kv = *(const u32x4*)(H + (size_t)(seq_base + pos) * DIN + OFF_K + kvh * 64 + c * 8);
            const int idx2 = (tid & 63) + 64 * i, c2 = tid >> 6, pos2 = blk - 128 + idx2;
            u32x4 vv = (u32x4){0u, 0u, 0u, 0u};
            if (pos2 >= 0) vv = *(const u32x4*)(H + (size_t)(seq_base + pos2) * DIN + OFF_V + kvh * 64 + c2 * 8);
            {
                float kf[8];
#pragma unroll
                for (int q = 0; q < 4; ++q) { kf[2 * q] = bflo(kv[q]); kf[2 * q + 1] = bfhi(kv[q]); }
                float ss = 0.f;
#pragma unroll
                for (int q = 0; q < 8; ++q) ss += kf[q] * kf[q];
                ss = oct_allsum(ss);
                const float rs = rsqrtf(ss * (1.0f / 64.0f) + 1e-6f);
#pragma unroll
                for (int q = 0; q < 8; ++q) kf[q] *= rs * kwr[q];
                kv.x = pack2(kf[0], kf[1]); kv.y = pack2(kf[2], kf[3]); kv.z = pack2(kf[4], kf[5]); kv.w = pack2(kf[6], kf[7]);
                if (qb == 31 && idx >= 128) {
                    const size_t o = ((size_t)(b * 128 + (idx - 128)) * 2 + kvh) * 64 + c * 8;
                    *(f32x4*)(P.o_ck_p + o) = (f32x4){kf[0], kf[1], kf[2], kf[3]}; *(f32x4*)(P.o_ck_p + o + 4) = (f32x4){kf[4], kf[5], kf[6], kf[7]};
                }
            }
            if (qb == 31 && idx2 >= 128) {
                const size_t o = ((size_t)(b * 128 + (idx2 - 128)) * 2 + kvh) * 64 + c2 * 8;
                *(f32x4*)(P.o_cv_p + o) = (f32x4){bflo(vv.x), bfhi(vv.x), bflo(vv.y), bfhi(vv.y)}; *(f32x4*)(P.o_cv_p + o + 4) = (f32x4){bflo(vv.z), bfhi(vv.z), bflo(vv.w), bfhi(vv.w)};
            }
            *(u32x4*)(ldsK + idx * 128 + ((c ^ (idx & 7)) << 4)) = kv;
#pragma unroll
            for (int q = 0; q < 4; ++q) {
                ldsVT[(c2 * 8 + q * 2) * VT_LD + idx2] = (bf16_t)(vv[q] & 0xffffu);
                ldsVT[(c2 * 8 + q * 2 + 1) * VT_LD + idx2] = (bf16_t)(vv[q] >> 16);
            }
        }
        __syncthreads();
        const int g = wid & 3, half = wid >> 2, head = kvh * 4 + g;
        {
            const bf16_t* hr = H + (size_t)(seq_base + blk + half * 64 + 32 + (lane & 31)) * DIN;
#pragma unroll
            for (int s = 0; s < 4; ++s) qraw[1][s] = *(const u32x4*)(hr + OFF_Q + head * 64 + s * 16 + (lane >> 5) * 8);
        }
        const float sink = P.sinks[head] * 1.44269504f;
        const int ql = lane & 31, hh = lane >> 5;
#pragma unroll
        for (int sb = 0; sb < 2; ++sb) {
            const int q0 = half * 64 + sb * 32;
            const int qrow = seq_base + blk + q0 + ql;
            uint2 zz[8];
            { const bf16_t* zr_ = H + (size_t)qrow * DIN + OFF_ZA + head * 64;
#pragma unroll
              for (int dt = 0; dt < 2; ++dt)
#pragma unroll
                for (int gq = 0; gq < 4; ++gq) zz[dt * 4 + gq] = *(const uint2*)(zr_ + dt * 32 + 8 * gq + 4 * hh); }
            bf16x8 qf[4];
            {
                float ss = 0.f;
#pragma unroll
                for (int s = 0; s < 4; ++s) {
#pragma unroll
                    for (int q = 0; q < 4; ++q) { const float x0 = bflo(qraw[sb][s][q]), x1 = bfhi(qraw[sb][s][q]); ss += x0 * x0 + x1 * x1; } }
                ss += __shfl_xor(ss, 32);
                const float rs = rsqrtf(ss * (1.0f / 64.0f) + 1e-6f) * (0.125f * 1.44269504f);
#pragma unroll
                for (int s = 0; s < 4; ++s) { u32x4 w;
#pragma unroll
                    for (int q = 0; q < 4; ++q) { const int d = s * 16 + hh * 8 + q * 2; w[q] = pack2(bflo(qraw[sb][s][q]) * rs * P.q_norm_w[d], bfhi(qraw[sb][s][q]) * rs * P.q_norm_w[d + 1]); }
                    qf[s] = __builtin_bit_cast(bf16x8, w); }
            }
            const int t0 = q0 >> 5;
            f32x16 sc[5];
#pragma unroll
            for (int kt = 0; kt < 5; ++kt) {
                f32x16 a;
#pragma unroll
                for (int r = 0; r < 16; ++r) a[r] = 0.f;
                const int krow = (t0 + kt) * 32 + ql;
#pragma unroll
                for (int s = 0; s < 4; ++s) {
                    const int c = s * 2 + hh;
                    const bf16x8 kf = *(const bf16x8*)(ldsK + krow * 128 + ((c ^ (krow & 7)) << 4));
                    a = __builtin_amdgcn_mfma_f32_32x32x16_bf16(kf, qf[s], a, 0, 0, 0);
                }
                sc[kt] = a;
            }
            const int kt_min = (qb == 0) ? 4 - t0 : 0;
            const int xq = ql - 4 * hh;
            float m = sink;
#pragma unroll
            for (int kt = 0; kt < 5; ++kt) {
                const bool dead = kt < kt_min;
#pragma unroll
                for (int r = 0; r < 16; ++r) {
                    const int cr = (r & 3) + 8 * (r >> 2);
                    const bool bad = dead || (kt == 0 && cr <= xq) || (kt == 4 && cr > xq);
                    const float s = bad ? -1e30f : sc[kt][r];
                    sc[kt][r] = s;
                    m = fmaxf(m, s);
                }
            }
            m = fmaxf(m, __shfl_xor(m, 32));
            float sum = 0.f;
#pragma unroll
            for (int kt = 0; kt < 5; ++kt)
#pragma unroll
                for (int r = 0; r < 16; ++r) { const float p = fexp2_(sc[kt][r] - m); sc[kt][r] = p; sum += p; }
            sum += __shfl_xor(sum, 32);
            const float inv = frcp_(sum + fexp2_(sink - m));
            f32x16 o[2];
#pragma unroll
            for (int dt = 0; dt < 2; ++dt)
#pragma unroll
                for (int r = 0; r < 16; ++r) o[dt][r] = 0.f;
#pragma unroll
            for (int kt = 0; kt < 5; ++kt)
#pragma unroll
                for (int s = 0; s < 2; ++s) {
                    u32x4 pw;
                    pw.x = pack2(sc[kt][8 * s + 0], sc[kt][8 * s + 1]); pw.y = pack2(sc[kt][8 * s + 2], sc[kt][8 * s + 3]);
                    pw.z = pack2(sc[kt][8 * s + 4], sc[kt][8 * s + 5]); pw.w = pack2(sc[kt][8 * s + 6], sc[kt][8 * s + 7]);
                    const bf16x8 pf = __builtin_bit_cast(bf16x8, pw);
                    const int key0 = (t0 + kt) * 32 + 16 * s + 4 * hh;
#pragma unroll
                    for (int dt = 0; dt < 2; ++dt) {
                        const bf16_t* vp = ldsVT + (dt * 32 + ql) * VT_LD + key0;
                        const uint2 v0 = *(const uint2*)vp, v1 = *(const uint2*)(vp + 8);
                        u32x4 vw; vw.x = v0.x; vw.y = v0.y; vw.z = v1.x; vw.w = v1.y;
                        const bf16x8 vf = __builtin_bit_cast(bf16x8, vw);
                        o[dt] = __builtin_amdgcn_mfma_f32_32x32x16_bf16(vf, pf, o[dt], 0, 0, 0);
                    }
                }
            const bf16_t* zr = H + (size_t)qrow * DIN + OFF_ZA + head * 64;
            int qrow_o = qrow; asm volatile("" : "+v"(qrow_o));
            bf16_t* orow = (bf16_t*)((unsigned char*)P.H + ((unsigned)qrow_o * (unsigned)(DIN * 2) + (unsigned)((OFF_Q + head * 64) * 2)));
#pragma unroll
            for (int dt = 0; dt < 2; ++dt)
#pragma unroll
                for (int gq = 0; gq < 4; ++gq) {
                    const int d = dt * 32 + 8 * gq + 4 * hh;
                    const uint2 z2 = zz[dt * 4 + gq];
                    const float z0 = bflo(z2.x), z1 = bfhi(z2.x), z2f = bflo(z2.y), z3 = bfhi(z2.y);
                    const float o0 = o[dt][gq * 4 + 0] * inv * z0 * sigmoidf_(z0);
                    const float o1 = o[dt][gq * 4 + 1] * inv * z1 * sigmoidf_(z1);
                    const float o2 = o[dt][gq * 4 + 2] * inv * z2f * sigmoidf_(z2f);
                    const float o3 = o[dt][gq * 4 + 3] * inv * z3 * sigmoidf_(z3);
                    *(uint2*)(orow + d) = make_uint2(pack2(o0, o1), pack2(o2, o3));
                }
            __builtin_amdgcn_sched_barrier(0);
        }
    }
}

#define VS_LD 168
__device__ __forceinline__ void p3_attn_sample(const Params& P, unsigned char* lds) {
    unsigned char* ldsK = lds;
    bf16_t* ldsVT = (bf16_t*)(lds + 20480);
    const bf16_t* H = P.H;
    int tid_o = TIDX_(P.wid); asm volatile("" : "+v"(tid_o)); const int tid = tid_o, lane = tid & 63, wid = tid >> 6;
    for (int unit = blockIdx.x; unit < 256; unit += gridDim.x) {
        const int b = 16 * (unit & 7) + (unit >> 4), kvh = (unit >> 3) & 1;
        __syncthreads();
#pragma unroll
        for (int i = 0; i < 2; ++i) {
            const int id = tid + NTHR * i, j = id >> 3, c = id & 7;
            const float* kp = P.cache_k + ((size_t)(b * 128 + j) * 2 + kvh) * 64 + c * 8;
            const f32x4 k0 = *(const f32x4*)kp, k1 = *(const f32x4*)(kp + 4);
            *(u32x4*)(ldsK + j * 128 + ((c ^ (j & 7)) << 4)) = (u32x4){pack2(k0[0], k0[1]), pack2(k0[2], k0[3]), pack2(k1[0], k1[1]), pack2(k1[2], k1[3])};
            if (j >= 8) { float* op = P.o_ck_s + ((size_t)(b * 128 + j - 8) * 2 + kvh) * 64 + c * 8; *(f32x4*)op = k0; *(f32x4*)(op + 4) = k1; }
            const int j2 = (tid & 63) + 64 * i, c2 = tid >> 6;
            const float* vp = P.cache_v + ((size_t)(b * 128 + j2) * 2 + kvh) * 64 + c2 * 8;
            const f32x4 v0 = *(const f32x4*)vp, v1 = *(const f32x4*)(vp + 4);
#pragma unroll
            for (int q = 0; q < 4; ++q) { ldsVT[(c2 * 8 + q) * VS_LD + j2] = f2bf(v0[q]); ldsVT[(c2 * 8 + 4 + q) * VS_LD + j2] = f2bf(v1[q]); }
            if (j2 >= 8) { float* op = P.o_cv_s + ((size_t)(b * 128 + j2 - 8) * 2 + kvh) * 64 + c2 * 8; *(f32x4*)op = v0; *(f32x4*)(op + 4) = v1; }
        }
        if (tid < 64) {
            const int t = tid >> 3, c = tid & 7;
            const bf16_t* hr = H + (size_t)(MP + b * TS + t) * DIN;
            const u32x4 kv = *(const u32x4*)(hr + OFF_K + kvh * 64 + c * 8), vv = *(const u32x4*)(hr + OFF_V + kvh * 64 + c * 8);
            float kf[8], vf[8];
#pragma unroll
            for (int q = 0; q < 4; ++q) { kf[2 * q] = bflo(kv[q]); kf[2 * q + 1] = bfhi(kv[q]); vf[2 * q] = bflo(vv[q]); vf[2 * q + 1] = bfhi(vv[q]); }
            float ss = 0.f;
#pragma unroll
            for (int q = 0; q < 8; ++q) ss += kf[q] * kf[q];
            ss = oct_allsum(ss);
            const float rs = rsqrtf(ss * (1.0f / 64.0f) + 1e-6f);
#pragma unroll
            for (int q = 0; q < 8; ++q) kf[q] *= rs * P.k_norm_w[c * 8 + q];
            const int j = 128 + t;
            *(u32x4*)(ldsK + j * 128 + ((c ^ (j & 7)) << 4)) = (u32x4){pack2(kf[0], kf[1]), pack2(kf[2], kf[3]), pack2(kf[4], kf[5]), pack2(kf[6], kf[7])};
#pragma unroll
            for (int q = 0; q < 8; ++q) ldsVT[(c * 8 + q) * VS_LD + j] = f2bf(vf[q]);
            float* okp = P.o_ck_s + ((size_t)(b * 128 + 120 + t) * 2 + kvh) * 64 + c * 8; float* ovp = P.o_cv_s + ((size_t)(b * 128 + 120 + t) * 2 + kvh) * 64 + c * 8;
            *(f32x4*)okp = (f32x4){kf[0], kf[1], kf[2], kf[3]}; *(f32x4*)(okp + 4) = (f32x4){kf[4], kf[5], kf[6], kf[7]};
            *(f32x4*)ovp = (f32x4){vf[0], vf[1], vf[2], vf[3]}; *(f32x4*)(ovp + 4) = (f32x4){vf[4], vf[5], vf[6], vf[7]};
        } else if (tid < 64 + 192) {
            const int id = tid - 64, j = 136 + (id >> 3), c = id & 7;
            *(u32x4*)(ldsK + j * 128 + ((c ^ (j & 7)) << 4)) = (u32x4){0u, 0u, 0u, 0u};
#pragma unroll
            for (int q = 0; q < 8; ++q) ldsVT[(c * 8 + q) * VS_LD + j] = (bf16_t)0;
        }
        __syncthreads();
        if (wid == 0) {
            const int ql = lane & 31, hh = lane >> 5, t = ql >> 2, g = ql & 3, head = kvh * 4 + g;
            const int qrow = MP + b * TS + t;
            const float sink = P.sinks[head];
            uint2 zz[8];
            { const bf16_t* zr_ = H + (size_t)qrow * DIN + OFF_ZA + head * 64;
#pragma unroll
              for (int dt = 0; dt < 2; ++dt)
#pragma unroll
                for (int gq = 0; gq < 4; ++gq) zz[dt * 4 + gq] = *(const uint2*)(zr_ + dt * 32 + 8 * gq + 4 * hh); }
            bf16x8 qf[4];
            {
                u32x4 qraw[4]; float ss = 0.f;
#pragma unroll
                for (int s = 0; s < 4; ++s) { qraw[s] = *(const u32x4*)(H + (size_t)qrow * DIN + OFF_Q + head * 64 + s * 16 + hh * 8);
#pragma unroll
                    for (int q = 0; q < 4; ++q) { const float x0 = bflo(qraw[s][q]), x1 = bfhi(qraw[s][q]); ss += x0 * x0 + x1 * x1; } }
                ss += __shfl_xor(ss, 32);
                const float rs = rsqrtf(ss * (1.0f / 64.0f) + 1e-6f) * 0.125f;
#pragma unroll
                for (int s = 0; s < 4; ++s) { u32x4 w;
#pragma unroll
                    for (int q = 0; q < 4; ++q) { const int d = s * 16 + hh * 8 + q * 2; w[q] = pack2(bflo(qraw[s][q]) * rs * P.q_norm_w[d], bfhi(qraw[s][q]) * rs * P.q_norm_w[d + 1]); }
                    qf[s] = __builtin_bit_cast(bf16x8, w); }
            }
            f32x16 sc[5];
#pragma unroll
            for (int kt = 0; kt < 5; ++kt) {
                f32x16 a;
#pragma unroll
                for (int r = 0; r < 16; ++r) a[r] = 0.f;
                const int krow = kt * 32 + ql;
#pragma unroll
                for (int s = 0; s < 4; ++s) {
                    const int c = s * 2 + hh;
                    const bf16x8 kf = *(const bf16x8*)(ldsK + krow * 128 + ((c ^ (krow & 7)) << 4));
                    a = __builtin_amdgcn_mfma_f32_32x32x16_bf16(kf, qf[s], a, 0, 0, 0);
                }
                sc[kt] = a;
            }
            float m = sink;
#pragma unroll
            for (int kt = 0; kt < 5; ++kt)
#pragma unroll
                for (int r = 0; r < 16; ++r) {
                    const int kidx = kt * 32 + (r & 3) + 8 * (r >> 2) + 4 * hh;
                    const bool valid = (kidx > t) && (kidx <= t + 128);
                    const float s = valid ? sc[kt][r] : -1e30f;
                    sc[kt][r] = s;
                    m = fmaxf(m, s);
                }
            m = fmaxf(m, __shfl_xor(m, 32));
            float sum = 0.f;
#pragma unroll
            for (int kt = 0; kt < 5; ++kt)
#pragma unroll
                for (int r = 0; r < 16; ++r) { const float p = __expf(sc[kt][r] - m); sc[kt][r] = p; sum += p; }
            sum += __shfl_xor(sum, 32);
            const float inv = 1.0f / (sum + __expf(sink - m));
            f32x16 o[2];
#pragma unroll
            for (int dt = 0; dt < 2; ++dt)
#pragma unroll
                for (int r = 0; r < 16; ++r) o[dt][r] = 0.f;
#pragma unroll
            for (int kt = 0; kt < 5; ++kt)
#pragma unroll
                for (int s = 0; s < 2; ++s) {
                    u32x4 pw;
                    pw.x = pack2(sc[kt][8 * s + 0], sc[kt][8 * s + 1]); pw.y = pack2(sc[kt][8 * s + 2], sc[kt][8 * s + 3]);
                    pw.z = pack2(sc[kt][8 * s + 4], sc[kt][8 * s + 5]); pw.w = pack2(sc[kt][8 * s + 6], sc[kt][8 * s + 7]);
                    const bf16x8 pf = __builtin_bit_cast(bf16x8, pw);
                    const int key0 = kt * 32 + 16 * s + 4 * hh;
#pragma unroll
                    for (int dt = 0; dt < 2; ++dt) {
                        const bf16_t* vp = ldsVT + (dt * 32 + ql) * VS_LD + key0;
                        const uint2 v0 = *(const uint2*)vp, v1 = *(const uint2*)(vp + 8);
                        u32x4 vw; vw.x = v0.x; vw.y = v0.y; vw.z = v1.x; vw.w = v1.y;
                        const bf16x8 vf = __builtin_bit_cast(bf16x8, vw);
                        o[dt] = __builtin_amdgcn_mfma_f32_32x32x16_bf16(vf, pf, o[dt], 0, 0, 0);
                    }
                }
            bf16_t* orow = P.H + (size_t)qrow * DIN + OFF_Q + head * 64;
#pragma unroll
            for (int dt = 0; dt < 2; ++dt)
#pragma unroll
                for (int gq = 0; gq < 4; ++gq) {
                    const int d = dt * 32 + 8 * gq + 4 * hh;
                    const uint2 z2 = zz[dt * 4 + gq];
                    const float z0 = bflo(z2.x), z1 = bfhi(z2.x), z2f = bflo(z2.y), z3 = bfhi(z2.y);
                    const float o0 = o[dt][gq * 4 + 0] * inv * z0 * sigmoidf_(z0);
                    const float o1 = o[dt][gq * 4 + 1] * inv * z1 * sigmoidf_(z1);
                    const float o2 = o[dt][gq * 4 + 2] * inv * z2f * sigmoidf_(z2f);
                    const float o3 = o[dt][gq * 4 + 3] * inv * z3 * sigmoidf_(z3);
                    *(uint2*)(orow + d) = make_uint2(pack2(o0, o1), pack2(o2, o3));
                }
        }
    }
}
#define SS_BUF 2832
__device__ __forceinline__ void p3_scan(const Params& P, unsigned char* lds) {
    int tid_o = TIDX_(P.wid); asm volatile("" : "+v"(tid_o)); const int tid = tid_o, lane = tid & 63, wv = tid >> 6;
    const int grp = wv >> 2, tl = tid & 255;
    float* const B_ = (float*)lds + grp * SS_BUF;
    const int row_local = (wv & 3) * 4 + (lane >> 4), kq = lane & 15;
    const int stok = tl >> 3, scc = tl & 7; const bool stager = tl < 64;
    u32x4 gr = (u32x4){0u, 0u, 0u, 0u}, ge = gr, gk = gr, gv = gr, gkk = gr, get = gr;
    f32x4 Snext = (f32x4){0.f, 0.f, 0.f, 0.f};
#define SS_UNIT(p) (512 * ((int)blockIdx.x & 7) + ((int)blockIdx.x >> 3) * 16 + 2 * (p) + grp)
#define SS_PREFETCH(p) { const int un_ = SS_UNIT(p), b_ = un_ >> 5, h_ = (un_ >> 2) & 7, vq_ = un_ & 3; \
        Snext = *(const f32x4*)(P.state_rwkv + (size_t)(b_ * 8 + h_) * 4096 + (vq_ * 16 + row_local) * 64 + kq * 4); \
        if (stager) { const size_t o = (size_t)(MP + b_ * TS + stok) * 512 + h_ * 64 + scc * 8; \
            gr = *(const u32x4*)(P.Rr + o); ge = *(const u32x4*)(P.Re + o); gk = *(const u32x4*)(P.Rk + o); gv = *(const u32x4*)(P.Rv + o); gkk = *(const u32x4*)(P.Rkk + o); get = *(const u32x4*)(P.Reta + o); } }
    SS_PREFETCH(0)
    for (int p = 0; p < 8; ++p) {
        const int un = SS_UNIT(p), b = un >> 5, h = (un >> 2) & 7, vq = un & 3;
        __syncthreads();
        if (stager) {
            const int bo = stok * 64 + scc * 8; float fa[8], fwr[8], fw[8], fb[8], fk[8]; float br = 0.f, kr = 0.f;
#pragma unroll
            for (int q = 0; q < 4; ++q) {
                const float kk0 = bflo(gkk[q]), kk1 = bfhi(gkk[q]), r0 = bflo(gr[q]), r1 = bfhi(gr[q]);
                fa[2 * q] = -kk0; fa[2 * q + 1] = -kk1; fb[2 * q] = kk0 * bflo(get[q]); fb[2 * q + 1] = kk1 * bfhi(get[q]);
                fw[2 * q] = fexp2_(-bflo(ge[q])); fw[2 * q + 1] = fexp2_(-bfhi(ge[q])); fwr[2 * q] = fw[2 * q] * r0; fwr[2 * q + 1] = fw[2 * q + 1] * r1;
                fk[2 * q] = bflo(gk[q]); fk[2 * q + 1] = bfhi(gk[q]);
                br += fb[2 * q] * r0 + fb[2 * q + 1] * r1; kr += fk[2 * q] * r0 + fk[2 * q + 1] * r1; }
            *(f32x4*)(B_ + bo) = (f32x4){fa[0], fa[1], fa[2], fa[3]}; *(f32x4*)(B_ + bo + 4) = (f32x4){fa[4], fa[5], fa[6], fa[7]};
            *(f32x4*)(B_ + 512 + bo) = (f32x4){fwr[0], fwr[1], fwr[2], fwr[3]}; *(f32x4*)(B_ + 512 + bo + 4) = (f32x4){fwr[4], fwr[5], fwr[6], fwr[7]};
            *(f32x4*)(B_ + 1024 + bo) = (f32x4){fw[0], fw[1], fw[2], fw[3]}; *(f32x4*)(B_ + 1024 + bo + 4) = (f32x4){fw[4], fw[5], fw[6], fw[7]};
            *(f32x4*)(B_ + 1536 + bo) = (f32x4){fb[0], fb[1], fb[2], fb[3]}; *(f32x4*)(B_ + 1536 + bo + 4) = (f32x4){fb[4], fb[5], fb[6], fb[7]};
            *(f32x4*)(B_ + 2048 + bo) = (f32x4){fk[0], fk[1], fk[2], fk[3]}; *(f32x4*)(B_ + 2048 + bo + 4) = (f32x4){fk[4], fk[5], fk[6], fk[7]};
            if ((scc >> 1) == vq) { float* vp = B_ + 2560 + stok * 16 + (scc & 1) * 8;
                *(f32x4*)vp = (f32x4){bflo(gv[0]), bfhi(gv[0]), bflo(gv[1]), bfhi(gv[1])}; *(f32x4*)(vp + 4) = (f32x4){bflo(gv[2]), bfhi(gv[2]), bflo(gv[3]), bfhi(gv[3])}; }
            br = oct_allsum(br); kr = oct_allsum(kr);
            if (scc == 0) { B_[2688 + stok * 2] = br; B_[2688 + stok * 2 + 1] = kr; }
        }
        float S[4] = {Snext[0], Snext[1], Snext[2], Snext[3]};
        if (p + 1 < 8) SS_PREFETCH(p + 1)
        __syncthreads();
        {
            const float* pa = B_ + kq * 4; const float* pv = B_ + 2560 + row_local; const float* pbk = B_ + 2688; float* py = B_ + 2704 + row_local;
#define SS_LOAD(X, tt) const f32x4 a_##X = *(const f32x4*)(pa + (tt) * 64), wr_##X = *(const f32x4*)(pa + 512 + (tt) * 64), w_##X = *(const f32x4*)(pa + 1024 + (tt) * 64), \
                b_##X = *(const f32x4*)(pa + 1536 + (tt) * 64), k_##X = *(const f32x4*)(pa + 2048 + (tt) * 64); const float v_##X = pv[(tt) * 16]; const f32x2_t bk_##X = *(const f32x2_t*)(pbk + (tt) * 2);
#define SS_STEP(X, tt) { float u = (S[0] * a_##X[0] + S[1] * a_##X[1]) + (S[2] * a_##X[2] + S[3] * a_##X[3]); \
                float ya = (S[0] * wr_##X[0] + S[1] * wr_##X[1]) + (S[2] * wr_##X[2] + S[3] * wr_##X[3]); \
                u += dpp_f<0x128>(u); ya += dpp_f<0x128>(ya); u += dpp_f<0x124>(u); ya += dpp_f<0x124>(ya); \
                u += dpp_f<0x122>(u); ya += dpp_f<0x122>(ya); u += dpp_f<0x121>(u); ya += dpp_f<0x121>(ya); \
                S[0] = S[0] * w_##X[0] + (v_##X * k_##X[0] + u * b_##X[0]); S[1] = S[1] * w_##X[1] + (v_##X * k_##X[1] + u * b_##X[1]); \
                S[2] = S[2] * w_##X[2] + (v_##X * k_##X[2] + u * b_##X[2]); S[3] = S[3] * w_##X[3] + (v_##X * k_##X[3] + u * b_##X[3]); \
                const float y = ya + (u * bk_##X[0] + v_##X * bk_##X[1]); if (kq == 0) py[(tt) * 16] = y; }
            { SS_LOAD(A, 0) SS_LOAD(B, 1) SS_STEP(A, 0) SS_LOAD(C, 2) SS_STEP(B, 1) SS_LOAD(D, 3) SS_STEP(C, 2) SS_STEP(D, 3) }
            { SS_LOAD(A, 4) SS_LOAD(B, 5) SS_STEP(A, 4) SS_LOAD(C, 6) SS_STEP(B, 5) SS_LOAD(D, 7) SS_STEP(C, 6) SS_STEP(D, 7) }
#undef SS_LOAD
#undef SS_STEP
            f32x4 s4; s4[0] = S[0]; s4[1] = S[1]; s4[2] = S[2]; s4[3] = S[3];
            *(f32x4*)(P.o_state_s + (size_t)(b * 8 + h) * 4096 + (vq * 16 + row_local) * 64 + kq * 4) = s4;
        }
        __syncthreads();
        if (tl < 16) { const int tok = tl >> 1, hf = tl & 1; const float* yp = B_ + 2704 + tok * 16 + hf * 8;
            u32x4 o4; o4.x = pack2(yp[0], yp[1]); o4.y = pack2(yp[2], yp[3]); o4.z = pack2(yp[4], yp[5]); o4.w = pack2(yp[6], yp[7]);
            *(u32x4*)(P.YR + (size_t)(MP + b * TS + tok) * 512 + h * 64 + vq * 16 + hf * 8) = o4; }
    }
#undef SS_UNIT
#undef SS_PREFETCH
}
#define CH_EF 0
#define CH_ZF 17408
#define CH_A 21760
#define CH_R 29952
#define CH_B 38144
#define CH_K 46336
#define CH_AT 54528
#define CH_BH 62720
#define CH_KH 70912
#define CH_VT 79104
#define CH_T 87296
#define CH_AK 95488
#define CH_RB 103680
#define CH_G2 111872
#define CH_QV 120064
__device__ __forceinline__ int sw_ch(int row, int ch) { return (ch ^ row ^ (int)(0x63417250u >> ((row >> 1) & 0x1c))) & 7; }
__device__ __forceinline__ int sw_off(int row, int col) { return row * 128 + ((sw_ch(row, col >> 3) << 4) | ((col & 7) << 1)); }
__device__ __forceinline__ void nt_prod(const unsigned char* Y, const unsigned char* X, f32x4 (&acc)[2], int w, int lane) {
#pragma unroll
    for (int s = 0; s < 2; ++s) {
        const int yr = 16 * (w & 3) + (lane & 15), ch = 4 * s + (lane >> 4);
        const bf16x8 af = *(const bf16x8*)(Y + yr * 128 + (sw_ch(yr, ch) << 4));
#pragma unroll
        for (int n = 0; n < 2; ++n) {
            const int xr = 32 * (w >> 2) + 8 * ((lane & 15) >> 2) + 4 * n + (lane & 3);
            const bf16x8 bf = *(const bf16x8*)(X + xr * 128 + (sw_ch(xr, ch) << 4));
            acc[n] = __builtin_amdgcn_mfma_f32_16x16x32_bf16(bf, af, acc[n], 0, 0, 0);
        }
    }
}
template <int MODE> __device__ __forceinline__ void nt_mask(f32x4 (&acc)[2], int w, int lane) {
    if (MODE == 0) return;
    const int r = 16 * (w & 3) + (lane & 15);
#pragma unroll
    for (int n = 0; n < 2; ++n)
#pragma unroll
        for (int q = 0; q < 4; ++q) {
            const int c = 32 * (w >> 2) + 8 * (lane >> 4) + 4 * n + q;
            const bool keep = MODE == 1 ? (c < r) : MODE == 2 ? (c > r) : (c <= r);
            if (!keep) acc[n][q] = 0.f;
        }
}
__device__ __forceinline__ void nt_init_lds(const unsigned char* I, f32x4 (&acc)[2], int w, int lane) {
    const int r = 16 * (w & 3) + (lane & 15);
    const u32x4 v = *(const u32x4*)(I + sw_off(r, 32 * (w >> 2) + 8 * (lane >> 4)));
    acc[0] = (f32x4){bflo(v.x), bfhi(v.x), bflo(v.y), bfhi(v.y)}; acc[1] = (f32x4){bflo(v.z), bfhi(v.z), bflo(v.w), bfhi(v.w)};
}
__device__ __forceinline__ void nt_store_lds(unsigned char* O, const f32x4 (&acc)[2], int w, int lane) {
    const int r = 16 * (w & 3) + (lane & 15);
    *(u32x4*)(O + sw_off(r, 32 * (w >> 2) + 8 * (lane >> 4))) = (u32x4){pack2(acc[0][0], acc[0][1]), pack2(acc[0][2], acc[0][3]), pack2(acc[1][0], acc[1][1]), pack2(acc[1][2], acc[1][3])};
}
__device__ __forceinline__ void nt_store_f32(float* O, const f32x4 (&acc)[2], int w, int lane) {
    const int r = 16 * (w & 3) + (lane & 15);
#pragma unroll
    for (int n = 0; n < 2; ++n) { const int c = 32 * (w >> 2) + 8 * (lane >> 4) + 4 * n; *(f32x4*)(O + r * 68 + c) = acc[n]; }
}
__device__ __forceinline__ void nt_store_glb(bf16_t* O, const f32x4 (&acc)[2], int w, int lane) {
    const int r = 16 * (w & 3) + (lane & 15);
    *(u32x4*)(O + r * 64 + 32 * (w >> 2) + 8 * (lane >> 4)) = (u32x4){pack2(acc[0][0], acc[0][1]), pack2(acc[0][2], acc[0][3]), pack2(acc[1][0], acc[1][1]), pack2(acc[1][2], acc[1][3])};
}
#define ZACC(a) { a[0] = (f32x4){0.f, 0.f, 0.f, 0.f}; a[1] = (f32x4){0.f, 0.f, 0.f, 0.f}; }

#define CH_TH CH_A
#define CH_AL CH_R
#define CH_WD CH_B
#define CH_WA CH_K
#define CH_ZW CH_AT
#define CH_ZA 71936
#define CH_CST (131072 + 1024)
__device__ __forceinline__ void p3_chunk_a(const Params& P, unsigned char* lds) {
    int tid_o = TIDX_(P.wid); asm volatile("" : "+v"(tid_o)); const int tid = tid_o, lane = tid & 63, w = tid >> 6;
    float* EF = (float*)(lds + CH_EF); float* ZF = (float*)(lds + CH_ZF); float* cst = (float*)(lds + CH_CST);
    const bf16_t* H = P.H;
    const int tok = tid >> 3, cc = tid & 7;
    const int tok2 = (tid & 255) >> 2, cc2 = (tid >> 8) * 4 + (tid & 3);
    __syncthreads();
    { cst[tid] = P.w0[tid]; cst[512 + tid] = P.a0[tid]; cst[1024 + tid] = P.mu[tid]; cst[1536 + tid] = P.mu[512 + tid]; cst[2048 + tid] = P.mu[1024 + tid];
      cst[2560 + tid] = P.k_k[tid]; cst[3072 + tid] = P.k_a[tid]; cst[3584 + tid] = P.r_k[tid]; }
    if (tid < 128) cst[4096 + tid] = P.mu[1536 + tid];
    u32x4 nhr, nhk, nhv, npr, npk, npv, nl0, nl1, nq0, nq1, nwd, nwa;
#define CH_GLOAD(un) { const int bh_ = (un) >> 6, c_ = (un) & 63, h_ = bh_ & 7; const size_t R_ = (size_t)((bh_ >> 3) * TP + c_ * 64 + tok); const bf16_t* hc = H + R_ * DIN; \
        nhr = *(const u32x4*)(hc + h_ * 64 + cc * 8); nhk = *(const u32x4*)(hc + 512 + h_ * 64 + cc * 8); nhv = *(const u32x4*)(hc + 1024 + h_ * 64 + cc * 8); \
        const bf16_t* hl = H + (size_t)((bh_ >> 3) * TP + c_ * 64 + tok2) * DIN + 1536 + 16 * cc2; nl0 = *(const u32x4*)hl; nl1 = *(const u32x4*)(hl + 8); \
        if (c_ == 0 && tok == 0) { npr = (u32x4){0u, 0u, 0u, 0u}; npk = npr; npv = npr; } \
        else { const bf16_t* hp = hc - DIN; npr = *(const u32x4*)(hp + h_ * 64 + cc * 8); npk = *(const u32x4*)(hp + 512 + h_ * 64 + cc * 8); npv = *(const u32x4*)(hp + 1024 + h_ * 64 + cc * 8); } \
        if (c_ == 0 && tok2 == 0) { nq0 = (u32x4){0u, 0u, 0u, 0u}; nq1 = nq0; } else { nq0 = *(const u32x4*)(hl - DIN); nq1 = *(const u32x4*)(hl - DIN + 8); } \
        nwd = *(const u32x4*)(P.WLd + (size_t)h_ * 4096 + tid * 8); nwa = *(const u32x4*)(P.WLa + (size_t)h_ * 4096 + tid * 8); }
#define CH_UNIT(k) ((8 * ((int)blockIdx.x & 7) + (((int)blockIdx.x >> 3) & 7)) * 64 + ((int)blockIdx.x >> 6) + 4 * (k))
    CH_GLOAD(CH_UNIT(0))
    __syncthreads();
    for (int ku = 0; ku < 16; ++ku) { const int unit = CH_UNIT(ku);
        int tid_l = tid; asm volatile("" : "+v"(tid_l));
        const int tok = tid_l >> 3, cc = tid_l & 7, lane = tid_l & 63, w = tid_l >> 6, tok2 = (tid_l & 255) >> 2, cc2 = (tid_l >> 8) * 4 + (tid_l & 3);
        const int bh = unit >> 6, c = unit & 63, b = bh >> 3, h = bh & 7;
        const size_t R = (size_t)(b * TP + c * 64 + tok);
        float r[8], k2[8], v[8], e2[8], kk[8], eta[8];
        {
            const int c0 = h * 64 + cc * 8;
            const f32x4 mr0 = *(const f32x4*)(cst + 1024 + c0), mr1 = *(const f32x4*)(cst + 1024 + c0 + 4), mk0 = *(const f32x4*)(cst + 1536 + c0), mk1 = *(const f32x4*)(cst + 1536 + c0 + 4);
            const f32x4 mv0 = *(const f32x4*)(cst + 2048 + c0), mv1 = *(const f32x4*)(cst + 2048 + c0 + 4);
#pragma unroll
            for (int q = 0; q < 8; ++q) {
                const float fr = (q & 1) ? bfhi(nhr[q >> 1]) : bflo(nhr[q >> 1]), pr = (q & 1) ? bfhi(npr[q >> 1]) : bflo(npr[q >> 1]);
                const float fk = (q & 1) ? bfhi(nhk[q >> 1]) : bflo(nhk[q >> 1]), pk = (q & 1) ? bfhi(npk[q >> 1]) : bflo(npk[q >> 1]);
                const float fv = (q & 1) ? bfhi(nhv[q >> 1]) : bflo(nhv[q >> 1]), pv = (q & 1) ? bfhi(npv[q >> 1]) : bflo(npv[q >> 1]);
                r[q] = fr + (pr - fr) * (q < 4 ? mr0[q & 3] : mr1[q & 3]);
                k2[q] = fk + (pk - fk) * (q < 4 ? mk0[q & 3] : mk1[q & 3]);
                v[q] = fv + (pv - fv) * (q < 4 ? mv0[q & 3] : mv1[q & 3]);
            }
            float x[16];
#pragma unroll
            for (int j = 0; j < 16; ++j) { const unsigned wc_ = j < 8 ? nl0[(j & 7) >> 1] : nl1[(j & 7) >> 1], wp_ = j < 8 ? nq0[(j & 7) >> 1] : nq1[(j & 7) >> 1];
                const float f = (j & 1) ? bfhi(wc_) : bflo(wc_), fp = (j & 1) ? bfhi(wp_) : bflo(wp_);
                x[j] = f + (fp - f) * cst[4096 + 16 * cc2 + j]; }
            if (cc2 < 4) {
#pragma unroll
                for (int j = 0; j < 16; ++j) x[j] = 1.0f - 2.0f * frcp_(1.0f + fexp2_(2.88539008f * x[j]));
            }
            unsigned char* dst = lds + (cc2 < 4 ? CH_TH : CH_AL) + tok2 * 128; const int ch0 = 2 * (cc2 & 3);
            *(u32x4*)(dst + (sw_ch(tok2, ch0) << 4)) = (u32x4){pack2(x[0], x[1]), pack2(x[2], x[3]), pack2(x[4], x[5]), pack2(x[6], x[7])};
            *(u32x4*)(dst + (sw_ch(tok2, ch0 + 1) << 4)) = (u32x4){pack2(x[8], x[9]), pack2(x[10], x[11]), pack2(x[12], x[13]), pack2(x[14], x[15])};
            const int wrow = tid >> 3, wch = tid & 7;
            *(u32x4*)(lds + CH_WD + wrow * 128 + (sw_ch(wrow, wch) << 4)) = nwd; *(u32x4*)(lds + CH_WA + wrow * 128 + (sw_ch(wrow, wch) << 4)) = nwa;
        }
        __syncthreads();
        {
            f32x4 a0[2], a1[2]; ZACC(a0) ZACC(a1)
            nt_prod(lds + CH_TH, lds + CH_WD, a0, w, lane); nt_prod(lds + CH_AL, lds + CH_WA, a1, w, lane);
            nt_store_f32((float*)(lds + CH_ZW), a0, w, lane); nt_store_f32((float*)(lds + CH_ZA), a1, w, lane);
        }
        __syncthreads();
        {
            const int c0 = h * 64 + cc * 8;
            const float* zwp = (const float*)(lds + CH_ZW) + tok * 68 + cc * 8; const float* zap = (const float*)(lds + CH_ZA) + tok * 68 + cc * 8;
            const f32x4 zw0 = *(const f32x4*)zwp + *(const f32x4*)(cst + c0), zw1 = *(const f32x4*)(zwp + 4) + *(const f32x4*)(cst + c0 + 4);
            const f32x4 za0 = *(const f32x4*)zap + *(const f32x4*)(cst + 512 + c0), za1 = *(const f32x4*)(zap + 4) + *(const f32x4*)(cst + 512 + c0 + 4);
            const f32x4 kk0 = *(const f32x4*)(cst + 2560 + c0), kk1 = *(const f32x4*)(cst + 2560 + c0 + 4), ka0 = *(const f32x4*)(cst + 3072 + c0), ka1 = *(const f32x4*)(cst + 3072 + c0 + 4);
            const f32x4 rk0 = *(const f32x4*)(cst + 3584 + c0), rk1 = *(const f32x4*)(cst + 3584 + c0 + 4);
            float ss = 0.f, rks = 0.f;
#pragma unroll
            for (int q = 0; q < 8; ++q) {
                e2[q] = 0.87506123f * sigmoidf_(q < 4 ? zw0[q & 3] : zw1[q & 3]);
                eta[q] = sigmoidf_(q < 4 ? za0[q & 3] : za1[q & 3]);
                const float km = k2[q];
                kk[q] = km * (q < 4 ? kk0[q & 3] : kk1[q & 3]); ss += kk[q] * kk[q];
                k2[q] = km * (1.0f + (eta[q] - 1.0f) * (q < 4 ? ka0[q & 3] : ka1[q & 3]));
                rks += r[q] * k2[q] * (q < 4 ? rk0[q & 3] : rk1[q & 3]);
            }
            ss = oct_allsum(ss); rks = oct_allsum(rks);
            const float kn = rsqrtf(fmaxf(ss, 1e-24f));
#pragma unroll
            for (int q = 0; q < 8; ++q) kk[q] *= kn;
            *(u32x4*)(P.Rv + R * 512 + c0) = (u32x4){pack2(v[0], v[1]), pack2(v[2], v[3]), pack2(v[4], v[5]), pack2(v[6], v[7])};
            if (cc == 0) P.rk[R * 8 + h] = rks;
            *(f32x4*)(EF + tok * 68 + cc * 8) = (f32x4){e2[0], e2[1], e2[2], e2[3]}; *(f32x4*)(EF + tok * 68 + cc * 8 + 4) = (f32x4){e2[4], e2[5], e2[6], e2[7]};
        }
        __syncthreads();
        *(u32x4*)(lds + CH_T + tid * 16) = (u32x4){0u, 0u, 0u, 0u};
        {
            const int ch = tid & 63, seg = tid >> 6;
            float p[8]; float run = 0.f;
#pragma unroll
            for (int q = 0; q < 8; ++q) { run += EF[(8 * seg + q) * 68 + ch]; p[q] = run; }
            ZF[seg * 64 + ch] = run;
            __syncthreads();
            float offs = 0.f;
#pragma unroll
            for (int s2 = 0; s2 < 7; ++s2) if (s2 < seg) offs += ZF[s2 * 64 + ch];
#pragma unroll
            for (int q = 0; q < 8; ++q) EF[(8 * seg + q) * 68 + ch] = p[q] + offs;
            if (seg == 7) ZF[512 + ch] = __builtin_amdgcn_exp2f(-(p[7] + offs));
        }
        __syncthreads();
        {
            const f32x4 E0 = *(const f32x4*)(EF + tok * 68 + cc * 8), E1 = *(const f32x4*)(EF + tok * 68 + cc * 8 + 4);
            const f32x4 C0 = *(const f32x4*)(ZF + 512 + cc * 8), C1 = *(const f32x4*)(ZF + 512 + cc * 8 + 4);
            float At[8], Rt[8], Bt[8], Kt[8], Bh[8], Kh[8];
#pragma unroll
            for (int q = 0; q < 8; ++q) {
                const float E = q < 4 ? E0[q & 3] : E1[q & 3];
                const float g = __builtin_amdgcn_exp2f(-E), gi = __builtin_amdgcn_exp2f(E), gp = __builtin_amdgcn_exp2f(e2[q] - E), gc = gi * (q < 4 ? C0[q & 3] : C1[q & 3]);
                const float bb = kk[q] * eta[q];
                At[q] = -kk[q] * gp; Rt[q] = r[q] * g; Bt[q] = bb * gi; Kt[q] = k2[q] * gi; Bh[q] = bb * gc; Kh[q] = k2[q] * gc;
            }
            const int so = tok * 128 + (sw_ch(tok, cc) << 4);
            *(u32x4*)(lds + CH_A + so) = (u32x4){pack2(At[0], At[1]), pack2(At[2], At[3]), pack2(At[4], At[5]), pack2(At[6], At[7])};
            *(u32x4*)(lds + CH_R + so) = (u32x4){pack2(Rt[0], Rt[1]), pack2(Rt[2], Rt[3]), pack2(Rt[4], Rt[5]), pack2(Rt[6], Rt[7])};
            *(u32x4*)(lds + CH_B + so) = (u32x4){pack2(Bt[0], Bt[1]), pack2(Bt[2], Bt[3]), pack2(Bt[4], Bt[5]), pack2(Bt[6], Bt[7])};
            *(u32x4*)(lds + CH_K + so) = (u32x4){pack2(Kt[0], Kt[1]), pack2(Kt[2], Kt[3]), pack2(Kt[4], Kt[5]), pack2(Kt[6], Kt[7])};
#pragma unroll
            for (int q = 0; q < 8; ++q) {
                const int to = sw_off(cc * 8 + q, tok);
                *(bf16_t*)(lds + CH_AT + to) = f2bf(At[q]); *(bf16_t*)(lds + CH_BH + to) = f2bf(Bh[q]); *(bf16_t*)(lds + CH_KH + to) = f2bf(Kh[q]); *(bf16_t*)(lds + CH_VT + to) = f2bf(v[q]);
            }
            if (tok == 63) { float* gcp = P.SA_GC + (size_t)unit * 64 + cc * 8;
                *(f32x4*)gcp = C0; *(f32x4*)(gcp + 4) = C1; }
        }
        __syncthreads();
        if (ku + 1 < 16) CH_GLOAD(CH_UNIT(ku + 1))
        {
            f32x4 a0[2], a1[2], a2[2]; ZACC(a0) ZACC(a1) ZACC(a2)
            nt_prod(lds + CH_A, lds + CH_B, a0, w, lane); nt_prod(lds + CH_K, lds + CH_A, a1, w, lane); nt_prod(lds + CH_R, lds + CH_B, a2, w, lane);
            nt_mask<1>(a0, w, lane); nt_mask<2>(a1, w, lane); nt_mask<3>(a2, w, lane);
            nt_store_f32(EF, a0, w, lane); nt_store_lds(lds + CH_G2, a0, w, lane); nt_store_lds(lds + CH_AK, a1, w, lane); nt_store_lds(lds + CH_RB, a2, w, lane);
            *(u32x4*)(lds + CH_QV + tid * 16) = (u32x4){0u, 0u, 0u, 0u};
            if (tid < 272) *(u32x4*)(lds + CH_ZF + tid * 16) = (u32x4){0u, 0u, 0u, 0u};
        }
        __syncthreads();
        if (tid < 64) {
            const int d = tid >> 4, j = tid & 15; const float* Ad = EF + (16 * d) * 68 + 16 * d;
            f32x4 ar[16][4]; float col[16];
#pragma unroll
            for (int t = 1; t < 10; ++t)
#pragma unroll
                for (int c4 = 0; c4 * 4 < t; ++c4) ar[t][c4] = *(const f32x4*)(Ad + t * 68 + 4 * c4);
#pragma unroll
            for (int t = 0; t < 10; ++t) { float v = (t == j) ? 1.f : 0.f;
#pragma unroll
                for (int i = 0; i < t; ++i) v += ar[t][i >> 2][i & 3] * col[i];
                col[t] = v; }
#pragma unroll
            for (int t = 10; t < 16; ++t)
#pragma unroll
                for (int c4 = 0; c4 * 4 < t; ++c4) ar[t][c4] = *(const f32x4*)(Ad + t * 68 + 4 * c4);
#pragma unroll
            for (int t = 10; t < 16; ++t) { float v = (t == j) ? 1.f : 0.f;
#pragma unroll
                for (int i = 0; i < t; ++i) v += ar[t][i >> 2][i & 3] * col[i];
                col[t] = v; }
#pragma unroll
            for (int t = 0; t < 16; ++t) { const bf16_t tv = f2bf(col[t]); *(bf16_t*)(lds + CH_T + sw_off(16 * d + t, 16 * d + j)) = tv; *(bf16_t*)(lds + CH_QV + sw_off(16 * d + j, 16 * d + t)) = tv; }
            const int l15 = lane & 15, g4 = lane >> 4;
#define CH_LVL(dd) { _Pragma("unroll") for (int jb = 0; jb < (dd); ++jb) { f32x4 z = (f32x4){0.f, 0.f, 0.f, 0.f}; \
                    _Pragma("unroll") for (int s = 0; s < ((dd) + 1) / 2; ++s) { const int yr = 16 * jb + l15, xr = 16 * (dd) + l15, ch = 4 * s + g4; \
                        const bf16x8 yf = *(const bf16x8*)(lds + CH_QV + yr * 128 + (sw_ch(yr, ch) << 4)), xf = *(const bf16x8*)(lds + CH_G2 + xr * 128 + (sw_ch(xr, ch) << 4)); \
                        z = __builtin_amdgcn_mfma_f32_16x16x32_bf16(xf, yf, z, 0, 0, 0); } \
                    *(uint2*)(lds + CH_ZF + (16 * jb + l15) * 64 + 32 + 8 * g4) = make_uint2(pack2(z[0], z[1]), pack2(z[2], z[3])); } \
                asm volatile("s_waitcnt lgkmcnt(0)" ::: "memory"); \
                _Pragma("unroll") for (int jb = 0; jb < (dd); ++jb) { const int yr = 16 * (dd) + l15, ch = 2 * (dd) - 2 + g4; \
                    const bf16x8 yf = *(const bf16x8*)(lds + CH_T + yr * 128 + (sw_ch(yr, ch) << 4)), xf = *(const bf16x8*)(lds + CH_ZF + (16 * jb + l15) * 64 + 16 * g4); \
                    f32x4 t = __builtin_amdgcn_mfma_f32_16x16x32_bf16(xf, yf, (f32x4){0.f, 0.f, 0.f, 0.f}, 0, 0, 0); \
                    tq[jb] = t; } \
                _Pragma("unroll") for (int jb = 0; jb < (dd); ++jb) { const f32x4 t = tq[jb]; const int rr = 16 * (dd) + l15, cc0 = 16 * jb + 4 * g4; \
                    *(uint2*)(lds + CH_T + sw_off(rr, cc0)) = make_uint2(pack2(t[0], t[1]), pack2(t[2], t[3])); \
                    _Pragma("unroll") for (int q = 0; q < 4; ++q) *(bf16_t*)(lds + CH_QV + sw_off(cc0 + q, rr)) = f2bf(t[q]); } \
                asm volatile("s_waitcnt lgkmcnt(0)" ::: "memory"); }
            asm volatile("s_waitcnt lgkmcnt(0)" ::: "memory");
            f32x4 tq[3];
            CH_LVL(1) CH_LVL(2) CH_LVL(3)
#undef CH_LVL
        }
        __syncthreads();
        {
            f32x4 a0[2], a1[2]; ZACC(a0) ZACC(a1)
            nt_prod(lds + CH_AT, lds + CH_T, a0, w, lane); nt_prod(lds + CH_AK, lds + CH_T, a1, w, lane);
            nt_store_lds(lds + CH_B, a0, w, lane); nt_store_lds(lds + CH_A, a1, w, lane);
        }
        __syncthreads();
        {
            f32x4 a0[2], a1[2], a2[2], a3[2];
            nt_init_lds(lds + CH_R, a0, w, lane); nt_prod(lds + CH_RB, lds + CH_B, a0, w, lane);
            ZACC(a1) nt_prod(lds + CH_R, lds + CH_K, a1, w, lane); nt_mask<3>(a1, w, lane); nt_prod(lds + CH_RB, lds + CH_A, a1, w, lane);
            ZACC(a2) nt_prod(lds + CH_BH, lds + CH_B, a2, w, lane);
            nt_init_lds(lds + CH_KH, a3, w, lane); nt_prod(lds + CH_BH, lds + CH_A, a3, w, lane);
            nt_store_glb(P.SA_G1 + (size_t)unit * 4096, a0, w, lane); nt_store_lds(lds + CH_G2, a1, w, lane);
            nt_store_glb(P.SA_PC + (size_t)unit * 4096, a2, w, lane); nt_store_lds(lds + CH_QV, a3, w, lane);
        }
        __syncthreads();
        {
            f32x4 a0[2], a1[2]; ZACC(a0) ZACC(a1)
            nt_prod(lds + CH_VT, lds + CH_G2, a0, w, lane); nt_prod(lds + CH_VT, lds + CH_QV, a1, w, lane);
            nt_store_glb(P.SA_YL + (size_t)unit * 4096, a0, w, lane); nt_store_glb(P.SA_QT + (size_t)unit * 4096, a1, w, lane);
        }
    }
}

#undef CH_GLOAD
#undef CH_UNIT
#define CB_PC 0
#define CB_G1 8192
#define CB_QT 16384
#define CB_YL 18432
#define CB_GC 20480
#define CB_SLOT 20736
#define CB_SF (2 * CB_SLOT)
__device__ __forceinline__ void p4_chunk_b(const Params& P, unsigned char* lds) {
    int tid_o = TIDX_(P.wid); asm volatile("" : "+v"(tid_o)); const int tid = tid_o, lane = tid & 63, w = tid >> 6;
    for (int unit = blockIdx.x; unit < 256; unit += gridDim.x) {
        const int bh = (unit & 7) * 8 + (unit >> 5), vq = (unit >> 3) & 3, b = bh >> 3, h = bh & 7;
        const size_t u0 = (size_t)bh * 64;
        const int crow = tid >> 3, cch = tid & 7, cdst = crow * 128 + (sw_ch(crow, cch) << 4);
        const size_t x2off = tid < 128 ? (size_t)(16 * vq + (tid >> 3)) * 64 + (tid & 7) * 8 : tid < 256 ? (size_t)(16 * vq + ((tid - 128) >> 3)) * 64 + (tid & 7) * 8 : (size_t)((tid < 272 ? tid - 256 : 0) * 8);
        const int x2dst = tid < 128 ? CB_QT + cdst : tid < 256 ? CB_YL + (crow - 16) * 128 + (sw_ch(crow - 16, cch) << 4) : CB_GC + (tid < 272 ? tid - 256 : 0) * 16;
#define CB_LOAD(X, c) { const size_t uu = u0 + (c); X##0 = *(const u32x4*)(P.SA_PC + uu * 4096 + tid * 8); X##1 = *(const u32x4*)(P.SA_G1 + uu * 4096 + tid * 8); \
        const bf16_t* p2_ = tid < 128 ? P.SA_QT + uu * 4096 : tid < 256 ? P.SA_YL + uu * 4096 : (const bf16_t*)(P.SA_GC + uu * 64); X##2 = *(const u32x4*)(p2_ + x2off); }
#define CB_STORE(X, slot) { unsigned char* sl_ = lds + (slot) * CB_SLOT; *(u32x4*)(sl_ + CB_PC + cdst) = X##0; *(u32x4*)(sl_ + CB_G1 + cdst) = X##1; \
        if (tid < 272) *(u32x4*)(sl_ + x2dst) = X##2; }
        u32x4 A0, A1, A2 = (u32x4){0u, 0u, 0u, 0u}, B0, B1, B2 = A2, C0, C1, C2 = A2, D0, D1, D2 = A2, E0, E1, E2 = A2, F0, F1, F2 = A2;
        f32x4 Sn = (f32x4){0.f, 0.f, 0.f, 0.f};
        __syncthreads();
        if (tid < 128) *(u32x4*)(lds + CB_SF + tid * 16) = (u32x4){0u, 0u, 0u, 0u};
        CB_LOAD(A, 0) CB_STORE(A, 0)
        CB_LOAD(B, 1) CB_LOAD(C, 2) CB_LOAD(D, 3) CB_LOAD(E, 4) CB_LOAD(F, 5)
        asm volatile("s_waitcnt lgkmcnt(0)" ::: "memory"); __builtin_amdgcn_s_barrier(); asm volatile("" ::: "memory");
#define CB_STEP(c, CUR, NXT) { \
        { const unsigned char* sl_ = lds + ((c) & 1) * CB_SLOT; const int v_ = lane & 15, g_ = lane >> 4, n = w & 3, xr = 16 * n + v_; \
            bf16x8 sf[2]; sf[0] = *(const bf16x8*)(lds + CB_SF + ((c) & 1) * 2048 + lane * 16); sf[1] = *(const bf16x8*)(lds + CB_SF + ((c) & 1) * 2048 + 1024 + lane * 16); \
            if (w < 4) {     \
                const uint2 qt = *(const uint2*)(sl_ + CB_QT + sw_off(v_, 16 * n + 4 * g_)); const f32x4 gc = *(const f32x4*)(sl_ + CB_GC + (16 * n + 4 * g_) * 4); \
                f32x4 as = (f32x4){bflo(qt.x), bfhi(qt.x), bflo(qt.y), bfhi(qt.y)} + gc * Sn; \
                _Pragma("unroll") for (int s = 0; s < 2; ++s) { \
                    const uint2 p0 = *(const uint2*)(sl_ + CB_PC + sw_off(xr, 32 * s + 4 * g_)), p1 = *(const uint2*)(sl_ + CB_PC + sw_off(xr, 32 * s + 16 + 4 * g_)); \
                    u32x4 pf; pf.x = p0.x; pf.y = p0.y; pf.z = p1.x; pf.w = p1.y; \
                    as = __builtin_amdgcn_mfma_f32_16x16x32_bf16(__builtin_bit_cast(bf16x8, pf), sf[s], as, 0, 0, 0); } \
                Sn = as; \
                *(uint2*)(lds + CB_SF + (((c) + 1) & 1) * 2048 + (n >> 1) * 1024 + lane * 16 + (n & 1) * 8) = make_uint2(pack2(as[0], as[1]), pack2(as[2], as[3])); \
            } else {         \
                const uint2 yl = *(const uint2*)(sl_ + CB_YL + sw_off(v_, 16 * n + 4 * g_)); f32x4 ay = (f32x4){bflo(yl.x), bfhi(yl.x), bflo(yl.y), bfhi(yl.y)}; \
                _Pragma("unroll") for (int s = 0; s < 2; ++s) { \
                    const uint2 q0 = *(const uint2*)(sl_ + CB_G1 + sw_off(xr, 32 * s + 4 * g_)), q1 = *(const uint2*)(sl_ + CB_G1 + sw_off(xr, 32 * s + 16 + 4 * g_)); \
                    u32x4 gf; gf.x = q0.x; gf.y = q0.y; gf.z = q1.x; gf.w = q1.y; \
                    ay = __builtin_amdgcn_mfma_f32_16x16x32_bf16(__builtin_bit_cast(bf16x8, gf), sf[s], ay, 0, 0, 0); } \
                bf16_t* yo = P.YR + (size_t)(b * TP + (c) * 64) * 512 + h * 64 + 16 * vq + v_; \
                _Pragma("unroll") for (int q = 0; q < 4; ++q) yo[(size_t)(16 * n + 4 * g_ + q) * 512] = f2bf(ay[q]); } } \
        if ((c) + 1 < 64) CB_STORE(NXT, ((c) + 1) & 1) \
        if ((c) + 6 < 64) CB_LOAD(CUR, (c) + 6) \
        asm volatile("s_waitcnt lgkmcnt(0)" ::: "memory"); __builtin_amdgcn_s_barrier(); asm volatile("" ::: "memory"); }
        for (int c = 0; c < 60; c += 6) { CB_STEP(c, A, B) CB_STEP(c + 1, B, C) CB_STEP(c + 2, C, D) CB_STEP(c + 3, D, E) CB_STEP(c + 4, E, F) CB_STEP(c + 5, F, A) }
        CB_STEP(60, A, B) CB_STEP(61, B, C) CB_STEP(62, C, D) CB_STEP(63, D, E)
        if (w < 4) { float* so = P.o_state_p + (size_t)bh * 4096 + (size_t)(16 * vq + (lane & 15)) * 64 + 4 * (lane >> 4); *(f32x4*)(so + 16 * w) = Sn; }
#undef CB_LOAD
#undef CB_STORE
#undef CB_STEP
    }
}
template <int MODE>
__device__ __forceinline__ void g64_phase(const Params& P, unsigned char* lds, const bf16_t* A, const int lda, const bf16_t* Bt) {
    int tid_o = TIDX_(P.wid); asm volatile("" : "+v"(tid_o)); const int tid = tid_o, lane = tid & 63, w = tid >> 6;
    for (int tile = blockIdx.x; tile < 256; tile += gridDim.x) {
        const int row0 = MP + 64 * ((tile & 7) * 2 + (tile >> 7)), col0 = 64 * ((tile >> 3) & 15);
        u32x4 af[4][4], bf[4][4];
#pragma unroll
        for (int s = 0; s < 4; ++s)
#pragma unroll
            for (int m = 0; m < 4; ++m) {
                af[m][s] = *(const u32x4*)(A + (size_t)(row0 + 16 * m + (lane & 15)) * lda + 128 * w + 32 * s + 8 * (lane >> 4));
                bf[m][s] = *(const u32x4*)(Bt + (size_t)(col0 + 16 * m + (lane & 15)) * DM + 128 * w + 32 * s + 8 * (lane >> 4));
            }
        f32x4 acc[4][4];
#pragma unroll
        for (int m = 0; m < 4; ++m)
#pragma unroll
            for (int n = 0; n < 4; ++n) acc[m][n] = (f32x4){0.f, 0.f, 0.f, 0.f};
#pragma unroll
        for (int s = 0; s < 4; ++s)
#pragma unroll
            for (int m = 0; m < 4; ++m)
#pragma unroll
                for (int n = 0; n < 4; ++n) acc[m][n] = __builtin_amdgcn_mfma_f32_16x16x32_bf16(__builtin_bit_cast(bf16x8, bf[n][s]), __builtin_bit_cast(bf16x8, af[m][s]), acc[m][n], 0, 0, 0);
        __syncthreads();
        float* part_l = (float*)lds + w * 4096;
#pragma unroll
        for (int m = 0; m < 4; ++m)
#pragma unroll
            for (int n = 0; n < 4; ++n) { const int r = 16 * m + (lane & 15), ch = 4 * n + (lane >> 4); *(f32x4*)(part_l + r * 64 + ((ch ^ (r & 15)) << 2)) = acc[m][n]; }
        __syncthreads();
        const int r = tid >> 3, j = tid & 7, row = row0 + r, col = col0 + 8 * j;
        f32x4 s0 = (f32x4){0.f, 0.f, 0.f, 0.f}, s1 = s0;
#pragma unroll
        for (int ww = 0; ww < 8; ++ww) { const float* pl = (const float*)lds + ww * 4096 + r * 64; s0 += *(const f32x4*)(pl + (((2 * j) ^ (r & 15)) << 2)); s1 += *(const f32x4*)(pl + (((2 * j + 1) ^ (r & 15)) << 2)); }
        if (MODE == 0) {
            const float* xr = P.x_sample + (size_t)(row - MP) * DM + col;
            const f32x4 h0 = *(const f32x4*)xr + s0, h1 = *(const f32x4*)(xr + 4) + s1;
            u32x4 wv; wv.x = pack2(h0[0], h0[1]); wv.y = pack2(h0[2], h0[3]); wv.z = pack2(h1[0], h1[1]); wv.w = pack2(h1[2], h1[3]);
            *(u32x4*)(P.HB + (size_t)row * DM + col) = wv;
            float ss = (h0[0] * h0[0] + h0[1] * h0[1]) + (h0[2] * h0[2] + h0[3] * h0[3]) + (h1[0] * h1[0] + h1[1] * h1[1]) + (h1[2] * h1[2] + h1[3] * h1[3]);
            ss = oct_allsum(ss);
            if (j == 0) P.part[(size_t)row * 16 + (col0 >> 6)] = ss;
        } else {
            float ss = 0.f;
#pragma unroll
            for (int i = 0; i < 4; ++i) { const f32x4 p4 = *(const f32x4*)(P.part + (size_t)row * 16 + i * 4); ss += (p4[0] + p4[1]) + (p4[2] + p4[3]); }
            const float rs = rsqrtf(ss * (1.0f / DM) + 1e-6f);
            const u32x4 hh = *(const u32x4*)(P.HB + (size_t)row * DM + col), pl = *(const u32x4*)(P.PLS + (size_t)(row - MP) * DM + col);
            f32x4 o0, o1;
            o0[0] = bflo(hh.x) + sigmoidf_(s0[0] * rs) * bflo(pl.x); o0[1] = bfhi(hh.x) + sigmoidf_(s0[1] * rs) * bfhi(pl.x);
            o0[2] = bflo(hh.y) + sigmoidf_(s0[2] * rs) * bflo(pl.y); o0[3] = bfhi(hh.y) + sigmoidf_(s0[3] * rs) * bfhi(pl.y);
            o1[0] = bflo(hh.z) + sigmoidf_(s1[0] * rs) * bflo(pl.z); o1[1] = bfhi(hh.z) + sigmoidf_(s1[1] * rs) * bfhi(pl.z);
            o1[2] = bflo(hh.w) + sigmoidf_(s1[2] * rs) * bflo(pl.w); o1[3] = bfhi(hh.w) + sigmoidf_(s1[3] * rs) * bfhi(pl.w);
            float* yp = P.y_all + (size_t)row * DM + col; *(f32x4*)yp = o0; *(f32x4*)(yp + 4) = o1;
        }
    }
}

#ifndef REP_P0
#define REP_P0 1
#endif
#ifndef REP_P1
#define REP_P1 1
#endif
#ifndef REP_PREP
#define REP_PREP 1
#endif
#ifndef REP_ATTN
#define REP_ATTN 1
#endif
#ifndef REP_SCAN
#define REP_SCAN 1
#endif
#ifndef REP_CHA
#define REP_CHA 1
#endif
#ifndef REP_CHB
#define REP_CHB 1
#endif
#ifndef REP_P7
#define REP_P7 1
#endif
#ifndef REP_POST
#define REP_POST 1
#endif
#ifndef REP_ATTS
#define REP_ATTS 1
#endif
#ifndef REP_P5
#define REP_P5 1
#endif
__device__ __forceinline__ int opq(int x) { asm volatile("" : "+s"(x)); return x; }
typedef const __attribute__((address_space(4))) Params* KParams;
__device__ __forceinline__ KParams opq_kp(KParams p) { asm volatile("" : "+s"(p)); return p; }
#define LDS_RING 131072
#define LDS_TOTAL (LDS_RING + 1024 + 16384 + 512)
__global__ void __launch_bounds__(NTHR, 2) fwd_kernel(Params P0_) {
    extern __shared__ __attribute__((aligned(16))) unsigned char lds[];
#ifdef PADNOPS
    asm volatile(".rept " PADNOPS "\n\ts_nop 0\n\t.endr");
#endif
    const int tid = threadIdx.x;
    volatile LAS unsigned* bst = (volatile LAS unsigned*)((LAS unsigned char*)lds + LDS_RING);
    if (tid < 4) bst[tid] = 0u;
    __syncthreads();
    int wid_s = __builtin_amdgcn_readfirstlane(tid >> 6); asm volatile("" : "+s"(wid_s));
    XcdBarrier bar = xcd_barrier_post(P0_.bar, bst, wid_s);
    if (tid == 0) P0_.bar[XB_IDS + blockIdx.x] = bar.x + 1u;
    const int G = gridDim.x, cu = blockIdx.x;
    const KParams Pk = (KParams)__builtin_amdgcn_kernarg_segment_ptr();
#if defined(__HIP_DEVICE_COMPILE__)
#define PLOAD Params P = *opq_kp(Pk); P.wid = wid_s;
#else
#define PLOAD Params P = P0_; P.wid = wid_s;
#endif

    for (int rep = 0, nrep_ = opq(REP_P0); rep < nrep_; ++rep) { PLOAD p0_prologue(P, lds); }
    xcd_barrier(bar);
    xcd_check(bar);
    for (int rep = 0, nrep_ = opq(REP_P1); rep < nrep_; ++rep) { PLOAD Gemm g{P.XB, P.Wt_in, MT, DINP, DM, DM, P.wid}; StaticOrder S; S.init(MT, DINP, G, cu); EpiInProj E{P.H};
      gemm_phase<EpiInProj, StaticOrder, true, true>((LAS unsigned char*)lds, g, S, E); }
    { PLOAD Gemm g{P.PB, P.Wt_ple, MT, DM, 256, 256, P.wid}; TailOrder S{(MT / 256) * 4, G, (MT / 256) * (DINP / 256) - 7 * G, cu}; EpiPle E{P.y_all, P.PLS};
      gemm_phase<EpiPle, TailOrder, true, true>((LAS unsigned char*)lds, g, S, E); }
    xcd_barrier(bar);
#ifdef DESYNC_SLEEPS
    { const int xc_ = (int)blockIdx.x & 7; const int nsl_ = (DESYNC_SLEEPS); for (int i = 0; i < nsl_; ++i) __builtin_amdgcn_s_sleep(127); }
#endif
    { int flip = ((int)blockIdx.x >> 7) & 1; asm volatile("" : "+s"(flip));
      if (flip == 0) {
          for (int rep = 0, nrep_ = opq(REP_ATTN); rep < nrep_; ++rep) { PLOAD p3_attn_prompt(P, lds); }
          for (int rep = 0, nrep_ = opq(REP_ATTS); rep < nrep_; ++rep) { PLOAD p3_attn_sample(P, lds); }
          for (int rep = 0, nrep_ = opq(REP_PREP); rep < nrep_; ++rep) { PLOAD p2_rwkv_prep(P, lds); }
      }
      for (int rep = 0, nrep_ = opq(REP_CHA); rep < nrep_; ++rep) { PLOAD p3_chunk_a(P, lds); }
      if (flip != 0) {
          for (int rep = 0, nrep_ = opq(REP_ATTN); rep < nrep_; ++rep) { PLOAD p3_attn_prompt(P, lds); }
          for (int rep = 0, nrep_ = opq(REP_ATTS); rep < nrep_; ++rep) { PLOAD p3_attn_sample(P, lds); }
          for (int rep = 0, nrep_ = opq(REP_PREP); rep < nrep_; ++rep) { PLOAD p2_rwkv_prep(P, lds); }
      }
    }
    xcd_barrier_local(bar);
    for (int rep = 0, nrep_ = opq(REP_CHB); rep < nrep_; ++rep) { PLOAD p4_chunk_b(P, lds); }
    for (int rep = 0, nrep_ = opq(REP_SCAN); rep < nrep_; ++rep) { PLOAD p3_scan(P, lds); }
    xcd_barrier_local(bar);
    for (int rep = 0, nrep_ = opq(REP_POST); rep < nrep_; ++rep) { PLOAD p4_post(P); }
    xcd_barrier_local(bar);
    for (int rep = 0, nrep_ = opq(REP_P5); rep < nrep_; ++rep) {
    { PLOAD Gemm g{P.H + OFF_ZR, P.Wt_out, MP, DM, DM, DIN, P.wid}; StaticOrder S; S.init(MP, DM, G, cu); EpiOut E{P.HB, P.part, P.rstd_x};
      gemm_phase<EpiOut, StaticOrder, true, true>((LAS unsigned char*)lds, g, S, E);
      }
      { PLOAD g64_phase<0>(P, lds, P.H + OFF_ZR, DIN, P.Wt_out); }
    }
    xcd_barrier_local(bar);
    for (int rep = 0, nrep_ = opq(REP_P7); rep < nrep_; ++rep) { { PLOAD Gemm g{P.HB, P.Wt_gate, MP, DM, DM, DM, P.wid}; StaticOrder S; S.init(MP, DM, G, cu); EpiGate E{P.y_all, P.HB, P.part};
      gemm_phase<EpiGate, StaticOrder, true, true>((LAS unsigned char*)lds, g, S, E);
      }
      { PLOAD g64_phase<1>(P, lds, P.HB, DM, P.Wt_gate); } }
}

extern "C" void kernel_launch(void* const* d_in, const int* in_sizes, int n_in, void* d_out, int out_size, void* d_ws, size_t ws_size, hipStream_t stream) {
    static int grid = 0;
    if (grid == 0) {
        int dev = 0, cus = 0, per_cu = 0;
        hipGetDevice(&dev);
        hipDeviceGetAttribute(&cus, hipDeviceAttributeMultiprocessorCount, dev);
        if (hipFuncSetAttribute((const void*)fwd_kernel, hipFuncAttributeMaxDynamicSharedMemorySize, LDS_TOTAL) != hipSuccess) { fprintf(stderr, "hipFuncSetAttribute failed\n"); }
        hipOccupancyMaxActiveBlocksPerMultiprocessor(&per_cu, (const void*)fwd_kernel, NTHR, LDS_TOTAL);
        (void)hipGetLastError();
        grid = 256;
        if (cus != 256) fprintf(stderr, "warning: %d CUs reported; this kernel is written for 256\n", cus);
        if (per_cu < 1) fprintf(stderr, "occupancy query says %d blocks/CU\n", per_cu);
    }
    Params P{};
    const float** in = (const float**)&P.x_prompt;
    for (int i = 0; i < 27; ++i) in[i] = (const float*)d_in[i];
    float* out = (float*)d_out;
    P.y_all = out;
    P.o_state_p = out + (size_t)MT * DM;
    P.o_state_s = P.o_state_p + 262144;
    P.o_shift_p = P.o_state_s + 4194304;
    P.o_shift_s = P.o_shift_p + 13312;
    P.o_ck_p = P.o_shift_s + 212992;
    P.o_ck_s = P.o_ck_p + 131072;
    P.o_cv_p = P.o_ck_s + 2097152;
    P.o_cv_s = P.o_cv_p + 131072;
    unsigned char* ws = (unsigned char*)d_ws;
    size_t off = 0;
    auto take = [&](size_t bytes) { unsigned char* p = ws + off; off += (bytes + 255) & ~(size_t)255; return p; };
    P.bar = (unsigned*)take(16384);
    P.Wt_in = (bf16_t*)take((size_t)DINP * DM * 2);
    P.Wt_out = (bf16_t*)take((size_t)DM * DM * 2);
    P.Wt_gate = (bf16_t*)take((size_t)DM * DM * 2);
    P.Wt_ple = (bf16_t*)take((size_t)DM * 256 * 2);
    P.rstd_x = (float*)take((size_t)MT * 4);
    P.part = (float*)take((size_t)MT * 16 * 4);
    P.rk = (float*)take((size_t)MT * 8 * 4);
    P.WLd = (bf16_t*)take(8 * 64 * 64 * 2);
    P.WLa = (bf16_t*)take(8 * 64 * 64 * 2);
    P.PLS = (bf16_t*)take((size_t)MS * DM * 2);
    P.H = (bf16_t*)take((size_t)MT * DIN * 2);
    P.XB = (bf16_t*)take((size_t)MT * DM * 2);
    P.SA_G1 = (bf16_t*)take((size_t)4096 * 4096 * 2);
    P.SA_PC = (bf16_t*)take((size_t)4096 * 4096 * 2);
    P.SA_QT = (bf16_t*)take((size_t)4096 * 4096 * 2);
    P.SA_YL = (bf16_t*)take((size_t)4096 * 4096 * 2);
    P.SA_GC = (float*)take((size_t)4096 * 64 * 4);
    P.YR = (bf16_t*)take((size_t)MT * 512 * 2);
    P.Rv = (bf16_t*)take((size_t)MT * 512 * 2);
    P.Rr = (bf16_t*)take((size_t)MS * 512 * 2) - (size_t)MP * 512;
    P.Re = (bf16_t*)take((size_t)MS * 512 * 2) - (size_t)MP * 512;
    P.Rk = (bf16_t*)take((size_t)MS * 512 * 2) - (size_t)MP * 512;
    P.Rkk = (bf16_t*)take((size_t)MS * 512 * 2) - (size_t)MP * 512;
    P.Reta = (bf16_t*)take((size_t)MS * 512 * 2) - (size_t)MP * 512;
    P.PB = (bf16_t*)P.o_state_p;
    P.PLE = nullptr;
    P.HB = P.XB;
    if (off > ws_size) { fprintf(stderr, "workspace too small: need %zu have %zu\n", off, ws_size); return; }
    hipMemsetAsync(P.bar, 0, 16384, stream);
    hipLaunchKernelGGL(fwd_kernel, dim3(grid), dim3(NTHR), LDS_TOTAL, stream, P);
}
```

```cpp
#include <hip/hip_runtime.h>
#include <stdint.h>
#include <cstdio>

#define LAS __attribute__((address_space(3)))
typedef float f32x16 __attribute__((ext_vector_type(16)));

#define MP 32768
#define MS 1024
#define MT 33792
#define TP 4096
#define TS 8
#define DM 1024
#define DIN 3456
#define DINP 3584
#define DSH 1664
#define OFF_ZR 1664
#define OFF_Q 2176
#define OFF_K 2688
#define OFF_V 2816
#define OFF_ZA 2944
#define NTHR 512

__device__ __forceinline__ int lane_id_() { int l; asm volatile("v_mbcnt_lo_u32_b32 %0, -1, 0\n\tv_mbcnt_hi_u32_b32 %0, -1, %0" : "=v"(l)); return l; }
#define TIDX_(wid) ((wid) * 64 + lane_id_())
namespace pg8 {
#define PG8_LAS __attribute__((address_space(3)))
typedef unsigned short bf16_t;
typedef short bf16x8 __attribute__((ext_vector_type(8)));
typedef float f32x4 __attribute__((ext_vector_type(4)));
typedef unsigned u32x4 __attribute__((ext_vector_type(4)));
constexpr int BM = 256, BK = 64, HALF = 128, HTB = HALF * BK * 2  , STAGE_BYTES = 8 * HTB, NXCD = 8, WGM = 8;

__host__ __device__ __forceinline__ int lds_byte(int r, int c) { const int st = (r >> 4) * 2 + (c >> 5), rr = r & 15, cc = c & 31, ob = rr * 64 + cc * 2; return st * 1024 + (ob ^ (((ob >> 9) & 1) << 5)); }
__host__ __device__ __forceinline__ void stage_rc(int b, int& R, int& C) { const int st = b / 1024, sb = b % 1024, swz = sb ^ (((sb >> 9) & 1) << 5); R = (st >> 1) * 16 + swz / 64; C = (st & 1) * 32 + (swz % 64) / 2; }
__host__ __device__ __forceinline__ int perm32(int rho) { const int n = rho >> 4, i = rho & 15; return 8 * (i >> 2) + 4 * n + (i & 3); }

struct Unit { int pm, pn; };
struct Gemm { const bf16_t* A; const bf16_t* Bt; int M, N, K, lda, wid; };

struct StaticOrder {
    int nM, nN, nwg, G, c;
    __host__ __device__ void init(int M, int N, int G_, int c_) { nM = M / BM; nN = N / BM; nwg = nM * nN; G = G_; c = c_; }
    __host__ __device__ bool next(int i, Unit& u) const {
        const long L = (long)i * G + c; if (L >= nwg) return false;
        int wgid = (int)L; { const int q = nwg / NXCD, r = nwg % NXCD, xcd = wgid % NXCD, off = wgid / NXCD; wgid = (xcd < r ? xcd * (q + 1) : r * (q + 1) + (xcd - r) * q) + off; }
        const int nig = WGM * nN, gid = wgid / nig, fm = gid * WGM, gsz = (nM - fm) < WGM ? (nM - fm) : WGM;
        u.pm = fm + ((wgid % nig) % gsz); u.pn = (wgid % nig) / gsz; return true;
    }
    __device__ __forceinline__ void a_ready(const Unit&) const {}
    __device__ __forceinline__ void done(const Unit&) const {}
};

typedef float f32x2_t __attribute__((ext_vector_type(2)));
typedef __bf16 bf16x2_t __attribute__((ext_vector_type(2)));
__device__ __forceinline__ unsigned pack2(float lo, float hi) { f32x2_t v = {lo, hi}; bf16x2_t b = __builtin_convertvector(v, bf16x2_t); return __builtin_bit_cast(unsigned, b); }
__device__ __forceinline__ bf16_t f2bf(float f) { return (bf16_t)(pack2(f, 0.f) & 0xffffu); }
__device__ __forceinline__ float bf2f(bf16_t h) { return __uint_as_float(((unsigned)h) << 16); }
__device__ __forceinline__ float bflo(unsigned u) { return __uint_as_float(u << 16); }
__device__ __forceinline__ float bfhi(unsigned u) { return __uint_as_float(u & 0xffff0000u); }
__device__ __forceinline__ float fexp2_(float x) { return __builtin_amdgcn_exp2f(x); }
__device__ __forceinline__ float frcp_(float x) { return __builtin_amdgcn_rcpf(x); }
__device__ __forceinline__ float sigmoidf_(float x) { return frcp_(1.0f + fexp2_(-1.44269504f * x)); }
__device__ __forceinline__ float wave_sum(float x) {
#pragma unroll
    for (int o = 32; o >= 1; o >>= 1) x += __shfl_xor(x, o);
    return x;
}
template <int CTRL> __device__ __forceinline__ float dpp_f(float x) {
    return __builtin_bit_cast(float, __builtin_amdgcn_update_dpp(0, __builtin_bit_cast(int, x), CTRL, 0xF, 0xF, false));
}
__device__ __forceinline__ float row16_allsum(float x) {
    x += dpp_f<0x128>(x); x += dpp_f<0x124>(x); x += dpp_f<0x122>(x); x += dpp_f<0x121>(x);
    return x;
}

struct EpiInProj {
    static constexpr bool PERM = true, AFTER_DRAIN = false;
    bf16_t* H;
    __device__ __forceinline__ void operator()(const f32x4 (&acc)[2][2][4][2], const Unit& u, int wr, int wc, int fr, int fq) const {
        const int row0 = u.pm * 256 + wr * 64 + fr, col0 = u.pn * 256 + wc * 32 + 8 * fq;
#pragma unroll
        for (int ai = 0; ai < 2; ++ai)
#pragma unroll
            for (int m = 0; m < 4; ++m) {
                const int row = row0 + ai * 128 + m * 16;
#pragma unroll
                for (int bj = 0; bj < 2; ++bj) {
                    const int col = col0 + bj * 128;
                    if (col < DIN) {
                        const f32x4 v0 = acc[ai][bj][m][0], v1 = acc[ai][bj][m][1];
                        u32x4 w; w.x = pack2(v0[0], v0[1]); w.y = pack2(v0[2], v0[3]); w.z = pack2(v1[0], v1[1]); w.w = pack2(v1[2], v1[3]);
                        *(u32x4*)(H + (size_t)row * DIN + col) = w;
                    }
                }
            }
    }
};
__device__ __forceinline__ unsigned char* ple_slot(float* y, int row, int pn, int wc, int fq) { return (unsigned char*)(y + (size_t)row * DM) + pn * 1024 + 512 + wc * 128 + fq * 32; }
struct EpiPle {
    static constexpr bool PERM = true, AFTER_DRAIN = false;
    float* y; bf16_t* pls;
    __device__ __forceinline__ void operator()(const f32x4 (&acc)[2][2][4][2], const Unit& u, int wr, int wc, int fr, int fq) const {
        const int row0 = u.pm * 256 + wr * 64 + fr;
#pragma unroll
        for (int ai = 0; ai < 2; ++ai)
#pragma unroll
            for (int m = 0; m < 4; ++m) {
                unsigned char* sl = ple_slot(y, row0 + ai * 128 + m * 16, u.pn, wc, fq);
#pragma unroll
                for (int bj = 0; bj < 2; ++bj) {
                    const f32x4 v0 = acc[ai][bj][m][0], v1 = acc[ai][bj][m][1];
                    u32x4 w; w.x = pack2(v0[0], v0[1]); w.y = pack2(v0[2], v0[3]); w.z = pack2(v1[0], v1[1]); w.w = pack2(v1[2], v1[3]);
                    *(u32x4*)(sl + bj * 16) = w;
                    if (u.pm >= MP / 256) *(u32x4*)(pls + (size_t)(row0 + ai * 128 + m * 16 - MP) * DM + u.pn * 256 + bj * 128 + wc * 32 + 8 * fq) = w;
                }
            }
    }
};
struct TailOrder {
    int n, G, c0, c;
    __device__ __forceinline__ bool next(int i, Unit& u) const { if (c < c0) return false; const int L = i * (G - c0) + (c - c0); if (L >= n) return false; u.pm = L >> 2; u.pn = L & 3; return true; }
    __device__ __forceinline__ void a_ready(const Unit&) const {}
    __device__ __forceinline__ void done(const Unit&) const {}
};
struct EpiOut {
    static constexpr bool PERM = true, AFTER_DRAIN = false;
    bf16_t* hb; float* part; const float* xs;
    __device__ __forceinline__ void operator()(const f32x4 (&acc)[2][2][4][2], const Unit& u, int wr, int wc, int fr, int fq) const {
        const int row0 = u.pm * 256 + wr * 64 + fr, col0 = u.pn * 256 + wc * 32 + 8 * fq;
        u32x4 xa[2], xb[2]; float sxa, sxb;
#define EO_LOAD(X, it) { const int row_ = row0 + ((it) >> 2) * 128 + ((it) & 3) * 16; const bf16_t* xr_ = hb + (size_t)row_ * DM + col0; X[0] = *(const u32x4*)xr_; X[1] = *(const u32x4*)(xr_ + 128); s##X = xs[row_]; }
#define EO_STEP(X, it) { const int ai_ = (it) >> 2, m_ = (it) & 3, row_ = row0 + ai_ * 128 + m_ * 16; float ss = 0.f; \
            _Pragma("unroll") for (int bj = 0; bj < 2; ++bj) { const u32x4 xv = X[bj]; \
                const f32x4 h0 = (f32x4){bflo(xv.x), bfhi(xv.x), bflo(xv.y), bfhi(xv.y)} * s##X + acc[ai_][bj][m_][0], h1 = (f32x4){bflo(xv.z), bfhi(xv.z), bflo(xv.w), bfhi(xv.w)} * s##X + acc[ai_][bj][m_][1]; \
                u32x4 w; w.x = pack2(h0[0], h0[1]); w.y = pack2(h0[2], h0[3]); w.z = pack2(h1[0], h1[1]); w.w = pack2(h1[2], h1[3]); \
                *(u32x4*)(hb + (size_t)row_ * DM + col0 + bj * 128) = w; \
                ss += (h0[0] * h0[0] + h0[1] * h0[1]) + (h0[2] * h0[2] + h0[3] * h0[3]) + (h1[0] * h1[0] + h1[1] * h1[1]) + (h1[2] * h1[2] + h1[3] * h1[3]); } \
            ss += __shfl_xor(ss, 16); ss += __shfl_xor(ss, 32); if (fq == 0) part[(size_t)row_ * 16 + u.pn * 4 + wc] = ss; }
        EO_LOAD(xa, 0)
        EO_LOAD(xb, 1) EO_STEP(xa, 0) EO_LOAD(xa, 2) EO_STEP(xb, 1) EO_LOAD(xb, 3) EO_STEP(xa, 2) EO_LOAD(xa, 4) EO_STEP(xb, 3)
        EO_LOAD(xb, 5) EO_STEP(xa, 4) EO_LOAD(xa, 6) EO_STEP(xb, 5) EO_LOAD(xb, 7) EO_STEP(xa, 6) EO_STEP(xb, 7)
#undef EO_LOAD
#undef EO_STEP
    }
};
struct EpiGate {
    static constexpr bool PERM = true, AFTER_DRAIN = false;
    float* y; const bf16_t* hb; const float* part;
    __device__ __forceinline__ void operator()(const f32x4 (&acc)[2][2][4][2], const Unit& u, int wr, int wc, int fr, int fq) const {
        const int row0 = u.pm * 256 + wr * 64 + fr, col0 = u.pn * 256 + wc * 32 + 8 * fq;
        u32x4 ha[2], hb2[2], pa[2], pb[2]; f32x4 qa[4], qb[4];
#define EG_LOAD(Hh, Pp, Qq, it) { const int row_ = row0 + ((it) >> 2) * 128 + ((it) & 3) * 16; \
            Hh[0] = *(const u32x4*)(hb + (size_t)row_ * DM + col0); Hh[1] = *(const u32x4*)(hb + (size_t)row_ * DM + col0 + 128); \
            { const unsigned char* sl_ = ple_slot(y, row_, u.pn, wc, fq); Pp[0] = *(const u32x4*)sl_; Pp[1] = *(const u32x4*)(sl_ + 16); } \
            _Pragma("unroll") for (int i = 0; i < 4; ++i) Qq[i] = *(const f32x4*)(part + (size_t)row_ * 16 + i * 4); }
#define EG_STEP(Hh, Pp, Qq, it) { const int ai_ = (it) >> 2, m_ = (it) & 3, row_ = row0 + ai_ * 128 + m_ * 16; \
            float ss = 0.f; _Pragma("unroll") for (int i = 0; i < 4; ++i) ss += (Qq[i][0] + Qq[i][1]) + (Qq[i][2] + Qq[i][3]); \
            const float rs = rsqrtf(ss * (1.0f / DM) + 1e-6f); \
            _Pragma("unroll") for (int bj = 0; bj < 2; ++bj) { const f32x4 a0 = acc[ai_][bj][m_][0], a1 = acc[ai_][bj][m_][1]; const u32x4 hh = Hh[bj], pl = Pp[bj]; f32x4 o0, o1; \
                o0[0] = bflo(hh.x) + sigmoidf_(a0[0] * rs) * bflo(pl.x); o0[1] = bfhi(hh.x) + sigmoidf_(a0[1] * rs) * bfhi(pl.x); \
                o0[2] = bflo(hh.y) + sigmoidf_(a0[2] * rs) * bflo(pl.y); o0[3] = bfhi(hh.y) + sigmoidf_(a0[3] * rs) * bfhi(pl.y); \
                o1[0] = bflo(hh.z) + sigmoidf_(a1[0] * rs) * bflo(pl.z); o1[1] = bfhi(hh.z) + sigmoidf_(a1[1] * rs) * bfhi(pl.z); \
                o1[2] = bflo(hh.w) + sigmoidf_(a1[2] * rs) * bflo(pl.w); o1[3] = bfhi(hh.w) + sigmoidf_(a1[3] * rs) * bfhi(pl.w); \
                float* yp = y + (size_t)row_ * DM + col0 + bj * 128; *(f32x4*)yp = o0; *(f32x4*)(yp + 4) = o1; } }
        EG_LOAD(ha, pa, qa, 0)
        EG_LOAD(hb2, pb, qb, 1) EG_STEP(ha, pa, qa, 0) EG_LOAD(ha, pa, qa, 2) EG_STEP(hb2, pb, qb, 1) EG_LOAD(hb2, pb, qb, 3) EG_STEP(ha, pa, qa, 2) EG_LOAD(ha, pa, qa, 4) EG_STEP(hb2, pb, qb, 3)
        EG_LOAD(hb2, pb, qb, 5) EG_STEP(ha, pa, qa, 4) EG_LOAD(ha, pa, qa, 6) EG_STEP(hb2, pb, qb, 5) EG_LOAD(hb2, pb, qb, 7) EG_STEP(ha, pa, qa, 6) EG_STEP(hb2, pb, qb, 7)
#undef EG_LOAD
#undef EG_STEP
    }
};

template <class Epi, class Sched, bool ALIGN_EPI = false, bool SP2 = false>
__device__ __forceinline__ void gemm_phase(PG8_LAS unsigned char* lds, const Gemm g, const Sched& S, const Epi& E) {
    int tid_o = TIDX_(g.wid); asm volatile("" : "+v"(tid_o));
    const int tid = tid_o, wid = __builtin_amdgcn_readfirstlane(tid >> 6), lane = tid & 63, wr = wid >> 2, wc = wid & 3, fr = lane & 15, fq = lane >> 4;
    const int K = g.K, nt = K / BK;
    unsigned voffA[2], voffB[2];
#pragma unroll
    for (int i = 0; i < 2; ++i) { int R, C; stage_rc(tid * 16 + i * 8192, R, C); const int Rb = Epi::PERM ? ((R & ~31) + perm32(R & 31)) : R;
        voffA[i] = (unsigned)(R * g.lda + C) * 2u; voffB[i] = (unsigned)(Rb * K + C) * 2u; }
    const size_t kstep = (size_t)(BK * 2);
    const size_t hstep = (size_t)HALF * K * 2;
    const size_t tstep = 2 * hstep;
    const size_t hstepA = (size_t)HALF * g.lda * 2, tstepA = 2 * hstepA;
    const unsigned ldsw = (unsigned)wid * 1024u;
    const int aoff = lds_byte(wr * 64 + fr, fq * 8), boff = lds_byte(wc * 32 + fr, fq * 8);
#define PG8_SA(b, h) (((b) * 2 + (h)) * HTB)
#define PG8_SB(b, h) ((4 + (b) * 2 + (h)) * HTB)
#define PG8_STAGE(bufoff, gbase, voff) do { _Pragma("unroll") for (int _i = 0; _i < 2; ++_i) \
        __builtin_amdgcn_global_load_lds((const unsigned*)((const char*)(gbase) + (voff)[_i]), (PG8_LAS unsigned*)(lds + (bufoff) + ldsw + _i * 8192), 16, 0, 0); } while (0)
#define PG8_LDA(dst, b, h) do { _Pragma("unroll") for (int m = 0; m < 4; ++m) _Pragma("unroll") for (int k = 0; k < 2; ++k) dst[m][k] = *(const PG8_LAS bf16x8*)(lds + PG8_SA(b, h) + aoff + m * 2048 + k * 1024); } while (0)
#define PG8_LDB(dst, b, h) do { _Pragma("unroll") for (int n = 0; n < 2; ++n) _Pragma("unroll") for (int k = 0; k < 2; ++k) dst[n][k] = *(const PG8_LAS bf16x8*)(lds + PG8_SB(b, h) + boff + n * 2048 + k * 1024); } while (0)
#define PG8_MMA(ai, bj, At, Bt) do { __builtin_amdgcn_s_setprio(1); _Pragma("unroll") for (int m = 0; m < 4; ++m) _Pragma("unroll") for (int n = 0; n < 2; ++n) _Pragma("unroll") for (int k = 0; k < 2; ++k) \
        acc[ai][bj][m][n] = __builtin_amdgcn_mfma_f32_16x16x32_bf16(Bt[n][k], At[m][k], acc[ai][bj][m][n], 0, 0, 0); __builtin_amdgcn_s_setprio(0); } while (0)
#define PG8_WAIT_V(n) asm volatile("s_waitcnt vmcnt(" #n ")" ::: "memory")
#define PG8_WAIT_L(n) asm volatile("s_waitcnt lgkmcnt(" #n ")" ::: "memory")
#define PG8_BAR __builtin_amdgcn_s_barrier()
#define PG8_SCHED __builtin_amdgcn_sched_barrier(0)
    Unit cur, nxt; int ui = 0;
    if (!S.next(0, cur)) return;
    f32x4 acc[2][2][4][2];
#pragma unroll
    for (int a = 0; a < 2; ++a)
#pragma unroll
        for (int b = 0; b < 2; ++b)
#pragma unroll
            for (int m = 0; m < 4; ++m)
#pragma unroll
                for (int n = 0; n < 2; ++n) acc[a][b][m][n] = (f32x4){0.f, 0.f, 0.f, 0.f};
    bf16x8 At[4][2], B0[2][2], B1[2][2];
    const char* cA = (const char*)g.A + (size_t)cur.pm * tstepA; const char* cB = (const char*)g.Bt + (size_t)cur.pn * tstep;
    S.a_ready(cur);
    if constexpr (SP2) {
        PG8_STAGE(PG8_SB(0, 0), cB, voffB); PG8_STAGE(PG8_SB(0, 1), cB + hstep, voffB); PG8_STAGE(PG8_SA(0, 0), cA, voffA); PG8_STAGE(PG8_SA(0, 1), cA + hstepA, voffA);
        if (wr == 1) PG8_BAR;
        PG8_WAIT_V(2); PG8_BAR;
        PG8_STAGE(PG8_SB(1, 0), cB + kstep, voffB); PG8_STAGE(PG8_SA(1, 0), cA + kstep, voffA); PG8_STAGE(PG8_SB(1, 1), cB + hstep + kstep, voffB);
        PG8_WAIT_V(6); PG8_BAR;
    } else {
        PG8_STAGE(PG8_SB(0, 0), cB, voffB); PG8_STAGE(PG8_SA(0, 0), cA, voffA); PG8_STAGE(PG8_SB(0, 1), cB + hstep, voffB); PG8_STAGE(PG8_SA(0, 1), cA + hstepA, voffA);
        if (wr == 1) PG8_BAR;
        PG8_WAIT_V(4); PG8_BAR;
        PG8_STAGE(PG8_SB(1, 0), cB + kstep, voffB); PG8_STAGE(PG8_SA(1, 0), cA + kstep, voffA); PG8_STAGE(PG8_SB(1, 1), cB + hstep + kstep, voffB);
        PG8_WAIT_V(6); PG8_BAR;
    }
    for (;;) {
        const bool has_next = S.next(ui + 1, nxt);
        const char* nA = has_next ? (const char*)g.A + (size_t)nxt.pm * tstepA : cA; const char* nB = has_next ? (const char*)g.Bt + (size_t)nxt.pn * tstep : cB;
#pragma unroll 1
        for (int t = 0; t < nt; t += 2) {
            const bool last = (t == nt - 2);
            const char* a1 = cA + (size_t)(t + 1) * kstep;
            const char* a2 = last ? nA : cA + (size_t)(t + 2) * kstep; const char* b2 = last ? nB : cB + (size_t)(t + 2) * kstep;
            const char* a3 = a2 + kstep; const char* b3 = b2 + kstep;
            if (last && has_next) S.a_ready(nxt);
            if constexpr (SP2) {
            PG8_LDB(B0, 0, 0); PG8_LDB(B1, 0, 1); PG8_SCHED; PG8_LDA(At, 0, 0); PG8_STAGE(PG8_SA(1, 1), a1 + hstepA, voffA);
            PG8_WAIT_V(8); PG8_WAIT_L(0); PG8_BAR; PG8_MMA(0, 0, At, B0); PG8_MMA(0, 1, At, B1); PG8_BAR; PG8_SCHED;
            PG8_LDA(At, 0, 1); PG8_STAGE(PG8_SB(0, 0), b2, voffB); PG8_STAGE(PG8_SB(0, 1), b2 + hstep, voffB); PG8_STAGE(PG8_SA(0, 0), a2, voffA);
            PG8_WAIT_V(8); PG8_WAIT_L(0); PG8_BAR; PG8_MMA(1, 0, At, B0); PG8_MMA(1, 1, At, B1); PG8_BAR; PG8_SCHED;
            PG8_LDB(B0, 1, 0); PG8_LDB(B1, 1, 1); PG8_SCHED; PG8_LDA(At, 1, 0); PG8_STAGE(PG8_SA(0, 1), a2 + hstepA, voffA);
            PG8_WAIT_V(8); PG8_WAIT_L(0); PG8_BAR; PG8_MMA(0, 0, At, B0); PG8_MMA(0, 1, At, B1); PG8_BAR; PG8_SCHED;
            PG8_LDA(At, 1, 1); PG8_STAGE(PG8_SB(1, 0), b3, voffB); PG8_STAGE(PG8_SB(1, 1), b3 + hstep, voffB); PG8_STAGE(PG8_SA(1, 0), a3, voffA);
            PG8_WAIT_V(8); PG8_WAIT_L(0); PG8_BAR; PG8_MMA(1, 0, At, B0); PG8_MMA(1, 1, At, B1); PG8_BAR; PG8_SCHED;
            } else {
            PG8_LDB(B0, 0, 0); PG8_SCHED; PG8_LDA(At, 0, 0); PG8_STAGE(PG8_SA(1, 1), a1 + hstepA, voffA);
            PG8_WAIT_L(8); PG8_BAR; PG8_WAIT_L(0); PG8_MMA(0, 0, At, B0); PG8_BAR; PG8_SCHED;
            PG8_LDB(B1, 0, 1); PG8_STAGE(PG8_SB(0, 0), b2, voffB);
            PG8_BAR; PG8_WAIT_L(0); PG8_MMA(0, 1, At, B1); PG8_BAR;
            PG8_LDA(At, 0, 1); PG8_STAGE(PG8_SA(0, 0), a2, voffA);
            PG8_BAR; PG8_WAIT_L(0); PG8_MMA(1, 0, At, B0); PG8_BAR; PG8_SCHED;
            PG8_STAGE(PG8_SB(0, 1), b2 + hstep, voffB);
            PG8_WAIT_V(6); PG8_BAR; PG8_MMA(1, 1, At, B1); PG8_BAR;
            PG8_LDB(B0, 1, 0); PG8_SCHED; PG8_LDA(At, 1, 0); PG8_STAGE(PG8_SA(0, 1), a2 + hstepA, voffA);
            PG8_WAIT_L(8); PG8_BAR; PG8_WAIT_L(0); PG8_MMA(0, 0, At, B0); PG8_BAR; PG8_SCHED;
            PG8_LDB(B1, 1, 1); PG8_STAGE(PG8_SB(1, 0), b3, voffB);
            PG8_BAR; PG8_WAIT_L(0); PG8_MMA(0, 1, At, B1); PG8_BAR;
            PG8_LDA(At, 1, 1); PG8_STAGE(PG8_SA(1, 0), a3, voffA);
            PG8_BAR; PG8_WAIT_L(0); PG8_MMA(1, 0, At, B0); PG8_BAR; PG8_SCHED;
            PG8_STAGE(PG8_SB(1, 1), b3 + hstep, voffB);
            PG8_WAIT_V(6); PG8_BAR; PG8_MMA(1, 1, At, B1); PG8_BAR;
            }
        }
        if constexpr (ALIGN_EPI) { if (wr == 0) PG8_BAR; }
        if constexpr (!Epi::AFTER_DRAIN) { E(acc, cur, wr, wc, fr, fq); S.done(cur); }
        if (!has_next) break;
#pragma unroll
        for (int a = 0; a < 2; ++a)
#pragma unroll
            for (int b = 0; b < 2; ++b)
#pragma unroll
                for (int m = 0; m < 4; ++m)
#pragma unroll
                    for (int n = 0; n < 2; ++n) acc[a][b][m][n] = (f32x4){0.f, 0.f, 0.f, 0.f};
        cur = nxt; cA = nA; cB = nB; ++ui;
        if constexpr (ALIGN_EPI) { if (wr == 1) PG8_BAR; }
    }
    PG8_WAIT_V(0);
    if constexpr (!ALIGN_EPI) { if (wr == 0) PG8_BAR; }
    PG8_BAR;
    if constexpr (Epi::AFTER_DRAIN) { E.fused(acc, cur, wr, wc, fr, fq, lds, wid, lane); S.done(cur); }
#undef PG8_SA
#undef PG8_SB
#undef PG8_STAGE
#undef PG8_LDA
#undef PG8_LDB
#undef PG8_MMA
#undef PG8_WAIT_V
#undef PG8_WAIT_L
#undef PG8_BAR
#undef PG8_SCHED
}
}
#define XB_TMO      128
#define XB_XCNT(j)  (256  + 64 * (j))
#define XB_XSUB(j)  (1280 + 64 * (j))
#define XB_XGEN(j)  (2304 + 64 * (j))
#define XB_TOP      3328
#define XB_TOPGEN   3392
#define XCD_BAR_WORDS 3456
#define XB_IDS      3520
#define XB_SPIN_CAP (1u << 18)
#define LAS __attribute__((address_space(3)))

__device__ __forceinline__ unsigned xb_ld(unsigned* p)              { return __hip_atomic_load(p, __ATOMIC_RELAXED, __HIP_MEMORY_SCOPE_AGENT); }
__device__ __forceinline__ unsigned xb_add(unsigned* p, unsigned v) { return __hip_atomic_fetch_add(p, v, __ATOMIC_RELAXED, __HIP_MEMORY_SCOPE_AGENT); }
__device__ __forceinline__ unsigned xb_xcc_id() { return (unsigned)__builtin_amdgcn_s_getreg((3 << 11) | 20) & 0xFu; }
#define XB_SPIN(cond, bar) do { unsigned _sp = 0; while (cond) { __builtin_amdgcn_s_sleep(1); \
    if ((++_sp & 255u) == 0u) { if (xb_ld(&(bar)[XB_TMO])) break; if (_sp > XB_SPIN_CAP) { atomicAdd(&(bar)[XB_TMO], 1u); break; } } } } while (0)

struct XcdBarrier {
    int wid; unsigned* bar; unsigned x;
    volatile LAS unsigned* st;
};

__device__ __forceinline__ XcdBarrier xcd_barrier_post(unsigned* bar, volatile LAS unsigned* st, int wid) {
    XcdBarrier b; b.wid = wid; b.bar = bar; b.x = xb_xcc_id(); b.st = st;
    if (TIDX_(wid) == 0) { (void)xb_add(&bar[XB_XCNT(b.x)], 1u); }
    return b;
}
__device__ __forceinline__ void xcd_barrier_complete(unsigned* bar, unsigned x, unsigned& nloc, unsigned& nx) {
    const unsigned G = gridDim.x * gridDim.y * gridDim.z;
    unsigned sum, cnt, mine, sp = 0u;
    for (;;) {
        sum = 0u; cnt = 0u; mine = 0u;
#pragma unroll
        for (unsigned j = 0; j < 16; ++j) { const unsigned c = xb_ld(&bar[XB_XCNT(j)]); sum += c; cnt += (c > 0u) ? 1u : 0u; mine = (j == x) ? c : mine; }
        if (sum == G) break;
        __builtin_amdgcn_s_sleep(1);
        if ((++sp & 255u) == 0u) { if (xb_ld(&bar[XB_TMO])) break; if (sp > XB_SPIN_CAP) { atomicAdd(&bar[XB_TMO], 1u); break; } }
    }
    nloc = mine > 0u ? mine : 1u; nx = cnt > 0u ? cnt : 1u;
}

__device__ __forceinline__ void xcd_barrier(const XcdBarrier& b) {
    asm volatile("s_waitcnt vmcnt(0)" ::: "memory");
    __syncthreads();
    if (TIDX_(b.wid) == 0) {
        unsigned* bar = b.bar;
        __builtin_amdgcn_s_waitcnt(0);
        unsigned nloc = b.st[0], nx = b.st[1];
        if (nloc == 0u) { xcd_barrier_complete(bar, b.x, nloc, nx); b.st[0] = nloc; b.st[1] = nx; }
        const unsigned old = xb_add(&bar[XB_XSUB(b.x)], 1u);
        const unsigned gen = old / nloc;
        if (old + 1u == (gen + 1u) * nloc) {
            __builtin_amdgcn_fence(__ATOMIC_RELEASE, "agent");
            asm volatile("s_waitcnt vmcnt(0)" ::: "memory");
            const unsigned og = xb_add(&bar[XB_TOP], 1u);
            const unsigned tg = og / nx;
            if (og + 1u == (tg + 1u) * nx) xb_add(&bar[XB_TOPGEN], 1u);
            else XB_SPIN(xb_ld(&bar[XB_TOPGEN]) == tg, bar);
            __builtin_amdgcn_fence(__ATOMIC_ACQUIRE, "agent");
            xb_add(&bar[XB_XGEN(b.x)], 1u);
            asm volatile("s_waitcnt vmcnt(0)" ::: "memory");
        } else {
            XB_SPIN(xb_ld(&bar[XB_XGEN(b.x)]) == gen, bar);
            __builtin_amdgcn_fence(__ATOMIC_ACQUIRE, "agent");
            asm volatile("s_waitcnt vmcnt(0)" ::: "memory");
        }
    }
    __syncthreads();
}

__device__ __forceinline__ void xcd_check(const XcdBarrier& b) {
    const int t = TIDX_(b.wid);
    bool ok = true;
    if (t < (int)gridDim.x && t < 512) { const unsigned v = xb_ld(&b.bar[XB_IDS + t]), r = xb_ld(&b.bar[XB_IDS + (t & 7)]); ok = (v != 0u) && (v == r); }
    if (!ok) b.st[3] = 1u;
    __syncthreads();
#ifdef FORCE_GLOBAL_BARRIERS
    if (t == 0) b.st[2] = 2u;
#else
    if (t == 0) b.st[2] = (b.st[3] == 0u && b.st[0] == 32u && b.st[1] == 8u && gridDim.x == 256u) ? 1u : 2u;
#endif
    __syncthreads();
}
__device__ __forceinline__ void xcd_barrier_local(const XcdBarrier& b) {
    if (b.st[2] != 1u) { xcd_barrier(b); return; }
    asm volatile("s_waitcnt vmcnt(0)" ::: "memory");
    __syncthreads();
    if (TIDX_(b.wid) == 0) {
        unsigned* bar = b.bar;
        __builtin_amdgcn_s_waitcnt(0);
        const unsigned nloc = b.st[0];
        const unsigned old = xb_add(&bar[XB_XSUB(b.x)], 1u);
        const unsigned gen = old / nloc;
        if (old + 1u == (gen + 1u) * nloc) xb_add(&bar[XB_XGEN(b.x)], 1u);
        else XB_SPIN(xb_ld(&bar[XB_XGEN(b.x)]) == gen, bar);
        __builtin_amdgcn_fence(__ATOMIC_ACQUIRE, "agent");
        asm volatile("s_waitcnt vmcnt(0)" ::: "memory");
    }
    __syncthreads();
}

using namespace pg8;

struct Params {
    const float *x_prompt, *x_sample, *state_rwkv, *state_shift, *cache_k, *cache_v, *p_prompt, *p_sample, *g_norm, *w_in, *mu, *w0, *w_dec2, *a0, *w_a2,
        *k_k, *k_a, *r_k, *lnx_w, *lnx_b, *q_norm_w, *k_norm_w, *sinks, *w_out, *g_ple, *w_ple_gate, *w_ple_proj;
    float *y_all, *o_state_p, *o_state_s, *o_shift_p, *o_shift_s, *o_ck_p, *o_ck_s, *o_cv_p, *o_cv_s;
    unsigned* bar;
    bf16_t *Wt_in, *Wt_out, *Wt_gate, *Wt_ple, *H, *XB, *Rr, *Re, *Rk, *Rv, *Rkk, *Reta, *PB, *PLE, *HB, *SA_G1, *SA_PC, *SA_QT, *SA_YL, *YR, *WLd, *WLa, *PLS;
    float *rstd_x, *part, *rk, *SA_GC;
    int wid;
};

__device__ __forceinline__ void p0_prologue(const Params& P, unsigned char* lds) {
    int tid_o = TIDX_(P.wid); asm volatile("" : "+v"(tid_o)); const int tid = tid_o, lane = tid & 63, wave = tid >> 6;
    float* tile = (float*)lds;
#define P0_DECODE(it_) const float* src; const float* scale; bf16_t* dst; int K, N, kt, nt; { int r = (it_); \
        if (r < 864) { src = P.w_in; scale = P.g_norm; dst = P.Wt_in; K = DM; N = DIN; kt = r / 54; nt = r % 54; } \
        else if ((r -= 864) < 256) { src = P.w_out; scale = nullptr; dst = P.Wt_out; K = DM; N = DM; kt = r >> 4; nt = r & 15; } \
        else if ((r -= 256) < 256) { src = P.w_ple_gate; scale = P.g_ple; dst = P.Wt_gate; K = DM; N = DM; kt = r >> 4; nt = r & 15; } \
        else { r -= 256; src = P.w_ple_proj; scale = nullptr; dst = P.Wt_ple; K = 256; N = DM; kt = r >> 4; nt = r & 15; } } \
        const int k0 = kt * 64, n0 = nt * 64, tx = tid & 63, ty = tid >> 6;
    { const int gw = (int)blockIdx.x * 8 + wave;
      if (gw < 1440) {
        P0_DECODE(gw)
        unsigned char* T = lds + wave * (64 * 144);
        const int kr = lane >> 4, nc = lane & 15;
        f32x4 v[16];
#pragma unroll
        for (int i = 0; i < 16; ++i) { const int k = kr + 4 * i; v[i] = *(const f32x4*)(src + (size_t)(k0 + k) * N + n0 + 4 * nc); if (scale) v[i] *= scale[k0 + k]; }
#pragma unroll
        for (int i = 0; i < 16; ++i) { const int k = kr + 4 * i;
#pragma unroll
            for (int j = 0; j < 4; ++j) *(bf16_t*)(T + (4 * nc + j) * 144 + 2 * k) = f2bf(v[i][j]); }
        asm volatile("s_waitcnt lgkmcnt(0)" ::: "memory");
#pragma unroll
        for (int c = 0; c < 8; ++c) { const u32x4 w = *(const u32x4*)(T + lane * 144 + 16 * c); *(u32x4*)(dst + (size_t)(n0 + lane) * K + k0 + 8 * c) = w; }
        (void)tx; (void)ty; (void)tile;
      } }
#undef P0_DECODE
    for (int i = blockIdx.x * NTHR + tid; i < 2 * 8 * 64 * 8; i += gridDim.x * NTHR) {
        const int which = i >> 12, r = i & 4095, hh = r >> 9, ch = (r >> 3) & 63, jc = r & 7;
        const float* src = (which ? P.w_a2 : P.w_dec2) + hh * 64 + ch;
        u32x4 wv; wv.x = pack2(src[(8 * jc + 0) * 512], src[(8 * jc + 1) * 512]); wv.y = pack2(src[(8 * jc + 2) * 512], src[(8 * jc + 3) * 512]);
        wv.z = pack2(src[(8 * jc + 4) * 512], src[(8 * jc + 5) * 512]); wv.w = pack2(src[(8 * jc + 6) * 512], src[(8 * jc + 7) * 512]);
        *(u32x4*)((which ? P.WLa : P.WLd) + (size_t)hh * 4096 + ch * 64 + jc * 8) = wv;
    }
    for (int i = blockIdx.x * NTHR + tid; i < (DINP - DIN) * DM / 8; i += gridDim.x * NTHR) *(u32x4*)(P.Wt_in + (size_t)DIN * DM + (size_t)i * 8) = (u32x4){0u, 0u, 0u, 0u};
    for (int row0 = blockIdx.x * 8 + wave; row0 < MT; row0 += gridDim.x * 8 * 4) {
        f32x4 v[4][4];
#pragma unroll
        for (int q = 0; q < 4; ++q) { const int row = row0 + q * gridDim.x * 8;
            if (row < MT) { const float* src = row < MP ? P.x_prompt + (size_t)row * DM : P.x_sample + (size_t)(row - MP) * DM;
#pragma unroll
                for (int i = 0; i < 4; ++i) v[q][i] = *(const f32x4*)(src + (lane + 64 * i) * 4); } }
#pragma unroll
        for (int q = 0; q < 4; ++q) { const int row = row0 + q * gridDim.x * 8;
            if (row < MT) { float ss = 0.f;
#pragma unroll
                for (int i = 0; i < 4; ++i) { const f32x4 x = v[q][i]; ss += (x[0] * x[0] + x[1] * x[1]) + (x[2] * x[2] + x[3] * x[3]); }
                ss = wave_sum(ss);
                const float ms = ss * (1.0f / DM) + 1e-6f, rs = rsqrtf(ms);
#pragma unroll
                for (int i = 0; i < 4; ++i) { const f32x4 x = v[q][i] * rs;
                    *(uint2*)(P.XB + (size_t)row * DM + (lane + 64 * i) * 4) = make_uint2(pack2(x[0], x[1]), pack2(x[2], x[3])); }
                if (lane == 0) P.rstd_x[row] = sqrtf(ms); } }
    }
    for (size_t i = (size_t)blockIdx.x * NTHR + tid; i < (size_t)MT * 64; i += (size_t)gridDim.x * NTHR * 4) {
        f32x4 v[4];
#pragma unroll
        for (int q = 0; q < 4; ++q) { const size_t e = (i + (size_t)q * gridDim.x * NTHR) * 4; if (e < (size_t)MT * 256) v[q] = *(const f32x4*)(e < (size_t)MP * 256 ? P.p_prompt + e : P.p_sample + (e - (size_t)MP * 256)); }
#pragma unroll
        for (int q = 0; q < 4; ++q) { const size_t e = (i + (size_t)q * gridDim.x * NTHR) * 4; if (e < (size_t)MT * 256) *(uint2*)(P.PB + e) = make_uint2(pack2(v[q][0], v[q][1]), pack2(v[q][2], v[q][3])); }
    }

}


#define PR_ROWB 3344
#define PR_FS 0
#define PR_AT (18 * PR_ROWB)
#define PR_CONST (PR_AT + 4096)
__device__ __forceinline__ void p2_rwkv_prep(const Params& P, unsigned char* lds) {
    int tid_o = TIDX_(P.wid); asm volatile("" : "+v"(tid_o)); const int tid = tid_o, lane = tid & 63, h = tid >> 6;
    const bf16_t* H = P.H;
    float* cst = (float*)(lds + PR_CONST);
    __syncthreads();
    { cst[tid] = P.w0[tid]; cst[512 + tid] = P.a0[tid]; cst[1024 + tid] = P.mu[tid]; cst[1536 + tid] = P.mu[512 + tid]; cst[2048 + tid] = P.mu[1024 + tid];
      cst[2560 + tid] = P.k_k[tid]; cst[3072 + tid] = P.k_a[tid]; cst[3584 + tid] = P.r_k[tid]; }
    bf16x8 wdf[4][2], waf[4][2];
#pragma unroll
    for (int n = 0; n < 4; ++n)
#pragma unroll
        for (int s = 0; s < 2; ++s) {
            const int ch = h * 64 + 16 * n + (lane & 15), j0 = 32 * s + 8 * (lane >> 4);
            u32x4 a, b;
#pragma unroll
            for (int q = 0; q < 4; ++q) {
                a[q] = pack2(P.w_dec2[(j0 + 2 * q) * 512 + ch], P.w_dec2[(j0 + 2 * q + 1) * 512 + ch]);
                b[q] = pack2(P.w_a2[(j0 + 2 * q) * 512 + ch], P.w_a2[(j0 + 2 * q + 1) * 512 + ch]);
            }
            wdf[n][s] = __builtin_bit_cast(bf16x8, a); waf[n][s] = __builtin_bit_cast(bf16x8, b);
        }
    const int atok = tid >> 5, aj = (tid & 31) * 4;
    float amu[4];
#pragma unroll
    for (int q = 0; q < 4; ++q) amu[q] = P.mu[1536 + aj + q];
#define PR_FILL(unit) { const int r0_ = (unit) * 16; const bool smp_ = r0_ >= MP; int tid_ = tid; asm volatile("" : "+v"(tid_)); \
        _Pragma("unroll") for (int hb = 0; hb < 2; ++hb) { u32x4 pre[4]; \
        _Pragma("unroll") for (int i = 0; i < 4; ++i) { const int id = tid_ + NTHR * (hb * 4 + i); const int row = id / 208, cc = id - row * 208; u32x4 v = (u32x4){0u, 0u, 0u, 0u}; \
            if (row >= 1 && row <= 16) v = *(const u32x4*)(H + (size_t)(r0_ + row - 1) * DIN + cc * 8); \
            else if (row == 0 && !smp_) { if ((r0_ & (TP - 1)) != 0) v = *(const u32x4*)(H + (size_t)(r0_ - 1) * DIN + cc * 8); } \
            else if (row < 18 && smp_) { const float* sp = P.state_shift + (size_t)(((r0_ - MP) >> 3) + (row == 17 ? 1 : 0)) * DSH + cc * 8; \
                const f32x4 s0 = *(const f32x4*)sp, s1 = *(const f32x4*)(sp + 4); v.x = pack2(s0[0], s0[1]); v.y = pack2(s0[2], s0[3]); v.z = pack2(s1[0], s1[1]); v.w = pack2(s1[2], s1[3]); } \
            pre[i] = v; } \
        _Pragma("unroll") for (int i = 0; i < 4; ++i) { const int id = tid_ + NTHR * (hb * 4 + i); const int row = id / 208, cc = id - row * 208; if (id < 18 * 208) *(u32x4*)(lds + PR_FS + row * PR_ROWB + cc * 16) = pre[i]; } \
        asm volatile("" ::: "memory"); } }
    int unit = ((int)blockIdx.x >> 3) < 8 ? MP / 16 + ((int)blockIdx.x & 7) * 8 + ((int)blockIdx.x >> 3) : MT / 16;
    if (unit < MT / 16) { PR_FILL(unit); }
    __syncthreads();
    for (; unit < MT / 16; unit += gridDim.x) {
        const int r0 = unit * 16; const bool smp = r0 >= MP;
        const int nxt = unit + gridDim.x;
        {
            const int prow = (smp && atok == 8) ? 17 : atok;
            const uint2 fc = *(const uint2*)(lds + PR_FS + (atok + 1) * PR_ROWB + (1536 + aj) * 2), fp = *(const uint2*)(lds + PR_FS + prow * PR_ROWB + (1536 + aj) * 2);
            float x[4];
            x[0] = bflo(fc.x) + (bflo(fp.x) - bflo(fc.x)) * amu[0]; x[1] = bfhi(fc.x) + (bfhi(fp.x) - bfhi(fc.x)) * amu[1];
            x[2] = bflo(fc.y) + (bflo(fp.y) - bflo(fc.y)) * amu[2]; x[3] = bfhi(fc.y) + (bfhi(fp.y) - bfhi(fc.y)) * amu[3];
            if (aj < 64) {
#pragma unroll
                for (int q = 0; q < 4; ++q) x[q] = 1.0f - 2.0f * frcp_(1.0f + fexp2_(2.88539008f * x[q]));
            }
            *(uint2*)(lds + PR_AT + (aj < 64 ? 0 : 2048) + atok * 128 + (aj & 63) * 2) = make_uint2(pack2(x[0], x[1]), pack2(x[2], x[3]));
        }
        __syncthreads();
        f32x4 accw[4], acca[4];
        {
            bf16x8 tf[2], af[2];
#pragma unroll
            for (int s = 0; s < 2; ++s) {
                tf[s] = *(const bf16x8*)(lds + PR_AT + (lane & 15) * 128 + (32 * s + 8 * (lane >> 4)) * 2);
                af[s] = *(const bf16x8*)(lds + PR_AT + 2048 + (lane & 15) * 128 + (32 * s + 8 * (lane >> 4)) * 2);
            }
#pragma unroll
            for (int n = 0; n < 4; ++n) {
                f32x4 cw = (f32x4){0.f, 0.f, 0.f, 0.f}, ca = (f32x4){0.f, 0.f, 0.f, 0.f};
#pragma unroll
                for (int s = 0; s < 2; ++s) {
                    cw = __builtin_amdgcn_mfma_f32_16x16x32_bf16(wdf[n][s], tf[s], cw, 0, 0, 0);
                    ca = __builtin_amdgcn_mfma_f32_16x16x32_bf16(waf[n][s], af[s], ca, 0, 0, 0);
                }
                accw[n] = cw; acca[n] = ca;
            }
        }
        const int tok = lane & 15, row = r0 + tok;
        const int prow = (smp && tok == 8) ? 17 : tok;
        const unsigned char* fcur = lds + PR_FS + (tok + 1) * PR_ROWB;
        const unsigned char* fprv = lds + PR_FS + prow * PR_ROWB;
        float ss = 0.f, rks = 0.f;
#pragma unroll
        for (int n = 0; n < 4; ++n) {
            const int c0 = h * 64 + 16 * n + 4 * (lane >> 4);
            const f32x4 cmk = *(const f32x4*)(cst + 1536 + c0), ckk = *(const f32x4*)(cst + 2560 + c0);
            const uint2 kc = *(const uint2*)(fcur + (512 + c0) * 2), kp = *(const uint2*)(fprv + (512 + c0) * 2);
            const float fk[4] = {bflo(kc.x), bfhi(kc.x), bflo(kc.y), bfhi(kc.y)}, pk[4] = {bflo(kp.x), bfhi(kp.x), bflo(kp.y), bfhi(kp.y)};
#pragma unroll
            for (int q = 0; q < 4; ++q) { const float kk = (fk[q] + (pk[q] - fk[q]) * cmk[q]) * ckk[q]; ss += kk * kk; }
        }
        asm volatile("" ::: "memory"); __builtin_amdgcn_sched_barrier(0);
        ss += __shfl_xor(ss, 16); ss += __shfl_xor(ss, 32);
        const float kn = rsqrtf(fmaxf(ss, 1e-24f));
#pragma unroll
        for (int n = 0; n < 4; ++n) {
            const int c0 = h * 64 + 16 * n + 4 * (lane >> 4);
            const f32x4 cw0 = *(const f32x4*)(cst + c0), ca0 = *(const f32x4*)(cst + 512 + c0), cmr = *(const f32x4*)(cst + 1024 + c0), cmk = *(const f32x4*)(cst + 1536 + c0);
            const f32x4 cmv = *(const f32x4*)(cst + 2048 + c0), ckk = *(const f32x4*)(cst + 2560 + c0), cka = *(const f32x4*)(cst + 3072 + c0), crk = *(const f32x4*)(cst + 3584 + c0);
            const uint2 rc = *(const uint2*)(fcur + c0 * 2), rp = *(const uint2*)(fprv + c0 * 2);
            const uint2 kc = *(const uint2*)(fcur + (512 + c0) * 2), kp = *(const uint2*)(fprv + (512 + c0) * 2);
            const uint2 vc = *(const uint2*)(fcur + (1024 + c0) * 2), vp = *(const uint2*)(fprv + (1024 + c0) * 2);
            const float fr[4] = {bflo(rc.x), bfhi(rc.x), bflo(rc.y), bfhi(rc.y)}, pr[4] = {bflo(rp.x), bfhi(rp.x), bflo(rp.y), bfhi(rp.y)};
            const float fk[4] = {bflo(kc.x), bfhi(kc.x), bflo(kc.y), bfhi(kc.y)}, pk[4] = {bflo(kp.x), bfhi(kp.x), bflo(kp.y), bfhi(kp.y)};
            const float fv[4] = {bflo(vc.x), bfhi(vc.x), bflo(vc.y), bfhi(vc.y)}, pv[4] = {bflo(vp.x), bfhi(vp.x), bflo(vp.y), bfhi(vp.y)};
            float r[4], k2[4], v[4], e2[4], eta[4], kk[4];
#pragma unroll
            for (int q = 0; q < 4; ++q) {
                r[q] = fr[q] + (pr[q] - fr[q]) * cmr[q];
                const float k = fk[q] + (pk[q] - fk[q]) * cmk[q];
                v[q] = fv[q] + (pv[q] - fv[q]) * cmv[q];
                e2[q] = 0.87506123f * sigmoidf_(accw[n][q] + cw0[q]);
                eta[q] = sigmoidf_(acca[n][q] + ca0[q]);
                kk[q] = k * ckk[q] * kn;
                k2[q] = k * (1.0f + (eta[q] - 1.0f) * cka[q]);
                rks += r[q] * k2[q] * crk[q];
            }
            const size_t o = (size_t)row * 512 + c0;
            *(uint2*)(P.Rr + o) = make_uint2(pack2(r[0], r[1]), pack2(r[2], r[3])); *(uint2*)(P.Re + o) = make_uint2(pack2(e2[0], e2[1]), pack2(e2[2], e2[3]));
            *(uint2*)(P.Rk + o) = make_uint2(pack2(k2[0], k2[1]), pack2(k2[2], k2[3])); *(uint2*)(P.Rv + o) = make_uint2(pack2(v[0], v[1]), pack2(v[2], v[3]));
            *(uint2*)(P.Rkk + o) = make_uint2(pack2(kk[0], kk[1]), pack2(kk[2], kk[3])); *(uint2*)(P.Reta + o) = make_uint2(pack2(eta[0], eta[1]), pack2(eta[2], eta[3]));
            asm volatile("" ::: "memory"); __builtin_amdgcn_sched_barrier(0);
        }
        rks += __shfl_xor(rks, 16); rks += __shfl_xor(rks, 32);
        if ((lane >> 4) == 0) P.rk[(size_t)row * 8 + h] = rks;
        if (!smp) { if (((r0 + 15) & (TP - 1)) == TP - 1) { float* dst = P.o_shift_p + (size_t)(r0 >> 12) * DSH; for (int col = tid; col < DSH; col += NTHR) dst[col] = bf2f(*(const bf16_t*)(lds + PR_FS + 16 * PR_ROWB + col * 2)); } }
        else { const int b0 = (r0 - MP) >> 3;
            for (int col = tid; col < 2 * DSH; col += NTHR) { const int which = col >= DSH, cc = col - which * DSH; P.o_shift_s[(size_t)(b0 + which) * DSH + cc] = bf2f(*(const bf16_t*)(lds + PR_FS + (which ? 16 : 8) * PR_ROWB + cc * 2)); } }
        __syncthreads();
        if (nxt < MT / 16) { PR_FILL(nxt); }
        __syncthreads();
    }
#undef PR_FILL
    if (blockIdx.x < 8) { const bf16_t* hr = H + (size_t)(blockIdx.x * TP + TP - 1) * DIN; for (int col = tid; col < DSH; col += NTHR) P.o_shift_p[(size_t)blockIdx.x * DSH + col] = bf2f(hr[col]); }
}
template <int CTRL> __device__ __forceinline__ float dpp_qp(float x) {
    return __builtin_bit_cast(float, __builtin_amdgcn_update_dpp(0, __builtin_bit_cast(int, x), CTRL, 0xF, 0xF, false));
}
__device__ __forceinline__ float oct_allsum(float x) {
    x += dpp_qp<0xB1>(x);
    x += dpp_qp<0x4E>(x);
    x += dpp_qp<0x141>(x);
    return x;
}
__device__ __forceinline__ void p4_post(const Params& P) {
    int tid_o = TIDX_(P.wid); asm volatile("" : "+v"(tid_o)); const int tid = tid_o, lane = tid & 63, wave = tid >> 6;
    float lw[8], lb[8];
#pragma unroll
    for (int j = 0; j < 8; ++j) { lw[j] = P.lnx_w[lane * 8 + j]; lb[j] = P.lnx_b[lane * 8 + j]; }
    const int xc = (int)blockIdx.x & 7, lwv = ((int)blockIdx.x >> 3) * 8 + wave;
#define POST_ROW(kq) ((kq) < 16 ? xc * TP + lwv + 256 * (kq) : ((kq) == 16 && lwv < 128 ? MP + 128 * xc + lwv : MT))
    for (int it = 0; it < 5; ++it) {
        u32x4 yv[4], vv[4], zv[4]; float rkv[4];
#pragma unroll
        for (int q = 0; q < 4; ++q) {
            const int row = POST_ROW(it * 4 + q);
            if (row < MT) {
                yv[q] = *(const u32x4*)(P.YR + (size_t)row * 512 + lane * 8);
                vv[q] = *(const u32x4*)(P.Rv + (size_t)row * 512 + lane * 8);
                zv[q] = *(const u32x4*)(P.H + (size_t)row * DIN + OFF_ZR + lane * 8);
                rkv[q] = P.rk[(size_t)row * 8 + (lane >> 3)];
            }
        }
#pragma unroll
        for (int q = 0; q < 4; ++q) {
            const int row = POST_ROW(it * 4 + q);
            if (row < MT) {
                float y[8], v[8], z[8];
#pragma unroll
                for (int j = 0; j < 4; ++j) { y[2 * j] = bflo(yv[q][j]); y[2 * j + 1] = bfhi(yv[q][j]); v[2 * j] = bflo(vv[q][j]); v[2 * j + 1] = bfhi(vv[q][j]); z[2 * j] = bflo(zv[q][j]); z[2 * j + 1] = bfhi(zv[q][j]); }
                float s = ((y[0] + y[1]) + (y[2] + y[3])) + ((y[4] + y[5]) + (y[6] + y[7]));
                const float mean = oct_allsum(s) * (1.0f / 64.0f);
                float d[8]; float s2 = 0.f;
#pragma unroll
                for (int j = 0; j < 8; ++j) { d[j] = y[j] - mean; s2 += d[j] * d[j]; }
                const float rstd = rsqrtf(oct_allsum(s2) * (1.0f / 64.0f) + 64e-5f);
                float o[8];
#pragma unroll
                for (int j = 0; j < 8; ++j) { float t = d[j] * rstd * lw[j] + lb[j] + rkv[q] * v[j]; o[j] = t * z[j] * sigmoidf_(z[j]); }
                u32x4 w; w.x = pack2(o[0], o[1]); w.y = pack2(o[2], o[3]); w.z = pack2(o[4], o[5]); w.w = pack2(o[6], o[7]);
                *(u32x4*)(P.H + (size_t)row * DIN + OFF_ZR + lane * 8) = w;
            }
        }
    }
}

__device__ __forceinline__ void p2_zcopy(const Params& P) {
    int tid_o = TIDX_(P.wid); asm volatile("" : "+v"(tid_o)); const int tid = tid_o;
    const int NT_ = gridDim.x * NTHR;
    for (int i = blockIdx.x * NTHR + tid; i < MT * 64; i += NT_ * 4) {
        u32x4 v[4];
#pragma unroll
        for (int q = 0; q < 4; ++q) { const int id = i + q * NT_; if (id < MT * 64) v[q] = *(const u32x4*)(P.H + (size_t)(id >> 6) * DIN + OFF_ZR + (id & 63) * 8); }
#pragma unroll
        for (int q = 0; q < 4; ++q) { const int id = i + q * NT_; if (id < MT * 64) *(u32x4*)(P.XB + (size_t)(id >> 6) * DM + (id & 63) * 8) = v[q]; }
    }
}
#define VT_LD 264
__device__ __forceinline__ void p3_attn_prompt(const Params& P, unsigned char* lds) {
    unsigned char* ldsK = lds;
    bf16_t* ldsVT = (bf16_t*)(lds + 32768);
    const bf16_t* H = P.H;
    int tid_o = TIDX_(P.wid); asm volatile("" : "+v"(tid_o));
    for (int unit = blockIdx.x; unit < 512; unit += gridDim.x) {
        int tid_l = tid_o; asm volatile("" : "+v"(tid_l)); const int tid = tid_l, lane = tid & 63, wid = tid >> 6;
        float kwr[8];
#pragma unroll
        for (int q = 0; q < 8; ++q) kwr[q] = P.k_norm_w[(tid & 7) * 8 + q];
        const int nu_ = (unit & 7) * 64 + (unit >> 3), qb = nu_ & 31, kvh = (nu_ >> 5) & 1, b = nu_ >> 6;
        const int seq_base = b * TP, blk = qb * 128;
        u32x4 qraw[2][4];
        {
            const int g_ = wid & 3, half_ = wid >> 2, head_ = kvh * 4 + g_, ql_ = lane & 31, hh_ = lane >> 5;
            {
                const bf16_t* hr = H + (size_t)(seq_base + blk + half_ * 64 + ql_) * DIN;
#pragma unroll
                for (int s = 0; s < 4; ++s) qraw[0][s] = *(const u32x4*)(hr + OFF_Q + head_ * 64 + s * 16 + hh_ * 8);
            }
        }
        __syncthreads();
#pragma unroll
        for (int i = 0; i < 4; ++i) {
            const int id = tid + NTHR * i, idx = id >> 3, c = id & 7;
            const int pos = blk - 128 + idx;
            u32x4 kv = (u32x4){0u, 0u, 0u, 0u};
            if (pos >= 0) kv = *(const u32x4*)(H + (size_t)(seq_base + pos) * DIN + OFF_K + kvh * 64 + c * 8);
            const int idx2 = (tid & 63) + 64 * i, c2 = tid >> 6, pos2 = blk - 128 + idx2;
            u32x4 vv = (u32x4){0u, 0u, 0u, 0u};
            if (pos2 >= 0) vv = *(const u32x4*)(H + (size_t)(seq_base + pos2) * DIN + OFF_V + kvh * 64 + c2 * 8);
            {
                float kf[8];
#pragma unroll
                for (int q = 0; q < 4; ++q) { kf[2 * q] = bflo(kv[q]); kf[2 * q + 1] = bfhi(kv[q]); }
                float ss = 0.f;
#pragma unroll
                for (int q = 0; q < 8; ++q) ss += kf[q] * kf[q];
                ss = oct_allsum(ss);
                const float rs = rsqrtf(ss * (1.0f / 64.0f) + 1e-6f);
#pragma unroll
                for (int q = 0; q < 8; ++q) kf[q] *= rs * kwr[q];
                kv.x = pack2(kf[0], kf[1]); kv.y = pack2(kf[2], kf[3]); kv.z = pack2(kf[4], kf[5]); kv.w = pack2(kf[6], kf[7]);
                if (qb == 31 && idx >= 128) {
                    const size_t o = ((size_t)(b * 128 + (idx - 128)) * 2 + kvh) * 64 + c * 8;
                    *(f32x4*)(P.o_ck_p + o) = (f32x4){kf[0], kf[1], kf[2], kf[3]}; *(f32x4*)(P.o_ck_p + o + 4) = (f32x4){kf[4], kf[5], kf[6], kf[7]};
                }
            }
            if (qb == 31 && idx2 >= 128) {
                const size_t o = ((size_t)(b * 128 + (idx2 - 128)) * 2 + kvh) * 64 + c2 * 8;
                *(f32x4*)(P.o_cv_p + o) = (f32x4){bflo(vv.x), bfhi(vv.x), bflo(vv.y), bfhi(vv.y)}; *(f32x4*)(P.o_cv_p + o + 4) = (f32x4){bflo(vv.z), bfhi(vv.z), bflo(vv.w), bfhi(vv.w)};
            }
            *(u32x4*)(ldsK + idx * 128 + ((c ^ (idx & 7)) << 4)) = kv;
#pragma unroll
            for (int q = 0; q < 4; ++q) {
                ldsVT[(c2 * 8 + q * 2) * VT_LD + idx2] = (bf16_t)(vv[q] & 0xffffu);
                ldsVT[(c2 * 8 + q * 2 + 1) * VT_LD + idx2] = (bf16_t)(vv[q] >> 16);
            }
        }
        __syncthreads();
        const int g = wid & 3, half = wid >> 2, head = kvh * 4 + g;
        {
            const bf16_t* hr = H + (size_t)(seq_base + blk + half * 64 + 32 + (lane & 31)) * DIN;
#pragma unroll
            for (int s = 0; s < 4; ++s) qraw[1][s] = *(const u32x4*)(hr + OFF_Q + head * 64 + s * 16 + (lane >> 5) * 8);
        }
        const float sink = P.sinks[head] * 1.44269504f;
        const int ql = lane & 31, hh = lane >> 5;
#pragma unroll
        for (int sb = 0; sb < 2; ++sb) {
            const int q0 = half * 64 + sb * 32;
            const int qrow = seq_base + blk + q0 + ql;
            uint2 zz[8];
            { const bf16_t* zr_ = H + (size_t)qrow * DIN + OFF_ZA + head * 64;
#pragma unroll
              for (int dt = 0; dt < 2; ++dt)
#pragma unroll
                for (int gq = 0; gq < 4; ++gq) zz[dt * 4 + gq] = *(const uint2*)(zr_ + dt * 32 + 8 * gq + 4 * hh); }
            bf16x8 qf[4];
            {
                float ss = 0.f;
#pragma unroll
                for (int s = 0; s < 4; ++s) {
#pragma unroll
                    for (int q = 0; q < 4; ++q) { const float x0 = bflo(qraw[sb][s][q]), x1 = bfhi(qraw[sb][s][q]); ss += x0 * x0 + x1 * x1; } }
                ss += __shfl_xor(ss, 32);
                const float rs = rsqrtf(ss * (1.0f / 64.0f) + 1e-6f) * (0.125f * 1.44269504f);
#pragma unroll
                for (int s = 0; s < 4; ++s) { u32x4 w;
#pragma unroll
                    for (int q = 0; q < 4; ++q) { const int d = s * 16 + hh * 8 + q * 2; w[q] = pack2(bflo(qraw[sb][s][q]) * rs * P.q_norm_w[d], bfhi(qraw[sb][s][q]) * rs * P.q_norm_w[d + 1]); }
                    qf[s] = __builtin_bit_cast(bf16x8, w); }
            }
            const int t0 = q0 >> 5;
            f32x16 sc[5];
#pragma unroll
            for (int kt = 0; kt < 5; ++kt) {
                f32x16 a;
#pragma unroll
                for (int r = 0; r < 16; ++r) a[r] = 0.f;
                const int krow = (t0 + kt) * 32 + ql;
#pragma unroll
                for (int s = 0; s < 4; ++s) {
                    const int c = s * 2 + hh;
                    const bf16x8 kf = *(const bf16x8*)(ldsK + krow * 128 + ((c ^ (krow & 7)) << 4));
                    a = __builtin_amdgcn_mfma_f32_32x32x16_bf16(kf, qf[s], a, 0, 0, 0);
                }
                sc[kt] = a;
            }
            const int kt_min = (qb == 0) ? 4 - t0 : 0;
            const int xq = ql - 4 * hh;
            float m = sink;
#pragma unroll
            for (int kt = 0; kt < 5; ++kt) {
                const bool dead = kt < kt_min;
#pragma unroll
                for (int r = 0; r < 16; ++r) {
                    const int cr = (r & 3) + 8 * (r >> 2);
                    const bool bad = dead || (kt == 0 && cr <= xq) || (kt == 4 && cr > xq);
                    const float s = bad ? -1e30f : sc[kt][r];
                    sc[kt][r] = s;
                    m = fmaxf(m, s);
                }
            }
            m = fmaxf(m, __shfl_xor(m, 32));
            float sum = 0.f;
#pragma unroll
            for (int kt = 0; kt < 5; ++kt)
#pragma unroll
                for (int r = 0; r < 16; ++r) { const float p = fexp2_(sc[kt][r] - m); sc[kt][r] = p; sum += p; }
            sum += __shfl_xor(sum, 32);
            const float inv = frcp_(sum + fexp2_(sink - m));
            f32x16 o[2];
#pragma unroll
            for (int dt = 0; dt < 2; ++dt)
#pragma unroll
                for (int r = 0; r < 16; ++r) o[dt][r] = 0.f;
#pragma unroll
            for (int kt = 0; kt < 5; ++kt)
#pragma unroll
                for (int s = 0; s < 2; ++s) {
                    u32x4 pw;
                    pw.x = pack2(sc[kt][8 * s + 0], sc[kt][8 * s + 1]); pw.y = pack2(sc[kt][8 * s + 2], sc[kt][8 * s + 3]);
                    pw.z = pack2(sc[kt][8 * s + 4], sc[kt][8 * s + 5]); pw.w = pack2(sc[kt][8 * s + 6], sc[kt][8 * s + 7]);
                    const bf16x8 pf = __builtin_bit_cast(bf16x8, pw);
                    const int key0 = (t0 + kt) * 32 + 16 * s + 4 * hh;
#pragma unroll
                    for (int dt = 0; dt < 2; ++dt) {
                        const bf16_t* vp = ldsVT + (dt * 32 + ql) * VT_LD + key0;
                        const uint2 v0 = *(const uint2*)vp, v1 = *(const uint2*)(vp + 8);
                        u32x4 vw; vw.x = v0.x; vw.y = v0.y; vw.z = v1.x; vw.w = v1.y;
                        const bf16x8 vf = __builtin_bit_cast(bf16x8, vw);
                        o[dt] = __builtin_amdgcn_mfma_f32_32x32x16_bf16(vf, pf, o[dt], 0, 0, 0);
                    }
                }
            const bf16_t* zr = H + (size_t)qrow * DIN + OFF_ZA + head * 64;
            int qrow_o = qrow; asm volatile("" : "+v"(qrow_o));
            bf16_t* orow = (bf16_t*)((unsigned char*)P.H + ((unsigned)qrow_o * (unsigned)(DIN * 2) + (unsigned)((OFF_Q + head * 64) * 2)));
#pragma unroll
            for (int dt = 0; dt < 2; ++dt)
#pragma unroll
                for (int gq = 0; gq < 4; ++gq) {
                    const int d = dt * 32 + 8 * gq + 4 * hh;
                    const uint2 z2 = zz[dt * 4 + gq];
                    const float z0 = bflo(z2.x), z1 = bfhi(z2.x), z2f = bflo(z2.y), z3 = bfhi(z2.y);
                    const float o0 = o[dt][gq * 4 + 0] * inv * z0 * sigmoidf_(z0);
                    const float o1 = o[dt][gq * 4 + 1] * inv * z1 * sigmoidf_(z1);
                    const float o2 = o[dt][gq * 4 + 2] * inv * z2f * sigmoidf_(z2f);
                    const float o3 = o[dt][gq * 4 + 3] * inv * z3 * sigmoidf_(z3);
                    *(uint2*)(orow + d) = make_uint2(pack2(o0, o1), pack2(o2, o3));
                }
            __builtin_amdgcn_sched_barrier(0);
        }
    }
}

#define VS_LD 168
__device__ __forceinline__ void p3_attn_sample(const Params& P, unsigned char* lds) {
    unsigned char* ldsK = lds;
    bf16_t* ldsVT = (bf16_t*)(lds + 20480);
    const bf16_t* H = P.H;
    int tid_o = TIDX_(P.wid); asm volatile("" : "+v"(tid_o)); const int tid = tid_o, lane = tid & 63, wid = tid >> 6;
    for (int unit = blockIdx.x; unit < 256; unit += gridDim.x) {
        const int b = 16 * (unit & 7) + (unit >> 4), kvh = (unit >> 3) & 1;
        __syncthreads();
#pragma unroll
        for (int i = 0; i < 2; ++i) {
            const int id = tid + NTHR * i, j = id >> 3, c = id & 7;
            const float* kp = P.cache_k + ((size_t)(b * 128 + j) * 2 + kvh) * 64 + c * 8;
            const f32x4 k0 = *(const f32x4*)kp, k1 = *(const f32x4*)(kp + 4);
            *(u32x4*)(ldsK + j * 128 + ((c ^ (j & 7)) << 4)) = (u32x4){pack2(k0[0], k0[1]), pack2(k0[2], k0[3]), pack2(k1[0], k1[1]), pack2(k1[2], k1[3])};
            if (j >= 8) { float* op = P.o_ck_s + ((size_t)(b * 128 + j - 8) * 2 + kvh) * 64 + c * 8; *(f32x4*)op = k0; *(f32x4*)(op + 4) = k1; }
            const int j2 = (tid & 63) + 64 * i, c2 = tid >> 6;
            const float* vp = P.cache_v + ((size_t)(b * 128 + j2) * 2 + kvh) * 64 + c2 * 8;
            const f32x4 v0 = *(const f32x4*)vp, v1 = *(const f32x4*)(vp + 4);
#pragma unroll
            for (int q = 0; q < 4; ++q) { ldsVT[(c2 * 8 + q) * VS_LD + j2] = f2bf(v0[q]); ldsVT[(c2 * 8 + 4 + q) * VS_LD + j2] = f2bf(v1[q]); }
            if (j2 >= 8) { float* op = P.o_cv_s + ((size_t)(b * 128 + j2 - 8) * 2 + kvh) * 64 + c2 * 8; *(f32x4*)op = v0; *(f32x4*)(op + 4) = v1; }
        }
        if (tid < 64) {
            const int t = tid >> 3, c = tid & 7;
            const bf16_t* hr = H + (size_t)(MP + b * TS + t) * DIN;
            const u32x4 kv = *(const u32x4*)(hr + OFF_K + kvh * 64 + c * 8), vv = *(const u32x4*)(hr + OFF_V + kvh * 64 + c * 8);
            float kf[8], vf[8];
#pragma unroll
            for (int q = 0; q < 4; ++q) { kf[2 * q] = bflo(kv[q]); kf[2 * q + 1] = bfhi(kv[q]); vf[2 * q] = bflo(vv[q]); vf[2 * q + 1] = bfhi(vv[q]); }
            float ss = 0.f;
#pragma unroll
            for (int q = 0; q < 8; ++q) ss += kf[q] * kf[q];
            ss = oct_allsum(ss);
            const float rs = rsqrtf(ss * (1.0f / 64.0f) + 1e-6f);
#pragma unroll
            for (int q = 0; q < 8; ++q) kf[q] *= rs * P.k_norm_w[c * 8 + q];
            const int j = 128 + t;
            *(u32x4*)(ldsK + j * 128 + ((c ^ (j & 7)) << 4)) = (u32x4){pack2(kf[0], kf[1]), pack2(kf[2], kf[3]), pack2(kf[4], kf[5]), pack2(kf[6], kf[7])};
#pragma unroll
            for (int q = 0; q < 8; ++q) ldsVT[(c * 8 + q) * VS_LD + j] = f2bf(vf[q]);
            float* okp = P.o_ck_s + ((size_t)(b * 128 + 120 + t) * 2 + kvh) * 64 + c * 8; float* ovp = P.o_cv_s + ((size_t)(b * 128 + 120 + t) * 2 + kvh) * 64 + c * 8;
            *(f32x4*)okp = (f32x4){kf[0], kf[1], kf[2], kf[3]}; *(f32x4*)(okp + 4) = (f32x4){kf[4], kf[5], kf[6], kf[7]};
            *(f32x4*)ovp = (f32x4){vf[0], vf[1], vf[2], vf[3]}; *(f32x4*)(ovp + 4) = (f32x4){vf[4], vf[5], vf[6], vf[7]};
        } else if (tid < 64 + 192) {
            const int id = tid - 64, j = 136 + (id >> 3), c = id & 7;
            *(u32x4*)(ldsK + j * 128 + ((c ^ (j & 7)) << 4)) = (u32x4){0u, 0u, 0u, 0u};
#pragma unroll
            for (int q = 0; q < 8; ++q) ldsVT[(c * 8 + q) * VS_LD + j] = (bf16_t)0;
        }
        __syncthreads();
        if (wid == 0) {
            const int ql = lane & 31, hh = lane >> 5, t = ql >> 2, g = ql & 3, head = kvh * 4 + g;
            const int qrow = MP + b * TS + t;
            const float sink = P.sinks[head];
            uint2 zz[8];
            { const bf16_t* zr_ = H + (size_t)qrow * DIN + OFF_ZA + head * 64;
#pragma unroll
              for (int dt = 0; dt < 2; ++dt)
#pragma unroll
                for (int gq = 0; gq < 4; ++gq) zz[dt * 4 + gq] = *(const uint2*)(zr_ + dt * 32 + 8 * gq + 4 * hh); }
            bf16x8 qf[4];
            {
                u32x4 qraw[4]; float ss = 0.f;
#pragma unroll
                for (int s = 0; s < 4; ++s) { qraw[s] = *(const u32x4*)(H + (size_t)qrow * DIN + OFF_Q + head * 64 + s * 16 + hh * 8);
#pragma unroll
                    for (int q = 0; q < 4; ++q) { const float x0 = bflo(qraw[s][q]), x1 = bfhi(qraw[s][q]); ss += x0 * x0 + x1 * x1; } }
                ss += __shfl_xor(ss, 32);
                const float rs = rsqrtf(ss * (1.0f / 64.0f) + 1e-6f) * 0.125f;
#pragma unroll
                for (int s = 0; s < 4; ++s) { u32x4 w;
#pragma unroll
                    for (int q = 0; q < 4; ++q) { const int d = s * 16 + hh * 8 + q * 2; w[q] = pack2(bflo(qraw[s][q]) * rs * P.q_norm_w[d], bfhi(qraw[s][q]) * rs * P.q_norm_w[d + 1]); }
                    qf[s] = __builtin_bit_cast(bf16x8, w); }
            }
            f32x16 sc[5];
#pragma unroll
            for (int kt = 0; kt < 5; ++kt) {
                f32x16 a;
#pragma unroll
                for (int r = 0; r < 16; ++r) a[r] = 0.f;
                const int krow = kt * 32 + ql;
#pragma unroll
                for (int s = 0; s < 4; ++s) {
                    const int c = s * 2 + hh;
                    const bf16x8 kf = *(const bf16x8*)(ldsK + krow * 128 + ((c ^ (krow & 7)) << 4));
                    a = __builtin_amdgcn_mfma_f32_32x32x16_bf16(kf, qf[s], a, 0, 0, 0);
                }
                sc[kt] = a;
            }
            float m = sink;
#pragma unroll
            for (int kt = 0; kt < 5; ++kt)
#pragma unroll
                for (int r = 0; r < 16; ++r) {
                    const int kidx = kt * 32 + (r & 3) + 8 * (r >> 2) + 4 * hh;
                    const bool valid = (kidx > t) && (kidx <= t + 128);
                    const float s = valid ? sc[kt][r] : -1e30f;
                    sc[kt][r] = s;
                    m = fmaxf(m, s);
                }
            m = fmaxf(m, __shfl_xor(m, 32));
            float sum = 0.f;
#pragma unroll
            for (int kt = 0; kt < 5; ++kt)
#pragma unroll
                for (int r = 0; r < 16; ++r) { const float p = __expf(sc[kt][r] - m); sc[kt][r] = p; sum += p; }
            sum += __shfl_xor(sum, 32);
            const float inv = 1.0f / (sum + __expf(sink - m));
            f32x16 o[2];
#pragma unroll
            for (int dt = 0; dt < 2; ++dt)
#pragma unroll
                for (int r = 0; r < 16; ++r) o[dt][r] = 0.f;
#pragma unroll
            for (int kt = 0; kt < 5; ++kt)
#pragma unroll
                for (int s = 0; s < 2; ++s) {
                    u32x4 pw;
                    pw.x = pack2(sc[kt][8 * s + 0], sc[kt][8 * s + 1]); pw.y = pack2(sc[kt][8 * s + 2], sc[kt][8 * s + 3]);
                    pw.z = pack2(sc[kt][8 * s + 4], sc[kt][8 * s + 5]); pw.w = pack2(sc[kt][8 * s + 6], sc[kt][8 * s + 7]);
                    const bf16x8 pf = __builtin_bit_cast(bf16x8, pw);
                    const int key0 = kt * 32 + 16 * s + 4 * hh;
#pragma unroll
                    for (int dt = 0; dt < 2; ++dt) {
                        const bf16_t* vp = ldsVT + (dt * 32 + ql) * VS_LD + key0;
                        const uint2 v0 = *(const uint2*)vp, v1 = *(const uint2*)(vp + 8);
                        u32x4 vw; vw.x = v0.x; vw.y = v0.y; vw.z = v1.x; vw.w = v1.y;
                        const bf16x8 vf = __builtin_bit_cast(bf16x8, vw);
                        o[dt] = __builtin_amdgcn_mfma_f32_32x32x16_bf16(vf, pf, o[dt], 0, 0, 0);
                    }
                }
            bf16_t* orow = P.H + (size_t)qrow * DIN + OFF_Q + head * 64;
#pragma unroll
            for (int dt = 0; dt < 2; ++dt)
#pragma unroll
                for (int gq = 0; gq < 4; ++gq) {
                    const int d = dt * 32 + 8 * gq + 4 * hh;
                    const uint2 z2 = zz[dt * 4 + gq];
                    const float z0 = bflo(z2.x), z1 = bfhi(z2.x), z2f = bflo(z2.y), z3 = bfhi(z2.y);
                    const float o0 = o[dt][gq * 4 + 0] * inv * z0 * sigmoidf_(z0);
                    const float o1 = o[dt][gq * 4 + 1] * inv * z1 * sigmoidf_(z1);
                    const float o2 = o[dt][gq * 4 + 2] * inv * z2f * sigmoidf_(z2f);
                    const float o3 = o[dt][gq * 4 + 3] * inv * z3 * sigmoidf_(z3);
                    *(uint2*)(orow + d) = make_uint2(pack2(o0, o1), pack2(o2, o3));
                }
        }
    }
}
#define SS_BUF 2832
__device__ __forceinline__ void p3_scan(const Params& P, unsigned char* lds) {
    int tid_o = TIDX_(P.wid); asm volatile("" : "+v"(tid_o)); const int tid = tid_o, lane = tid & 63, wv = tid >> 6;
    const int grp = wv >> 2, tl = tid & 255;
    float* const B_ = (float*)lds + grp * SS_BUF;
    const int row_local = (wv & 3) * 4 + (lane >> 4), kq = lane & 15;
    const int stok = tl >> 3, scc = tl & 7; const bool stager = tl < 64;
    u32x4 gr = (u32x4){0u, 0u, 0u, 0u}, ge = gr, gk = gr, gv = gr, gkk = gr, get = gr;
    f32x4 Snext = (f32x4){0.f, 0.f, 0.f, 0.f};
#define SS_UNIT(p) (512 * ((int)blockIdx.x & 7) + ((int)blockIdx.x >> 3) * 16 + 2 * (p) + grp)
#define SS_PREFETCH(p) { const int un_ = SS_UNIT(p), b_ = un_ >> 5, h_ = (un_ >> 2) & 7, vq_ = un_ & 3; \
        Snext = *(const f32x4*)(P.state_rwkv + (size_t)(b_ * 8 + h_) * 4096 + (vq_ * 16 + row_local) * 64 + kq * 4); \
        if (stager) { const size_t o = (size_t)(MP + b_ * TS + stok) * 512 + h_ * 64 + scc * 8; \
            gr = *(const u32x4*)(P.Rr + o); ge = *(const u32x4*)(P.Re + o); gk = *(const u32x4*)(P.Rk + o); gv = *(const u32x4*)(P.Rv + o); gkk = *(const u32x4*)(P.Rkk + o); get = *(const u32x4*)(P.Reta + o); } }
    SS_PREFETCH(0)
    for (int p = 0; p < 8; ++p) {
        const int un = SS_UNIT(p), b = un >> 5, h = (un >> 2) & 7, vq = un & 3;
        __syncthreads();
        if (stager) {
            const int bo = stok * 64 + scc * 8; float fa[8], fwr[8], fw[8], fb[8], fk[8]; float br = 0.f, kr = 0.f;
#pragma unroll
            for (int q = 0; q < 4; ++q) {
                const float kk0 = bflo(gkk[q]), kk1 = bfhi(gkk[q]), r0 = bflo(gr[q]), r1 = bfhi(gr[q]);
                fa[2 * q] = -kk0; fa[2 * q + 1] = -kk1; fb[2 * q] = kk0 * bflo(get[q]); fb[2 * q + 1] = kk1 * bfhi(get[q]);
                fw[2 * q] = fexp2_(-bflo(ge[q])); fw[2 * q + 1] = fexp2_(-bfhi(ge[q])); fwr[2 * q] = fw[2 * q] * r0; fwr[2 * q + 1] = fw[2 * q + 1] * r1;
                fk[2 * q] = bflo(gk[q]); fk[2 * q + 1] = bfhi(gk[q]);
                br += fb[2 * q] * r0 + fb[2 * q + 1] * r1; kr += fk[2 * q] * r0 + fk[2 * q + 1] * r1; }
            *(f32x4*)(B_ + bo) = (f32x4){fa[0], fa[1], fa[2], fa[3]}; *(f32x4*)(B_ + bo + 4) = (f32x4){fa[4], fa[5], fa[6], fa[7]};
            *(f32x4*)(B_ + 512 + bo) = (f32x4){fwr[0], fwr[1], fwr[2], fwr[3]}; *(f32x4*)(B_ + 512 + bo + 4) = (f32x4){fwr[4], fwr[5], fwr[6], fwr[7]};
            *(f32x4*)(B_ + 1024 + bo) = (f32x4){fw[0], fw[1], fw[2], fw[3]}; *(f32x4*)(B_ + 1024 + bo + 4) = (f32x4){fw[4], fw[5], fw[6], fw[7]};
            *(f32x4*)(B_ + 1536 + bo) = (f32x4){fb[0], fb[1], fb[2], fb[3]}; *(f32x4*)(B_ + 1536 + bo + 4) = (f32x4){fb[4], fb[5], fb[6], fb[7]};
            *(f32x4*)(B_ + 2048 + bo) = (f32x4){fk[0], fk[1], fk[2], fk[3]}; *(f32x4*)(B_ + 2048 + bo + 4) = (f32x4){fk[4], fk[5], fk[6], fk[7]};
            if ((scc >> 1) == vq) { float* vp = B_ + 2560 + stok * 16 + (scc & 1) * 8;
                *(f32x4*)vp = (f32x4){bflo(gv[0]), bfhi(gv[0]), bflo(gv[1]), bfhi(gv[1])}; *(f32x4*)(vp + 4) = (f32x4){bflo(gv[2]), bfhi(gv[2]), bflo(gv[3]), bfhi(gv[3])}; }
            br = oct_allsum(br); kr = oct_allsum(kr);
            if (scc == 0) { B_[2688 + stok * 2] = br; B_[2688 + stok * 2 + 1] = kr; }
        }
        float S[4] = {Snext[0], Snext[1], Snext[2], Snext[3]};
        if (p + 1 < 8) SS_PREFETCH(p + 1)
        __syncthreads();
        {
            const float* pa = B_ + kq * 4; const float* pv = B_ + 2560 + row_local; const float* pbk = B_ + 2688; float* py = B_ + 2704 + row_local;
#define SS_LOAD(X, tt) const f32x4 a_##X = *(const f32x4*)(pa + (tt) * 64), wr_##X = *(const f32x4*)(pa + 512 + (tt) * 64), w_##X = *(const f32x4*)(pa + 1024 + (tt) * 64), \
                b_##X = *(const f32x4*)(pa + 1536 + (tt) * 64), k_##X = *(const f32x4*)(pa + 2048 + (tt) * 64); const float v_##X = pv[(tt) * 16]; const f32x2_t bk_##X = *(const f32x2_t*)(pbk + (tt) * 2);
#define SS_STEP(X, tt) { float u = (S[0] * a_##X[0] + S[1] * a_##X[1]) + (S[2] * a_##X[2] + S[3] * a_##X[3]); \
                float ya = (S[0] * wr_##X[0] + S[1] * wr_##X[1]) + (S[2] * wr_##X[2] + S[3] * wr_##X[3]); \
                u += dpp_f<0x128>(u); ya += dpp_f<0x128>(ya); u += dpp_f<0x124>(u); ya += dpp_f<0x124>(ya); \
                u += dpp_f<0x122>(u); ya += dpp_f<0x122>(ya); u += dpp_f<0x121>(u); ya += dpp_f<0x121>(ya); \
                S[0] = S[0] * w_##X[0] + (v_##X * k_##X[0] + u * b_##X[0]); S[1] = S[1] * w_##X[1] + (v_##X * k_##X[1] + u * b_##X[1]); \
                S[2] = S[2] * w_##X[2] + (v_##X * k_##X[2] + u * b_##X[2]); S[3] = S[3] * w_##X[3] + (v_##X * k_##X[3] + u * b_##X[3]); \
                const float y = ya + (u * bk_##X[0] + v_##X * bk_##X[1]); if (kq == 0) py[(tt) * 16] = y; }
            { SS_LOAD(A, 0) SS_LOAD(B, 1) SS_STEP(A, 0) SS_LOAD(C, 2) SS_STEP(B, 1) SS_LOAD(D, 3) SS_STEP(C, 2) SS_STEP(D, 3) }
            { SS_LOAD(A, 4) SS_LOAD(B, 5) SS_STEP(A, 4) SS_LOAD(C, 6) SS_STEP(B, 5) SS_LOAD(D, 7) SS_STEP(C, 6) SS_STEP(D, 7) }
#undef SS_LOAD
#undef SS_STEP
            f32x4 s4; s4[0] = S[0]; s4[1] = S[1]; s4[2] = S[2]; s4[3] = S[3];
            *(f32x4*)(P.o_state_s + (size_t)(b * 8 + h) * 4096 + (vq * 16 + row_local) * 64 + kq * 4) = s4;
        }
        __syncthreads();
        if (tl < 16) { const int tok = tl >> 1, hf = tl & 1; const float* yp = B_ + 2704 + tok * 16 + hf * 8;
            u32x4 o4; o4.x = pack2(yp[0], yp[1]); o4.y = pack2(yp[2], yp[3]); o4.z = pack2(yp[4], yp[5]); o4.w = pack2(yp[6], yp[7]);
            *(u32x4*)(P.YR + (size_t)(MP + b * TS + tok) * 512 + h * 64 + vq * 16 + hf * 8) = o4; }
    }
#undef SS_UNIT
#undef SS_PREFETCH
}
#define CH_EF 0
#define CH_ZF 17408
#define CH_A 21760
#define CH_R 29952
#define CH_B 38144
#define CH_K 46336
#define CH_AT 54528
#define CH_BH 62720
#define CH_KH 70912
#define CH_VT 79104
#define CH_T 87296
#define CH_AK 95488
#define CH_RB 103680
#define CH_G2 111872
#define CH_QV 120064
__device__ __forceinline__ int sw_ch(int row, int ch) { return (ch ^ row ^ (int)(0x63417250u >> ((row >> 1) & 0x1c))) & 7; }
__device__ __forceinline__ int sw_off(int row, int col) { return row * 128 + ((sw_ch(row, col >> 3) << 4) | ((col & 7) << 1)); }
__device__ __forceinline__ void nt_prod(const unsigned char* Y, const unsigned char* X, f32x4 (&acc)[2], int w, int lane) {
#pragma unroll
    for (int s = 0; s < 2; ++s) {
        const int yr = 16 * (w & 3) + (lane & 15), ch = 4 * s + (lane >> 4);
        const bf16x8 af = *(const bf16x8*)(Y + yr * 128 + (sw_ch(yr, ch) << 4));
#pragma unroll
        for (int n = 0; n < 2; ++n) {
            const int xr = 32 * (w >> 2) + 8 * ((lane & 15) >> 2) + 4 * n + (lane & 3);
            const bf16x8 bf = *(const bf16x8*)(X + xr * 128 + (sw_ch(xr, ch) << 4));
            acc[n] = __builtin_amdgcn_mfma_f32_16x16x32_bf16(bf, af, acc[n], 0, 0, 0);
        }
    }
}
template <int MODE> __device__ __forceinline__ void nt_mask(f32x4 (&acc)[2], int w, int lane) {
    if (MODE == 0) return;
    const int r = 16 * (w & 3) + (lane & 15);
#pragma unroll
    for (int n = 0; n < 2; ++n)
#pragma unroll
        for (int q = 0; q < 4; ++q) {
            const int c = 32 * (w >> 2) + 8 * (lane >> 4) + 4 * n + q;
            const bool keep = MODE == 1 ? (c < r) : MODE == 2 ? (c > r) : (c <= r);
            if (!keep) acc[n][q] = 0.f;
        }
}
__device__ __forceinline__ void nt_init_lds(const unsigned char* I, f32x4 (&acc)[2], int w, int lane) {
    const int r = 16 * (w & 3) + (lane & 15);
    const u32x4 v = *(const u32x4*)(I + sw_off(r, 32 * (w >> 2) + 8 * (lane >> 4)));
    acc[0] = (f32x4){bflo(v.x), bfhi(v.x), bflo(v.y), bfhi(v.y)}; acc[1] = (f32x4){bflo(v.z), bfhi(v.z), bflo(v.w), bfhi(v.w)};
}
__device__ __forceinline__ void nt_store_lds(unsigned char* O, const f32x4 (&acc)[2], int w, int lane) {
    const int r = 16 * (w & 3) + (lane & 15);
    *(u32x4*)(O + sw_off(r, 32 * (w >> 2) + 8 * (lane >> 4))) = (u32x4){pack2(acc[0][0], acc[0][1]), pack2(acc[0][2], acc[0][3]), pack2(acc[1][0], acc[1][1]), pack2(acc[1][2], acc[1][3])};
}
__device__ __forceinline__ void nt_store_f32(float* O, const f32x4 (&acc)[2], int w, int lane) {
    const int r = 16 * (w & 3) + (lane & 15);
#pragma unroll
    for (int n = 0; n < 2; ++n) { const int c = 32 * (w >> 2) + 8 * (lane >> 4) + 4 * n; *(f32x4*)(O + r * 68 + c) = acc[n]; }
}
__device__ __forceinline__ void nt_store_glb(bf16_t* O, const f32x4 (&acc)[2], int w, int lane) {
    const int r = 16 * (w & 3) + (lane & 15);
    *(u32x4*)(O + r * 64 + 32 * (w >> 2) + 8 * (lane >> 4)) = (u32x4){pack2(acc[0][0], acc[0][1]), pack2(acc[0][2], acc[0][3]), pack2(acc[1][0], acc[1][1]), pack2(acc[1][2], acc[1][3])};
}
#define ZACC(a) { a[0] = (f32x4){0.f, 0.f, 0.f, 0.f}; a[1] = (f32x4){0.f, 0.f, 0.f, 0.f}; }

#define CH_TH CH_A
#define CH_AL CH_R
#define CH_WD CH_B
#define CH_WA CH_K
#define CH_ZW CH_AT
#define CH_ZA 71936
#define CH_CST (131072 + 1024)
__device__ __forceinline__ void p3_chunk_a(const Params& P, unsigned char* lds) {
    int tid_o = TIDX_(P.wid); asm volatile("" : "+v"(tid_o)); const int tid = tid_o, lane = tid & 63, w = tid >> 6;
    float* EF = (float*)(lds + CH_EF); float* ZF = (float*)(lds + CH_ZF); float* cst = (float*)(lds + CH_CST);
    const bf16_t* H = P.H;
    const int tok = tid >> 3, cc = tid & 7;
    const int tok2 = (tid & 255) >> 2, cc2 = (tid >> 8) * 4 + (tid & 3);
    __syncthreads();
    { cst[tid] = P.w0[tid]; cst[512 + tid] = P.a0[tid]; cst[1024 + tid] = P.mu[tid]; cst[1536 + tid] = P.mu[512 + tid]; cst[2048 + tid] = P.mu[1024 + tid];
      cst[2560 + tid] = P.k_k[tid]; cst[3072 + tid] = P.k_a[tid]; cst[3584 + tid] = P.r_k[tid]; }
    if (tid < 128) cst[4096 + tid] = P.mu[1536 + tid];
    u32x4 nhr, nhk, nhv, npr, npk, npv, nl0, nl1, nq0, nq1, nwd, nwa;
#define CH_GLOAD(un) { const int bh_ = (un) >> 6, c_ = (un) & 63, h_ = bh_ & 7; const size_t R_ = (size_t)((bh_ >> 3) * TP + c_ * 64 + tok); const bf16_t* hc = H + R_ * DIN; \
        nhr = *(const u32x4*)(hc + h_ * 64 + cc * 8); nhk = *(const u32x4*)(hc + 512 + h_ * 64 + cc * 8); nhv = *(const u32x4*)(hc + 1024 + h_ * 64 + cc * 8); \
        const bf16_t* hl = H + (size_t)((bh_ >> 3) * TP + c_ * 64 + tok2) * DIN + 1536 + 16 * cc2; nl0 = *(const u32x4*)hl; nl1 = *(const u32x4*)(hl + 8); \
        if (c_ == 0 && tok == 0) { npr = (u32x4){0u, 0u, 0u, 0u}; npk = npr; npv = npr; } \
        else { const bf16_t* hp = hc - DIN; npr = *(const u32x4*)(hp + h_ * 64 + cc * 8); npk = *(const u32x4*)(hp + 512 + h_ * 64 + cc * 8); npv = *(const u32x4*)(hp + 1024 + h_ * 64 + cc * 8); } \
        if (c_ == 0 && tok2 == 0) { nq0 = (u32x4){0u, 0u, 0u, 0u}; nq1 = nq0; } else { nq0 = *(const u32x4*)(hl - DIN); nq1 = *(const u32x4*)(hl - DIN + 8); } \
        nwd = *(const u32x4*)(P.WLd + (size_t)h_ * 4096 + tid * 8); nwa = *(const u32x4*)(P.WLa + (size_t)h_ * 4096 + tid * 8); }
#define CH_UNIT(k) ((8 * ((int)blockIdx.x & 7) + (((int)blockIdx.x >> 3) & 7)) * 64 + ((int)blockIdx.x >> 6) + 4 * (k))
    CH_GLOAD(CH_UNIT(0))
    __syncthreads();
    for (int ku = 0; ku < 16; ++ku) { const int unit = CH_UNIT(ku);
        int tid_l = tid; asm volatile("" : "+v"(tid_l));
        const int tok = tid_l >> 3, cc = tid_l & 7, lane = tid_l & 63, w = tid_l >> 6, tok2 = (tid_l & 255) >> 2, cc2 = (tid_l >> 8) * 4 + (tid_l & 3);
        const int bh = unit >> 6, c = unit & 63, b = bh >> 3, h = bh & 7;
        const size_t R = (size_t)(b * TP + c * 64 + tok);
        float r[8], k2[8], v[8], e2[8], kk[8], eta[8];
        {
            const int c0 = h * 64 + cc * 8;
            const f32x4 mr0 = *(const f32x4*)(cst + 1024 + c0), mr1 = *(const f32x4*)(cst + 1024 + c0 + 4), mk0 = *(const f32x4*)(cst + 1536 + c0), mk1 = *(const f32x4*)(cst + 1536 + c0 + 4);
            const f32x4 mv0 = *(const f32x4*)(cst + 2048 + c0), mv1 = *(const f32x4*)(cst + 2048 + c0 + 4);
#pragma unroll
            for (int q = 0; q < 8; ++q) {
                const float fr = (q & 1) ? bfhi(nhr[q >> 1]) : bflo(nhr[q >> 1]), pr = (q & 1) ? bfhi(npr[q >> 1]) : bflo(npr[q >> 1]);
                const float fk = (q & 1) ? bfhi(nhk[q >> 1]) : bflo(nhk[q >> 1]), pk = (q & 1) ? bfhi(npk[q >> 1]) : bflo(npk[q >> 1]);
                const float fv = (q & 1) ? bfhi(nhv[q >> 1]) : bflo(nhv[q >> 1]), pv = (q & 1) ? bfhi(npv[q >> 1]) : bflo(npv[q >> 1]);
                r[q] = fr + (pr - fr) * (q < 4 ? mr0[q & 3] : mr1[q & 3]);
                k2[q] = fk + (pk - fk) * (q < 4 ? mk0[q & 3] : mk1[q & 3]);
                v[q] = fv + (pv - fv) * (q < 4 ? mv0[q & 3] : mv1[q & 3]);
            }
            float x[16];
#pragma unroll
            for (int j = 0; j < 16; ++j) { const unsigned wc_ = j < 8 ? nl0[(j & 7) >> 1] : nl1[(j & 7) >> 1], wp_ = j < 8 ? nq0[(j & 7) >> 1] : nq1[(j & 7) >> 1];
                const float f = (j & 1) ? bfhi(wc_) : bflo(wc_), fp = (j & 1) ? bfhi(wp_) : bflo(wp_);
                x[j] = f + (fp - f) * cst[4096 + 16 * cc2 + j]; }
            if (cc2 < 4) {
#pragma unroll
                for (int j = 0; j < 16; ++j) x[j] = 1.0f - 2.0f * frcp_(1.0f + fexp2_(2.88539008f * x[j]));
            }
            unsigned char* dst = lds + (cc2 < 4 ? CH_TH : CH_AL) + tok2 * 128; const int ch0 = 2 * (cc2 & 3);
            *(u32x4*)(dst + (sw_ch(tok2, ch0) << 4)) = (u32x4){pack2(x[0], x[1]), pack2(x[2], x[3]), pack2(x[4], x[5]), pack2(x[6], x[7])};
            *(u32x4*)(dst + (sw_ch(tok2, ch0 + 1) << 4)) = (u32x4){pack2(x[8], x[9]), pack2(x[10], x[11]), pack2(x[12], x[13]), pack2(x[14], x[15])};
            const int wrow = tid >> 3, wch = tid & 7;
            *(u32x4*)(lds + CH_WD + wrow * 128 + (sw_ch(wrow, wch) << 4)) = nwd; *(u32x4*)(lds + CH_WA + wrow * 128 + (sw_ch(wrow, wch) << 4)) = nwa;
        }
        __syncthreads();
        {
            f32x4 a0[2], a1[2]; ZACC(a0) ZACC(a1)
            nt_prod(lds + CH_TH, lds + CH_WD, a0, w, lane); nt_prod(lds + CH_AL, lds + CH_WA, a1, w, lane);
            nt_store_f32((float*)(lds + CH_ZW), a0, w, lane); nt_store_f32((float*)(lds + CH_ZA), a1, w, lane);
        }
        __syncthreads();
        {
            const int c0 = h * 64 + cc * 8;
            const float* zwp = (const float*)(lds + CH_ZW) + tok * 68 + cc * 8; const float* zap = (const float*)(lds + CH_ZA) + tok * 68 + cc * 8;
            const f32x4 zw0 = *(const f32x4*)zwp + *(const f32x4*)(cst + c0), zw1 = *(const f32x4*)(zwp + 4) + *(const f32x4*)(cst + c0 + 4);
            const f32x4 za0 = *(const f32x4*)zap + *(const f32x4*)(cst + 512 + c0), za1 = *(const f32x4*)(zap + 4) + *(const f32x4*)(cst + 512 + c0 + 4);
            const f32x4 kk0 = *(const f32x4*)(cst + 2560 + c0), kk1 = *(const f32x4*)(cst + 2560 + c0 + 4), ka0 = *(const f32x4*)(cst + 3072 + c0), ka1 = *(const f32x4*)(cst + 3072 + c0 + 4);
            const f32x4 rk0 = *(const f32x4*)(cst + 3584 + c0), rk1 = *(const f32x4*)(cst + 3584 + c0 + 4);
            float ss = 0.f, rks = 0.f;
#pragma unroll
            for (int q = 0; q < 8; ++q) {
                e2[q] = 0.87506123f * sigmoidf_(q < 4 ? zw0[q & 3] : zw1[q & 3]);
                eta[q] = sigmoidf_(q < 4 ? za0[q & 3] : za1[q & 3]);
                const float km = k2[q];
                kk[q] = km * (q < 4 ? kk0[q & 3] : kk1[q & 3]); ss += kk[q] * kk[q];
                k2[q] = km * (1.0f + (eta[q] - 1.0f) * (q < 4 ? ka0[q & 3] : ka1[q & 3]));
                rks += r[q] * k2[q] * (q < 4 ? rk0[q & 3] : rk1[q & 3]);
            }
            ss = oct_allsum(ss); rks = oct_allsum(rks);
            const float kn = rsqrtf(fmaxf(ss, 1e-24f));
#pragma unroll
            for (int q = 0; q < 8; ++q) kk[q] *= kn;
            *(u32x4*)(P.Rv + R * 512 + c0) = (u32x4){pack2(v[0], v[1]), pack2(v[2], v[3]), pack2(v[4], v[5]), pack2(v[6], v[7])};
            if (cc == 0) P.rk[R * 8 + h] = rks;
            *(f32x4*)(EF + tok * 68 + cc * 8) = (f32x4){e2[0], e2[1], e2[2], e2[3]}; *(f32x4*)(EF + tok * 68 + cc * 8 + 4) = (f32x4){e2[4], e2[5], e2[6], e2[7]};
        }
        __syncthreads();
        *(u32x4*)(lds + CH_T + tid * 16) = (u32x4){0u, 0u, 0u, 0u};
        {
            const int ch = tid & 63, seg = tid >> 6;
            float p[8]; float run = 0.f;
#pragma unroll
            for (int q = 0; q < 8; ++q) { run += EF[(8 * seg + q) * 68 + ch]; p[q] = run; }
            ZF[seg * 64 + ch] = run;
            __syncthreads();
            float offs = 0.f;
#pragma unroll
            for (int s2 = 0; s2 < 7; ++s2) if (s2 < seg) offs += ZF[s2 * 64 + ch];
#pragma unroll
            for (int q = 0; q < 8; ++q) EF[(8 * seg + q) * 68 + ch] = p[q] + offs;
            if (seg == 7) ZF[512 + ch] = __builtin_amdgcn_exp2f(-(p[7] + offs));
        }
        __syncthreads();
        {
            const f32x4 E0 = *(const f32x4*)(EF + tok * 68 + cc * 8), E1 = *(const f32x4*)(EF + tok * 68 + cc * 8 + 4);
            const f32x4 C0 = *(const f32x4*)(ZF + 512 + cc * 8), C1 = *(const f32x4*)(ZF + 512 + cc * 8 + 4);
            float At[8], Rt[8], Bt[8], Kt[8], Bh[8], Kh[8];
#pragma unroll
            for (int q = 0; q < 8; ++q) {
                const float E = q < 4 ? E0[q & 3] : E1[q & 3];
                const float g = __builtin_amdgcn_exp2f(-E), gi = __builtin_amdgcn_exp2f(E), gp = __builtin_amdgcn_exp2f(e2[q] - E), gc = gi * (q < 4 ? C0[q & 3] : C1[q & 3]);
                const float bb = kk[q] * eta[q];
                At[q] = -kk[q] * gp; Rt[q] = r[q] * g; Bt[q] = bb * gi; Kt[q] = k2[q] * gi; Bh[q] = bb * gc; Kh[q] = k2[q] * gc;
            }
            const int so = tok * 128 + (sw_ch(tok, cc) << 4);
            *(u32x4*)(lds + CH_A + so) = (u32x4){pack2(At[0], At[1]), pack2(At[2], At[3]), pack2(At[4], At[5]), pack2(At[6], At[7])};
            *(u32x4*)(lds + CH_R + so) = (u32x4){pack2(Rt[0], Rt[1]), pack2(Rt[2], Rt[3]), pack2(Rt[4], Rt[5]), pack2(Rt[6], Rt[7])};
            *(u32x4*)(lds + CH_B + so) = (u32x4){pack2(Bt[0], Bt[1]), pack2(Bt[2], Bt[3]), pack2(Bt[4], Bt[5]), pack2(Bt[6], Bt[7])};
            *(u32x4*)(lds + CH_K + so) = (u32x4){pack2(Kt[0], Kt[1]), pack2(Kt[2], Kt[3]), pack2(Kt[4], Kt[5]), pack2(Kt[6], Kt[7])};
#pragma unroll
            for (int q = 0; q < 8; ++q) {
                const int to = sw_off(cc * 8 + q, tok);
                *(bf16_t*)(lds + CH_AT + to) = f2bf(At[q]); *(bf16_t*)(lds + CH_BH + to) = f2bf(Bh[q]); *(bf16_t*)(lds + CH_KH + to) = f2bf(Kh[q]); *(bf16_t*)(lds + CH_VT + to) = f2bf(v[q]);
            }
            if (tok == 63) { float* gcp = P.SA_GC + (size_t)unit * 64 + cc * 8;
                *(f32x4*)gcp = C0; *(f32x4*)(gcp + 4) = C1; }
        }
        __syncthreads();
        if (ku + 1 < 16) CH_GLOAD(CH_UNIT(ku + 1))
        {
            f32x4 a0[2], a1[2], a2[2]; ZACC(a0) ZACC(a1) ZACC(a2)
            nt_prod(lds + CH_A, lds + CH_B, a0, w, lane); nt_prod(lds + CH_K, lds + CH_A, a1, w, lane); nt_prod(lds + CH_R, lds + CH_B, a2, w, lane);
            nt_mask<1>(a0, w, lane); nt_mask<2>(a1, w, lane); nt_mask<3>(a2, w, lane);
            nt_store_f32(EF, a0, w, lane); nt_store_lds(lds + CH_G2, a0, w, lane); nt_store_lds(lds + CH_AK, a1, w, lane); nt_store_lds(lds + CH_RB, a2, w, lane);
            *(u32x4*)(lds + CH_QV + tid * 16) = (u32x4){0u, 0u, 0u, 0u};
            if (tid < 272) *(u32x4*)(lds + CH_ZF + tid * 16) = (u32x4){0u, 0u, 0u, 0u};
        }
        __syncthreads();
        if (tid < 64) {
            const int d = tid >> 4, j = tid & 15; const float* Ad = EF + (16 * d) * 68 + 16 * d;
            f32x4 ar[16][4]; float col[16];
#pragma unroll
            for (int t = 1; t < 10; ++t)
#pragma unroll
                for (int c4 = 0; c4 * 4 < t; ++c4) ar[t][c4] = *(const f32x4*)(Ad + t * 68 + 4 * c4);
#pragma unroll
            for (int t = 0; t < 10; ++t) { float v = (t == j) ? 1.f : 0.f;
#pragma unroll
                for (int i = 0; i < t; ++i) v += ar[t][i >> 2][i & 3] * col[i];
                col[t] = v; }
#pragma unroll
            for (int t = 10; t < 16; ++t)
#pragma unroll
                for (int c4 = 0; c4 * 4 < t; ++c4) ar[t][c4] = *(const f32x4*)(Ad + t * 68 + 4 * c4);
#pragma unroll
            for (int t = 10; t < 16; ++t) { float v = (t == j) ? 1.f : 0.f;
#pragma unroll
                for (int i = 0; i < t; ++i) v += ar[t][i >> 2][i & 3] * col[i];
                col[t] = v; }
#pragma unroll
            for (int t = 0; t < 16; ++t) { const bf16_t tv = f2bf(col[t]); *(bf16_t*)(lds + CH_T + sw_off(16 * d + t, 16 * d + j)) = tv; *(bf16_t*)(lds + CH_QV + sw_off(16 * d + j, 16 * d + t)) = tv; }
            const int l15 = lane & 15, g4 = lane >> 4;
#define CH_LVL(dd) { _Pragma("unroll") for (int jb = 0; jb < (dd); ++jb) { f32x4 z = (f32x4){0.f, 0.f, 0.f, 0.f}; \
                    _Pragma("unroll") for (int s = 0; s < ((dd) + 1) / 2; ++s) { const int yr = 16 * jb + l15, xr = 16 * (dd) + l15, ch = 4 * s + g4; \
                        const bf16x8 yf = *(const bf16x8*)(lds + CH_QV + yr * 128 + (sw_ch(yr, ch) << 4)), xf = *(const bf16x8*)(lds + CH_G2 + xr * 128 + (sw_ch(xr, ch) << 4)); \
                        z = __builtin_amdgcn_mfma_f32_16x16x32_bf16(xf, yf, z, 0, 0, 0); } \
                    *(uint2*)(lds + CH_ZF + (16 * jb + l15) * 64 + 32 + 8 * g4) = make_uint2(pack2(z[0], z[1]), pack2(z[2], z[3])); } \
                asm volatile("s_waitcnt lgkmcnt(0)" ::: "memory"); \
                _Pragma("unroll") for (int jb = 0; jb < (dd); ++jb) { const int yr = 16 * (dd) + l15, ch = 2 * (dd) - 2 + g4; \
                    const bf16x8 yf = *(const bf16x8*)(lds + CH_T + yr * 128 + (sw_ch(yr, ch) << 4)), xf = *(const bf16x8*)(lds + CH_ZF + (16 * jb + l15) * 64 + 16 * g4); \
                    f32x4 t = __builtin_amdgcn_mfma_f32_16x16x32_bf16(xf, yf, (f32x4){0.f, 0.f, 0.f, 0.f}, 0, 0, 0); \
                    tq[jb] = t; } \
                _Pragma("unroll") for (int jb = 0; jb < (dd); ++jb) { const f32x4 t = tq[jb]; const int rr = 16 * (dd) + l15, cc0 = 16 * jb + 4 * g4; \
                    *(uint2*)(lds + CH_T + sw_off(rr, cc0)) = make_uint2(pack2(t[0], t[1]), pack2(t[2], t[3])); \
                    _Pragma("unroll") for (int q = 0; q < 4; ++q) *(bf16_t*)(lds + CH_QV + sw_off(cc0 + q, rr)) = f2bf(t[q]); } \
                asm volatile("s_waitcnt lgkmcnt(0)" ::: "memory"); }
            asm volatile("s_waitcnt lgkmcnt(0)" ::: "memory");
            f32x4 tq[3];
            CH_LVL(1) CH_LVL(2) CH_LVL(3)
#undef CH_LVL
        }
        __syncthreads();
        {
            f32x4 a0[2], a1[2]; ZACC(a0) ZACC(a1)
            nt_prod(lds + CH_AT, lds + CH_T, a0, w, lane); nt_prod(lds + CH_AK, lds + CH_T, a1, w, lane);
            nt_store_lds(lds + CH_B, a0, w, lane); nt_store_lds(lds + CH_A, a1, w, lane);
        }
        __syncthreads();
        {
            f32x4 a0[2], a1[2], a2[2], a3[2];
            nt_init_lds(lds + CH_R, a0, w, lane); nt_prod(lds + CH_RB, lds + CH_B, a0, w, lane);
            ZACC(a1) nt_prod(lds + CH_R, lds + CH_K, a1, w, lane); nt_mask<3>(a1, w, lane); nt_prod(lds + CH_RB, lds + CH_A, a1, w, lane);
            ZACC(a2) nt_prod(lds + CH_BH, lds + CH_B, a2, w, lane);
            nt_init_lds(lds + CH_KH, a3, w, lane); nt_prod(lds + CH_BH, lds + CH_A, a3, w, lane);
            nt_store_glb(P.SA_G1 + (size_t)unit * 4096, a0, w, lane); nt_store_lds(lds + CH_G2, a1, w, lane);
            nt_store_glb(P.SA_PC + (size_t)unit * 4096, a2, w, lane); nt_store_lds(lds + CH_QV, a3, w, lane);
        }
        __syncthreads();
        {
            f32x4 a0[2], a1[2]; ZACC(a0) ZACC(a1)
            nt_prod(lds + CH_VT, lds + CH_G2, a0, w, lane); nt_prod(lds + CH_VT, lds + CH_QV, a1, w, lane);
            nt_store_glb(P.SA_YL + (size_t)unit * 4096, a0, w, lane); nt_store_glb(P.SA_QT + (size_t)unit * 4096, a1, w, lane);
        }
    }
}

#undef CH_GLOAD
#undef CH_UNIT
#define CB_PC 0
#define CB_G1 8192
#define CB_QT 16384
#define CB_YL 18432
#define CB_GC 20480
#define CB_SLOT 20736
#define CB_SF (2 * CB_SLOT)
__device__ __forceinline__ void p4_chunk_b(const Params& P, unsigned char* lds) {
    int tid_o = TIDX_(P.wid); asm volatile("" : "+v"(tid_o)); const int tid = tid_o, lane = tid & 63, w = tid >> 6;
    for (int unit = blockIdx.x; unit < 256; unit += gridDim.x) {
        const int bh = (unit & 7) * 8 + (unit >> 5), vq = (unit >> 3) & 3, b = bh >> 3, h = bh & 7;
        const size_t u0 = (size_t)bh * 64;
        const int crow = tid >> 3, cch = tid & 7, cdst = crow * 128 + (sw_ch(crow, cch) << 4);
        const size_t x2off = tid < 128 ? (size_t)(16 * vq + (tid >> 3)) * 64 + (tid & 7) * 8 : tid < 256 ? (size_t)(16 * vq + ((tid - 128) >> 3)) * 64 + (tid & 7) * 8 : (size_t)((tid < 272 ? tid - 256 : 0) * 8);
        const int x2dst = tid < 128 ? CB_QT + cdst : tid < 256 ? CB_YL + (crow - 16) * 128 + (sw_ch(crow - 16, cch) << 4) : CB_GC + (tid < 272 ? tid - 256 : 0) * 16;
#define CB_LOAD(X, c) { const size_t uu = u0 + (c); X##0 = *(const u32x4*)(P.SA_PC + uu * 4096 + tid * 8); X##1 = *(const u32x4*)(P.SA_G1 + uu * 4096 + tid * 8); \
        const bf16_t* p2_ = tid < 128 ? P.SA_QT + uu * 4096 : tid < 256 ? P.SA_YL + uu * 4096 : (const bf16_t*)(P.SA_GC + uu * 64); X##2 = *(const u32x4*)(p2_ + x2off); }
#define CB_STORE(X, slot) { unsigned char* sl_ = lds + (slot) * CB_SLOT; *(u32x4*)(sl_ + CB_PC + cdst) = X##0; *(u32x4*)(sl_ + CB_G1 + cdst) = X##1; \
        if (tid < 272) *(u32x4*)(sl_ + x2dst) = X##2; }
        u32x4 A0, A1, A2 = (u32x4){0u, 0u, 0u, 0u}, B0, B1, B2 = A2, C0, C1, C2 = A2, D0, D1, D2 = A2, E0, E1, E2 = A2, F0, F1, F2 = A2;
        f32x4 Sn = (f32x4){0.f, 0.f, 0.f, 0.f};
        __syncthreads();
        if (tid < 128) *(u32x4*)(lds + CB_SF + tid * 16) = (u32x4){0u, 0u, 0u, 0u};
        CB_LOAD(A, 0) CB_STORE(A, 0)
        CB_LOAD(B, 1) CB_LOAD(C, 2) CB_LOAD(D, 3) CB_LOAD(E, 4) CB_LOAD(F, 5)
        asm volatile("s_waitcnt lgkmcnt(0)" ::: "memory"); __builtin_amdgcn_s_barrier(); asm volatile("" ::: "memory");
#define CB_STEP(c, CUR, NXT) { \
        { const unsigned char* sl_ = lds + ((c) & 1) * CB_SLOT; const int v_ = lane & 15, g_ = lane >> 4, n = w & 3, xr = 16 * n + v_; \
            bf16x8 sf[2]; sf[0] = *(const bf16x8*)(lds + CB_SF + ((c) & 1) * 2048 + lane * 16); sf[1] = *(const bf16x8*)(lds + CB_SF + ((c) & 1) * 2048 + 1024 + lane * 16); \
            if (w < 4) {     \
                const uint2 qt = *(const uint2*)(sl_ + CB_QT + sw_off(v_, 16 * n + 4 * g_)); const f32x4 gc = *(const f32x4*)(sl_ + CB_GC + (16 * n + 4 * g_) * 4); \
                f32x4 as = (f32x4){bflo(qt.x), bfhi(qt.x), bflo(qt.y), bfhi(qt.y)} + gc * Sn; \
                _Pragma("unroll") for (int s = 0; s < 2; ++s) { \
                    const uint2 p0 = *(const uint2*)(sl_ + CB_PC + sw_off(xr, 32 * s + 4 * g_)), p1 = *(const uint2*)(sl_ + CB_PC + sw_off(xr, 32 * s + 16 + 4 * g_)); \
                    u32x4 pf; pf.x = p0.x; pf.y = p0.y; pf.z = p1.x; pf.w = p1.y; \
                    as = __builtin_amdgcn_mfma_f32_16x16x32_bf16(__builtin_bit_cast(bf16x8, pf), sf[s], as, 0, 0, 0); } \
                Sn = as; \
                *(uint2*)(lds + CB_SF + (((c) + 1) & 1) * 2048 + (n >> 1) * 1024 + lane * 16 + (n & 1) * 8) = make_uint2(pack2(as[0], as[1]), pack2(as[2], as[3])); \
            } else {         \
                const uint2 yl = *(const uint2*)(sl_ + CB_YL + sw_off(v_, 16 * n + 4 * g_)); f32x4 ay = (f32x4){bflo(yl.x), bfhi(yl.x), bflo(yl.y), bfhi(yl.y)}; \
                _Pragma("unroll") for (int s = 0; s < 2; ++s) { \
                    const uint2 q0 = *(const uint2*)(sl_ + CB_G1 + sw_off(xr, 32 * s + 4 * g_)), q1 = *(const uint2*)(sl_ + CB_G1 + sw_off(xr, 32 * s + 16 + 4 * g_)); \
                    u32x4 gf; gf.x = q0.x; gf.y = q0.y; gf.z = q1.x; gf.w = q1.y; \
                    ay = __builtin_amdgcn_mfma_f32_16x16x32_bf16(__builtin_bit_cast(bf16x8, gf), sf[s], ay, 0, 0, 0); } \
                bf16_t* yo = P.YR + (size_t)(b * TP + (c) * 64) * 512 + h * 64 + 16 * vq + v_; \
                _Pragma("unroll") for (int q = 0; q < 4; ++q) yo[(size_t)(16 * n + 4 * g_ + q) * 512] = f2bf(ay[q]); } } \
        if ((c) + 1 < 64) CB_STORE(NXT, ((c) + 1) & 1) \
        if ((c) + 6 < 64) CB_LOAD(CUR, (c) + 6) \
        asm volatile("s_waitcnt lgkmcnt(0)" ::: "memory"); __builtin_amdgcn_s_barrier(); asm volatile("" ::: "memory"); }
        for (int c = 0; c < 60; c += 6) { CB_STEP(c, A, B) CB_STEP(c + 1, B, C) CB_STEP(c + 2, C, D) CB_STEP(c + 3, D, E) CB_STEP(c + 4, E, F) CB_STEP(c + 5, F, A) }
        CB_STEP(60, A, B) CB_STEP(61, B, C) CB_STEP(62, C, D) CB_STEP(63, D, E)
        if (w < 4) { float* so = P.o_state_p + (size_t)bh * 4096 + (size_t)(16 * vq + (lane & 15)) * 64 + 4 * (lane >> 4); *(f32x4*)(so + 16 * w) = Sn; }
#undef CB_LOAD
#undef CB_STORE
#undef CB_STEP
    }
}
template <int MODE>
__device__ __forceinline__ void g64_phase(const Params& P, unsigned char* lds, const bf16_t* A, const int lda, const bf16_t* Bt) {
    int tid_o = TIDX_(P.wid); asm volatile("" : "+v"(tid_o)); const int tid = tid_o, lane = tid & 63, w = tid >> 6;
    for (int tile = blockIdx.x; tile < 256; tile += gridDim.x) {
        const int row0 = MP + 64 * ((tile & 7) * 2 + (tile >> 7)), col0 = 64 * ((tile >> 3) & 15);
        u32x4 af[4][4], bf[4][4];
#pragma unroll
        for (int s = 0; s < 4; ++s)
#pragma unroll
            for (int m = 0; m < 4; ++m) {
                af[m][s] = *(const u32x4*)(A + (size_t)(row0 + 16 * m + (lane & 15)) * lda + 128 * w + 32 * s + 8 * (lane >> 4));
                bf[m][s] = *(const u32x4*)(Bt + (size_t)(col0 + 16 * m + (lane & 15)) * DM + 128 * w + 32 * s + 8 * (lane >> 4));
            }
        f32x4 acc[4][4];
#pragma unroll
        for (int m = 0; m < 4; ++m)
#pragma unroll
            for (int n = 0; n < 4; ++n) acc[m][n] = (f32x4){0.f, 0.f, 0.f, 0.f};
#pragma unroll
        for (int s = 0; s < 4; ++s)
#pragma unroll
            for (int m = 0; m < 4; ++m)
#pragma unroll
                for (int n = 0; n < 4; ++n) acc[m][n] = __builtin_amdgcn_mfma_f32_16x16x32_bf16(__builtin_bit_cast(bf16x8, bf[n][s]), __builtin_bit_cast(bf16x8, af[m][s]), acc[m][n], 0, 0, 0);
        __syncthreads();
        float* part_l = (float*)lds + w * 4096;
#pragma unroll
        for (int m = 0; m < 4; ++m)
#pragma unroll
            for (int n = 0; n < 4; ++n) { const int r = 16 * m + (lane & 15), ch = 4 * n + (lane >> 4); *(f32x4*)(part_l + r * 64 + ((ch ^ (r & 15)) << 2)) = acc[m][n]; }
        __syncthreads();
        const int r = tid >> 3, j = tid & 7, row = row0 + r, col = col0 + 8 * j;
        f32x4 s0 = (f32x4){0.f, 0.f, 0.f, 0.f}, s1 = s0;
#pragma unroll
        for (int ww = 0; ww < 8; ++ww) { const float* pl = (const float*)lds + ww * 4096 + r * 64; s0 += *(const f32x4*)(pl + (((2 * j) ^ (r & 15)) << 2)); s1 += *(const f32x4*)(pl + (((2 * j + 1) ^ (r & 15)) << 2)); }
        if (MODE == 0) {
            const float* xr = P.x_sample + (size_t)(row - MP) * DM + col;
            const f32x4 h0 = *(const f32x4*)xr + s0, h1 = *(const f32x4*)(xr + 4) + s1;
            u32x4 wv; wv.x = pack2(h0[0], h0[1]); wv.y = pack2(h0[2], h0[3]); wv.z = pack2(h1[0], h1[1]); wv.w = pack2(h1[2], h1[3]);
            *(u32x4*)(P.HB + (size_t)row * DM + col) = wv;
            float ss = (h0[0] * h0[0] + h0[1] * h0[1]) + (h0[2] * h0[2] + h0[3] * h0[3]) + (h1[0] * h1[0] + h1[1] * h1[1]) + (h1[2] * h1[2] + h1[3] * h1[3]);
            ss = oct_allsum(ss);
            if (j == 0) P.part[(size_t)row * 16 + (col0 >> 6)] = ss;
        } else {
            float ss = 0.f;
#pragma unroll
            for (int i = 0; i < 4; ++i) { const f32x4 p4 = *(const f32x4*)(P.part + (size_t)row * 16 + i * 4); ss += (p4[0] + p4[1]) + (p4[2] + p4[3]); }
            const float rs = rsqrtf(ss * (1.0f / DM) + 1e-6f);
            const u32x4 hh = *(const u32x4*)(P.HB + (size_t)row * DM + col), pl = *(const u32x4*)(P.PLS + (size_t)(row - MP) * DM + col);
            f32x4 o0, o1;
            o0[0] = bflo(hh.x) + sigmoidf_(s0[0] * rs) * bflo(pl.x); o0[1] = bfhi(hh.x) + sigmoidf_(s0[1] * rs) * bfhi(pl.x);
            o0[2] = bflo(hh.y) + sigmoidf_(s0[2] * rs) * bflo(pl.y); o0[3] = bfhi(hh.y) + sigmoidf_(s0[3] * rs) * bfhi(pl.y);
            o1[0] = bflo(hh.z) + sigmoidf_(s1[0] * rs) * bflo(pl.z); o1[1] = bfhi(hh.z) + sigmoidf_(s1[1] * rs) * bfhi(pl.z);
            o1[2] = bflo(hh.w) + sigmoidf_(s1[2] * rs) * bflo(pl.w); o1[3] = bfhi(hh.w) + sigmoidf_(s1[3] * rs) * bfhi(pl.w);
            float* yp = P.y_all + (size_t)row * DM + col; *(f32x4*)yp = o0; *(f32x4*)(yp + 4) = o1;
        }
    }
}

#ifndef REP_P0
#define REP_P0 1
#endif
#ifndef REP_P1
#define REP_P1 1
#endif
#ifndef REP_PREP
#define REP_PREP 1
#endif
#ifndef REP_ATTN
#define REP_ATTN 1
#endif
#ifndef REP_SCAN
#define REP_SCAN 1
#endif
#ifndef REP_CHA
#define REP_CHA 1
#endif
#ifndef REP_CHB
#define REP_CHB 1
#endif
#ifndef REP_P7
#define REP_P7 1
#endif
#ifndef REP_POST
#define REP_POST 1
#endif
#ifndef REP_ATTS
#define REP_ATTS 1
#endif
#ifndef REP_P5
#define REP_P5 1
#endif
__device__ __forceinline__ int opq(int x) { asm volatile("" : "+s"(x)); return x; }
typedef const __attribute__((address_space(4))) Params* KParams;
__device__ __forceinline__ KParams opq_kp(KParams p) { asm volatile("" : "+s"(p)); return p; }
#define LDS_RING 131072
#define LDS_TOTAL (LDS_RING + 1024 + 16384 + 512)
__global__ void __launch_bounds__(NTHR, 2) fwd_kernel(Params P0_) {
    extern __shared__ __attribute__((aligned(16))) unsigned char lds[];
#ifdef PADNOPS
    asm volatile(".rept " PADNOPS "\n\ts_nop 0\n\t.endr");
#endif
    const int tid = threadIdx.x;
    volatile LAS unsigned* bst = (volatile LAS unsigned*)((LAS unsigned char*)lds + LDS_RING);
    if (tid < 4) bst[tid] = 0u;
    __syncthreads();
    int wid_s = __builtin_amdgcn_readfirstlane(tid >> 6); asm volatile("" : "+s"(wid_s));
    XcdBarrier bar = xcd_barrier_post(P0_.bar, bst, wid_s);
    if (tid == 0) P0_.bar[XB_IDS + blockIdx.x] = bar.x + 1u;
    const int G = gridDim.x, cu = blockIdx.x;
    const KParams Pk = (KParams)__builtin_amdgcn_kernarg_segment_ptr();
#if defined(__HIP_DEVICE_COMPILE__)
#define PLOAD Params P = *opq_kp(Pk); P.wid = wid_s;
#else
#define PLOAD Params P = P0_; P.wid = wid_s;
#endif

    for (int rep = 0, nrep_ = opq(REP_P0); rep < nrep_; ++rep) { PLOAD p0_prologue(P, lds); }
    xcd_barrier(bar);
    xcd_check(bar);
    for (int rep = 0, nrep_ = opq(REP_P1); rep < nrep_; ++rep) { PLOAD Gemm g{P.XB, P.Wt_in, MT, DINP, DM, DM, P.wid}; StaticOrder S; S.init(MT, DINP, G, cu); EpiInProj E{P.H};
      gemm_phase<EpiInProj, StaticOrder, true, true>((LAS unsigned char*)lds, g, S, E); }
    { PLOAD Gemm g{P.PB, P.Wt_ple, MT, DM, 256, 256, P.wid}; TailOrder S{(MT / 256) * 4, G, (MT / 256) * (DINP / 256) - 7 * G, cu}; EpiPle E{P.y_all, P.PLS};
      gemm_phase<EpiPle, TailOrder, true, true>((LAS unsigned char*)lds, g, S, E); }
    xcd_barrier(bar);
#ifndef DESYNC_SLEEPS
#define DESYNC_SLEEPS 0
#endif
#if 1
    { const int xc_ = (int)blockIdx.x & 7; const int nsl_ = (bst[2] == 1u) ? (DESYNC_SLEEPS) : 0; (void)xc_; for (int i = 0; i < nsl_; ++i) __builtin_amdgcn_s_sleep(127); }
#endif
#ifndef ANTIPHASE
#define ANTIPHASE 1
#endif
    const bool lok_ = (__builtin_amdgcn_readfirstlane((int)bst[2]) == 1);
#ifndef EFLIP
#define EFLIP 1
#endif
#ifndef AMODE_FN
#define AMODE_FN(xc) (((xc) & 4) ? 2 : 0)
#endif
    int amode = lok_ ? (AMODE_FN((int)blockIdx.x & 7)) : (((int)blockIdx.x >> 7) & 1); asm volatile("" : "+s"(amode));
    { if (amode == 0) {
          for (int rep = 0, nrep_ = opq(REP_ATTN); rep < nrep_; ++rep) { PLOAD p3_attn_prompt(P, lds); }
          for (int rep = 0, nrep_ = opq(REP_ATTS); rep < nrep_; ++rep) { PLOAD p3_attn_sample(P, lds); }
      }
      for (int rep = 0, nrep_ = opq(REP_PREP); rep < nrep_; ++rep) { PLOAD p2_rwkv_prep(P, lds); }
      for (int rep = 0, nrep_ = opq(REP_CHA); rep < nrep_; ++rep) { PLOAD p3_chunk_a(P, lds); }
      if (amode == 1) {
          for (int rep = 0, nrep_ = opq(REP_ATTN); rep < nrep_; ++rep) { PLOAD p3_attn_prompt(P, lds); }
          for (int rep = 0, nrep_ = opq(REP_ATTS); rep < nrep_; ++rep) { PLOAD p3_attn_sample(P, lds); }
      }
    }
    xcd_barrier_local(bar);
    for (int rep = 0, nrep_ = opq(REP_CHB); rep < nrep_; ++rep) { PLOAD p4_chunk_b(P, lds); }
    for (int rep = 0, nrep_ = opq(REP_SCAN); rep < nrep_; ++rep) { PLOAD p3_scan(P, lds); }
    xcd_barrier_local(bar);
    for (int rep = 0, nrep_ = opq(REP_POST); rep < nrep_; ++rep) { PLOAD p4_post(P); }
#ifndef P6_SLEEPS
#define P6_SLEEPS 0
#endif
    if (amode == 2) {
        for (int i = 0; i < (P6_SLEEPS); ++i) __builtin_amdgcn_s_sleep(127);
        for (int rep = 0, nrep_ = opq(REP_ATTN); rep < nrep_; ++rep) { PLOAD p3_attn_prompt(P, lds); }
        for (int rep = 0, nrep_ = opq(REP_ATTS); rep < nrep_; ++rep) { PLOAD p3_attn_sample(P, lds); }
    }
    xcd_barrier_local(bar);
    for (int rep = 0, nrep_ = opq(REP_P5); rep < nrep_; ++rep) {
    { PLOAD Gemm g{P.H + OFF_ZR, P.Wt_out, MP, DM, DM, DIN, P.wid}; StaticOrder S; S.init(MP, DM, G, cu); EpiOut E{P.HB, P.part, P.rstd_x};
      gemm_phase<EpiOut, StaticOrder, true, true>((LAS unsigned char*)lds, g, S, E);
      }
      { PLOAD g64_phase<0>(P, lds, P.H + OFF_ZR, DIN, P.Wt_out); }
    }
    xcd_barrier_local(bar);
    for (int rep = 0, nrep_ = opq(REP_P7); rep < nrep_; ++rep) { { PLOAD Gemm g{P.HB, P.Wt_gate, MP, DM, DM, DM, P.wid}; StaticOrder S; S.init(MP, DM, G, cu); EpiGate E{P.y_all, P.HB, P.part};
      gemm_phase<EpiGate, StaticOrder, true, true>((LAS unsigned char*)lds, g, S, E);
      }
      { PLOAD g64_phase<1>(P, lds, P.HB, DM, P.Wt_gate); } }
}

extern "C" void kernel_launch(void* const* d_in, const int* in_sizes, int n_in, void* d_out, int out_size, void* d_ws, size_t ws_size, hipStream_t stream) {
    static int grid = 0;
    if (grid == 0) {
        int dev = 0, cus = 0, per_cu = 0;
        hipGetDevice(&dev);
        hipDeviceGetAttribute(&cus, hipDeviceAttributeMultiprocessorCount, dev);
        if (hipFuncSetAttribute((const void*)fwd_kernel, hipFuncAttributeMaxDynamicSharedMemorySize, LDS_TOTAL) != hipSuccess) { fprintf(stderr, "hipFuncSetAttribute failed\n"); }
        hipOccupancyMaxActiveBlocksPerMultiprocessor(&per_cu, (const void*)fwd_kernel, NTHR, LDS_TOTAL);
        (void)hipGetLastError();
        grid = 256;
        if (cus != 256) fprintf(stderr, "warning: %d CUs reported; this kernel is written for 256\n", cus);
        if (per_cu < 1) fprintf(stderr, "occupancy query says %d blocks/CU\n", per_cu);
    }
    Params P{};
    const float** in = (const float**)&P.x_prompt;
    for (int i = 0; i < 27; ++i) in[i] = (const float*)d_in[i];
    float* out = (float*)d_out;
    P.y_all = out;
    P.o_state_p = out + (size_t)MT * DM;
    P.o_state_s = P.o_state_p + 262144;
    P.o_shift_p = P.o_state_s + 4194304;
    P.o_shift_s = P.o_shift_p + 13312;
    P.o_ck_p = P.o_shift_s + 212992;
    P.o_ck_s = P.o_ck_p + 131072;
    P.o_cv_p = P.o_ck_s + 2097152;
    P.o_cv_s = P.o_cv_p + 131072;
    unsigned char* ws = (unsigned char*)d_ws;
    size_t off = 0;
    auto take = [&](size_t bytes) { unsigned char* p = ws + off; off += (bytes + 255) & ~(size_t)255; return p; };
    P.bar = (unsigned*)take(16384);
    P.Wt_in = (bf16_t*)take((size_t)DINP * DM * 2);
    P.Wt_out = (bf16_t*)take((size_t)DM * DM * 2);
    P.Wt_gate = (bf16_t*)take((size_t)DM * DM * 2);
    P.Wt_ple = (bf16_t*)take((size_t)DM * 256 * 2);
    P.rstd_x = (float*)take((size_t)MT * 4);
    P.part = (float*)take((size_t)MT * 16 * 4);
    P.rk = (float*)take((size_t)MT * 8 * 4);
    P.WLd = (bf16_t*)take(8 * 64 * 64 * 2);
    P.WLa = (bf16_t*)take(8 * 64 * 64 * 2);
    P.PLS = (bf16_t*)take((size_t)MS * DM * 2);
    P.H = (bf16_t*)take((size_t)MT * DIN * 2);
    P.XB = (bf16_t*)take((size_t)MT * DM * 2);
    P.SA_G1 = (bf16_t*)take((size_t)4096 * 4096 * 2);
    P.SA_PC = (bf16_t*)take((size_t)4096 * 4096 * 2);
    P.SA_QT = (bf16_t*)take((size_t)4096 * 4096 * 2);
    P.SA_YL = (bf16_t*)take((size_t)4096 * 4096 * 2);
    P.SA_GC = (float*)take((size_t)4096 * 64 * 4);
    P.YR = (bf16_t*)take((size_t)MT * 512 * 2);
    P.Rv = (bf16_t*)take((size_t)MT * 512 * 2);
    P.Rr = (bf16_t*)take((size_t)MS * 512 * 2) - (size_t)MP * 512;
    P.Re = (bf16_t*)take((size_t)MS * 512 * 2) - (size_t)MP * 512;
    P.Rk = (bf16_t*)take((size_t)MS * 512 * 2) - (size_t)MP * 512;
    P.Rkk = (bf16_t*)take((size_t)MS * 512 * 2) - (size_t)MP * 512;
    P.Reta = (bf16_t*)take((size_t)MS * 512 * 2) - (size_t)MP * 512;
    P.PB = (bf16_t*)P.o_state_p;
    P.PLE = nullptr;
    P.HB = P.XB;
    if (off > ws_size) { fprintf(stderr, "workspace too small: need %zu have %zu\n", off, ws_size); return; }
    hipMemsetAsync(P.bar, 0, 16384, stream);
    hipLaunchKernelGGL(fwd_kernel, dim3(grid), dim3(NTHR), LDS_TOTAL, stream, P);
}
```
